# Optimizing an MI355X kernel written in HIP

```python
import math
import jax, jax.numpy as jnp
from jax import lax
import numpy as np

D_MODEL = 2048
BATCH = 2
SEQ = 8192
DEPTH = 4
DEC_BATCH = 8
DEC_SEQ = 2048
PAST_LEN = 128

N_MIXERS = 2
N_RET_LAYERS = (DEPTH + 1) // 2
N_MLA_LAYERS = DEPTH // 2

ALPHA = (2.0 * DEPTH) ** 0.25
BETA = (8.0 * DEPTH) ** -0.25

RET_HEADS = D_MODEL // 256
RET_QK_DIM = 256
RET_V_DIM = 512
RET_QK_W = RET_HEADS * RET_QK_DIM
RET_V_W = RET_HEADS * RET_V_DIM
RET_IN = 2 * RET_QK_W + 2 * RET_V_W
RET_CHUNK = 128
RET_ROPE_BASE = 10000.0

MLA_HEADS = 16
MLA_Q_RANK = 1536
MLA_KV_RANK = 512
MLA_NOPE = 128
MLA_ROPE = 64
MLA_V = 128
MLA_IN = MLA_Q_RANK + MLA_KV_RANK + MLA_ROPE
MLA_ROPE_BASE = 10000.0
Q_BLOCK = 128

FFN_DIM = 5632
CONV_WIDTH = 3

LN_EPS = 1e-5
RMS_EPS = 1e-6
GN_EPS = 1e-6

kernel_name = "hybrid_retention_mla_convffn_encoder"


def layer_norm(x, g, b):
    xf = x.astype(jnp.float32)
    mu = jnp.mean(xf, axis=-1, keepdims=True)
    var = jnp.mean(jnp.square(xf - mu), axis=-1, keepdims=True)
    y = (xf - mu) * lax.rsqrt(var + LN_EPS) * g.astype(jnp.float32) + b.astype(jnp.float32)
    return y.astype(x.dtype)


def rms_norm(x, g):
    xf = x.astype(jnp.float32)
    y = xf * lax.rsqrt(jnp.mean(jnp.square(xf), axis=-1, keepdims=True) + RMS_EPS)
    return (y * g.astype(jnp.float32)).astype(x.dtype)


def rope_tables(seq, dim, base):
    inv = 1.0 / (base ** (jnp.arange(0, dim // 2, dtype=jnp.float32) * (2.0 / dim)))
    ang = jnp.arange(seq, dtype=jnp.float32)[:, None] * inv[None, :]
    return jnp.cos(ang), jnp.sin(ang)


def apply_rope(x, cos, sin):
    half = x.shape[-1] // 2
    x1 = x[..., :half].astype(jnp.float32)
    x2 = x[..., half:].astype(jnp.float32)
    y = jnp.concatenate([x1 * cos - x2 * sin, x1 * sin + x2 * cos], axis=-1)
    return y.astype(x.dtype)


def retention_scan(q, k, v, log_g, strict):
    B, H, S, dk = q.shape
    dv = v.shape[-1]
    n_chunks = S // RET_CHUNK
    idx = jnp.arange(RET_CHUNK, dtype=jnp.float32)
    rel = idx[:, None] - idx[None, :]
    mask = (rel > 0) if strict else (rel >= 0)
    d_intra = jnp.where(mask[None], jnp.exp(log_g[:, None, None] * jnp.maximum(rel, 0.0)[None]), 0.0)
    xi = jnp.exp(log_g[:, None] * (idx[None, :] + 1.0))[:, :, None]
    zeta = jnp.exp(log_g[:, None] * (RET_CHUNK - 1.0 - idx[None, :]))[:, :, None]
    g_chunk = jnp.exp(log_g * RET_CHUNK)[:, None, None]

    def to_chunks(t):
        return t.reshape(B, H, n_chunks, RET_CHUNK, t.shape[-1]).transpose(2, 0, 1, 3, 4)

    def step(state, inp):
        qc, kc, vc = inp
        s = jnp.einsum('bhid,bhjd->bhij', qc, kc) * d_intra
        o = jnp.einsum('bhij,bhjv->bhiv', s, vc) + jnp.einsum('bhid,bhdv->bhiv', qc * xi, state)
        state = g_chunk * state + jnp.einsum('bhjd,bhjv->bhdv', kc * zeta, vc)
        return state, o

    state0 = jnp.zeros((B, H, dk, dv), jnp.float32)
    _, o = lax.scan(step, state0, (to_chunks(q), to_chunks(k), to_chunks(v)))
    return o.transpose(1, 2, 0, 3, 4).reshape(B, H, S, dv)


def retention_mixer(x, w_in, decay_fwd, decay_bwd, w_out):
    B, S, _ = x.shape
    p = x @ w_in
    q = p[..., :RET_QK_W].reshape(B, S, RET_HEADS, RET_QK_DIM)
    k = p[..., RET_QK_W:2 * RET_QK_W].reshape(B, S, RET_HEADS, RET_QK_DIM)
    v = p[..., 2 * RET_QK_W:2 * RET_QK_W + RET_V_W].reshape(B, S, RET_HEADS, RET_V_DIM)
    gate = p[..., 2 * RET_QK_W + RET_V_W:]
    cos, sin = rope_tables(S, RET_QK_DIM, RET_ROPE_BASE)
    q = apply_rope(q, cos[:, None], sin[:, None])
    k = apply_rope(k, cos[:, None], sin[:, None])
    qf = q.astype(jnp.float32).transpose(0, 2, 1, 3)
    kf = k.astype(jnp.float32).transpose(0, 2, 1, 3) * (RET_QK_DIM ** -0.5)
    vf = v.astype(jnp.float32).transpose(0, 2, 1, 3)
    log_f = jax.nn.log_sigmoid(decay_fwd.astype(jnp.float32))
    log_b = jax.nn.log_sigmoid(decay_bwd.astype(jnp.float32))
    o_fwd = retention_scan(qf, kf, vf, log_f, False)
    o_bwd = jnp.flip(retention_scan(jnp.flip(qf, 2), jnp.flip(kf, 2), jnp.flip(vf, 2), log_b, True), 2)
    o = o_fwd + o_bwd
    mu = jnp.mean(o, axis=-1, keepdims=True)
    var = jnp.mean(jnp.square(o - mu), axis=-1, keepdims=True)
    o = (o - mu) * lax.rsqrt(var + GN_EPS)
    o = o.transpose(0, 2, 1, 3).reshape(B, S, RET_V_W).astype(x.dtype)
    return (jax.nn.silu(gate) * o) @ w_out


def mla_mixer(x, w_in, q_norm, kv_norm, w_uq, w_ukv, w_out):
    B, S, _ = x.shape
    c = x @ w_in
    cq = rms_norm(c[..., :MLA_Q_RANK], q_norm)
    ckv = rms_norm(c[..., MLA_Q_RANK:MLA_Q_RANK + MLA_KV_RANK], kv_norm)
    k_rope = c[..., MLA_Q_RANK + MLA_KV_RANK:]
    q = (cq @ w_uq).reshape(B, S, MLA_HEADS, MLA_NOPE + MLA_ROPE)
    kv = (ckv @ w_ukv).reshape(B, S, MLA_HEADS, MLA_NOPE + MLA_V)
    q_nope, q_rope = q[..., :MLA_NOPE], q[..., MLA_NOPE:]
    k_nope, v = kv[..., :MLA_NOPE], kv[..., MLA_NOPE:]
    cos, sin = rope_tables(S, MLA_ROPE, MLA_ROPE_BASE)
    q_rope = apply_rope(q_rope, cos[:, None], sin[:, None])
    k_rope = apply_rope(k_rope, cos, sin)
    scale = (MLA_NOPE + MLA_ROPE) ** -0.5
    n_blocks = S // Q_BLOCK
    qn_blocks = q_nope.reshape(B, n_blocks, Q_BLOCK, MLA_HEADS, MLA_NOPE).transpose(1, 0, 2, 3, 4)
    qr_blocks = q_rope.reshape(B, n_blocks, Q_BLOCK, MLA_HEADS, MLA_ROPE).transpose(1, 0, 2, 3, 4)

    def attend(args):
        qn, qr = args
        s = jnp.einsum('bqhd,bkhd->bhqk', qn, k_nope) + jnp.einsum('bqhr,bkr->bhqk', qr, k_rope)
        pr = jax.nn.softmax(s.astype(jnp.float32) * scale, axis=-1).astype(v.dtype)
        return jnp.einsum('bhqk,bkhd->bqhd', pr, v)

    o = lax.map(attend, (qn_blocks, qr_blocks))
    o = o.transpose(1, 0, 2, 3, 4).reshape(B, S, MLA_HEADS * MLA_V)
    return o @ w_out


def conv_ffn(x, w_up, conv_w, conv_b, w_down):
    h = x @ w_up
    u, g = h[..., :FFN_DIM], h[..., FFN_DIM:]
    gp = jnp.pad(g, ((0, 0), (1, 1), (0, 0)))
    g = gp[:, :-2] * conv_w[0] + gp[:, 1:-1] * conv_w[1] + gp[:, 2:] * conv_w[2] + conv_b
    return (jax.nn.silu(g) * u) @ w_down


def trunk(x, ret_w_in, ret_decay_fwd, ret_decay_bwd, ret_w_out,
          mla_w_in, mla_q_norm, mla_kv_norm, mla_w_uq, mla_w_ukv, mla_w_out,
          ln1_g, ln1_b, ln2_g, ln2_b, ffn_w_up, ffn_conv_w, ffn_conv_b, ffn_w_down):
    for i in range(DEPTH):
        j = i // N_MIXERS
        if i % N_MIXERS == 0:
            m = retention_mixer(x, ret_w_in[j], ret_decay_fwd[j], ret_decay_bwd[j], ret_w_out[j])
        else:
            m = mla_mixer(x, mla_w_in[j], mla_q_norm[j], mla_kv_norm[j],
                          mla_w_uq[j], mla_w_ukv[j], mla_w_out[j])
        x = layer_norm(ALPHA * x + m, ln1_g[i], ln1_b[i])
        f = conv_ffn(x, ffn_w_up[i], ffn_conv_w[i], ffn_conv_b[i], ffn_w_down[i])
        x = layer_norm(ALPHA * x + f, ln2_g[i], ln2_b[i])
    return x


def _dense(k, shape, fan_in, scale=1.0):
    return jax.random.normal(k, shape, jnp.float32) * (scale * fan_in ** -0.5)


def setup_inputs(seed: int = 0) -> dict:
    key = jax.random.key(seed)
    ks = jax.random.split(key, 20)
    expo = 5.0 + jnp.arange(RET_HEADS, dtype=jnp.float32)
    decay_logit = jnp.log(jnp.exp2(expo) - 1.0)
    nrm = lambda k, shape: jax.random.normal(k, shape, jnp.float32)
    return {
        "x_prompt": nrm(ks[0], (BATCH, SEQ, D_MODEL)),
        "x_sample": nrm(ks[1], (DEC_BATCH, DEC_SEQ, D_MODEL)),
        "ret_w_in": _dense(ks[2], (N_RET_LAYERS, D_MODEL, RET_IN), D_MODEL),
        "ret_decay_fwd": decay_logit + 0.05 * nrm(ks[3], (N_RET_LAYERS, RET_HEADS)),
        "ret_decay_bwd": decay_logit + 0.05 * nrm(ks[4], (N_RET_LAYERS, RET_HEADS)),
        "ret_w_out": _dense(ks[5], (N_RET_LAYERS, RET_V_W, D_MODEL), RET_V_W, BETA),
        "mla_w_in": _dense(ks[6], (N_MLA_LAYERS, D_MODEL, MLA_IN), D_MODEL),
        "mla_q_norm": 1.0 + 0.02 * nrm(ks[7], (N_MLA_LAYERS, MLA_Q_RANK)),
        "mla_kv_norm": 1.0 + 0.02 * nrm(ks[8], (N_MLA_LAYERS, MLA_KV_RANK)),
        "mla_w_uq": _dense(ks[9], (N_MLA_LAYERS, MLA_Q_RANK, MLA_HEADS * (MLA_NOPE + MLA_ROPE)), MLA_Q_RANK),
        "mla_w_ukv": _dense(ks[10], (N_MLA_LAYERS, MLA_KV_RANK, MLA_HEADS * (MLA_NOPE + MLA_V)), MLA_KV_RANK),
        "mla_w_out": _dense(ks[11], (N_MLA_LAYERS, MLA_HEADS * MLA_V, D_MODEL), MLA_HEADS * MLA_V, BETA),
        "ln1_g": 1.0 + 0.02 * nrm(ks[12], (DEPTH, D_MODEL)),
        "ln1_b": 0.02 * nrm(ks[13], (DEPTH, D_MODEL)),
        "ln2_g": 1.0 + 0.02 * nrm(ks[14], (DEPTH, D_MODEL)),
        "ln2_b": 0.02 * nrm(ks[15], (DEPTH, D_MODEL)),
        "ffn_w_up": _dense(ks[16], (DEPTH, D_MODEL, 2 * FFN_DIM), D_MODEL),
        "ffn_conv_w": _dense(ks[17], (DEPTH, CONV_WIDTH, FFN_DIM), CONV_WIDTH),
        "ffn_conv_b": 0.02 * nrm(ks[18], (DEPTH, FFN_DIM)),
        "ffn_w_down": _dense(ks[19], (DEPTH, FFN_DIM, D_MODEL), FFN_DIM, BETA),
    }


def reference(x_prompt, x_sample, ret_w_in, ret_decay_fwd, ret_decay_bwd, ret_w_out,
              mla_w_in, mla_q_norm, mla_kv_norm, mla_w_uq, mla_w_ukv, mla_w_out,
              ln1_g, ln1_b, ln2_g, ln2_b, ffn_w_up, ffn_conv_w, ffn_conv_b, ffn_w_down):
    weights = (ret_w_in, ret_decay_fwd, ret_decay_bwd, ret_w_out,
               mla_w_in, mla_q_norm, mla_kv_norm, mla_w_uq, mla_w_ukv, mla_w_out,
               ln1_g, ln1_b, ln2_g, ln2_b, ffn_w_up, ffn_conv_w, ffn_conv_b, ffn_w_down)
    y_prompt = trunk(x_prompt, *weights)
    y_sample = trunk(x_sample, *weights)
    return (y_prompt, y_sample)
```

```cpp
#include <hip/hip_runtime.h>
#include <cstdio>
#include <cstdint>

#define GAS __attribute__((address_space(1)))
#define LAS __attribute__((address_space(3)))

namespace pg8 {
#define PG8_LAS __attribute__((address_space(3)))
typedef unsigned short bf16_t;
typedef short bf16x8 __attribute__((ext_vector_type(8)));
typedef float f32x4 __attribute__((ext_vector_type(4)));
typedef unsigned u32x4 __attribute__((ext_vector_type(4)));
typedef _Float16 f16x8 __attribute__((ext_vector_type(8)));
template <bool F16> __device__ __forceinline__ f32x4 mfma16(bf16x8 a, bf16x8 b, f32x4 c) {
    if constexpr (F16) return __builtin_amdgcn_mfma_f32_16x16x32_f16(__builtin_bit_cast(f16x8, a), __builtin_bit_cast(f16x8, b), c, 0, 0, 0);
    else return __builtin_amdgcn_mfma_f32_16x16x32_bf16(a, b, c, 0, 0, 0);
}
constexpr int BM = 256, BK = 64, HALF = 128, HTB = HALF * BK * 2  , STAGE_BYTES = 8 * HTB, NXCD = 8, WGM = 8;
constexpr int PF_OFF = STAGE_BYTES, PF_BYTES = 6144;

__host__ __device__ __forceinline__ int lds_byte(int r, int c) { const int st = (r >> 4) * 2 + (c >> 5), rr = r & 15, cc = c & 31, ob = rr * 64 + cc * 2; return st * 1024 + (ob ^ (((ob >> 9) & 1) << 5)); }
__host__ __device__ __forceinline__ void stage_rc(int b, int& R, int& C) { const int st = b / 1024, sb = b % 1024, swz = sb ^ (((sb >> 9) & 1) << 5); R = (st >> 1) * 16 + swz / 64; C = (st & 1) * 32 + (swz % 64) / 2; }
__host__ __device__ __forceinline__ int perm32(int rho) { const int n = rho >> 4, i = rho & 15; return 8 * (i >> 2) + 4 * n + (i & 3); }

struct Unit { int pm, pn; };
struct Gemm { const bf16_t* A; const bf16_t* Bt; int M, N, K; };

struct StaticOrder {
    int nM, nN, nwg, G, c;
    __host__ __device__ void init(int M, int N, int G_, int c_) { nM = M / BM; nN = N / BM; nwg = nM * nN; G = G_; c = c_; }
    __host__ __device__ bool next(int i, Unit& u) const {
        const long L = (long)i * G + c; if (L >= nwg) return false;
        int wgid = (int)L; { const int q = nwg / NXCD, r = nwg % NXCD, xcd = wgid % NXCD, off = wgid / NXCD; wgid = (xcd < r ? xcd * (q + 1) : r * (q + 1) + (xcd - r) * q) + off; }
        const int nig = WGM * nN, gid = wgid / nig, fm = gid * WGM, gsz = (nM - fm) < WGM ? (nM - fm) : WGM;
        u.pm = fm + ((wgid % nig) % gsz); u.pn = (wgid % nig) / gsz; return true;
    }
    __device__ __forceinline__ void a_ready(const Unit&) const {}
    __device__ __forceinline__ void done(const Unit&) const {}
};
__device__ __forceinline__ unsigned cvt_pk_bf16(float lo, float hi) { unsigned r; asm volatile("v_cvt_pk_bf16_f32 %0, %1, %2" : "=v"(r) : "v"(lo), "v"(hi)); return r; }

template <class Epi, class Sched, bool ALIGN_EPI = false, bool SP2 = false>
__device__ __forceinline__ void gemm_phase(PG8_LAS unsigned char* lds, const Gemm g, const Sched& S, const Epi& E) {
    int tid_l = threadIdx.x; asm volatile("" : "+v"(tid_l));
    const int tid = tid_l, wid = __builtin_amdgcn_readfirstlane(tid >> 6), lane = tid & 63, wr = wid >> 2, wc = wid & 3, fr = lane & 15, fq = lane >> 4;
    const int K = g.K, nt = K / BK;
    unsigned voffA[2], voffB[2];
#pragma unroll
    for (int i = 0; i < 2; ++i) { int R, C; stage_rc(tid * 16 + i * 8192, R, C); const int Rb = Epi::PERM ? ((R & ~31) + perm32(R & 31)) : R;
        const int Ra = Epi::APERM ? ((R & ~63) + 4 * (R & 15) + ((R >> 4) & 3)) : R;
        voffA[i] = (unsigned)(Ra * K + C) * 2u; voffB[i] = (unsigned)(Rb * K + C) * 2u; }
    const size_t kstep = (size_t)(BK * 2);
    const size_t hstep = (size_t)HALF * K * 2;
    const size_t tstep = 2 * hstep;
    const unsigned ldsw = (unsigned)wid * 1024u;
    const int aoff = lds_byte(wr * 64 + fr, fq * 8), boff = lds_byte(wc * 32 + fr, fq * 8);
#define PG8_SA(b, h) (((b) * 2 + (h)) * HTB)
#define PG8_SB(b, h) ((4 + (b) * 2 + (h)) * HTB)
#define PG8_STAGE(bufoff, gbase, voff) do { _Pragma("unroll") for (int _i = 0; _i < 2; ++_i) \
        __builtin_amdgcn_global_load_lds((const unsigned*)((const char*)(gbase) + (voff)[_i]), (PG8_LAS unsigned*)(lds + (bufoff) + ldsw + _i * 8192), 16, 0, 0); } while (0)
#define PG8_LDA(dst, b, h) do { _Pragma("unroll") for (int m = 0; m < 4; ++m) _Pragma("unroll") for (int k = 0; k < 2; ++k) dst[m][k] = *(const PG8_LAS bf16x8*)(lds + PG8_SA(b, h) + aoff + m * 2048 + k * 1024); } while (0)
#define PG8_LDB(dst, b, h) do { _Pragma("unroll") for (int n = 0; n < 2; ++n) _Pragma("unroll") for (int k = 0; k < 2; ++k) dst[n][k] = *(const PG8_LAS bf16x8*)(lds + PG8_SB(b, h) + boff + n * 2048 + k * 1024); } while (0)
#define PG8_MMA(ai, bj, At, Bt) do { __builtin_amdgcn_s_setprio(1); _Pragma("unroll") for (int m = 0; m < 4; ++m) _Pragma("unroll") for (int n = 0; n < 2; ++n) _Pragma("unroll") for (int k = 0; k < 2; ++k) \
        acc[ai][bj][m][n] = mfma16<Epi::F16>(Bt[n][k], At[m][k], acc[ai][bj][m][n]); __builtin_amdgcn_s_setprio(0); } while (0)
#define PG8_WAIT_V(n) asm volatile("s_waitcnt vmcnt(" #n ")" ::: "memory")
#define PG8_WAIT_L(n) asm volatile("s_waitcnt lgkmcnt(" #n ")" ::: "memory")
#define PG8_BAR __builtin_amdgcn_s_barrier()
#define PG8_SCHED __builtin_amdgcn_sched_barrier(0)
    Unit cur, nxt; int ui = 0;
    if (!S.next(0, cur)) return;
    f32x4 acc[2][2][4][2];
#pragma unroll
    for (int a = 0; a < 2; ++a)
#pragma unroll
        for (int b = 0; b < 2; ++b)
#pragma unroll
            for (int m = 0; m < 4; ++m)
#pragma unroll
                for (int n = 0; n < 2; ++n) acc[a][b][m][n] = (f32x4){0.f, 0.f, 0.f, 0.f};
    bf16x8 At[4][2], B0[2][2], B1[2][2];
    const char* cA = (const char*)g.A + (size_t)cur.pm * tstep; const char* cB = (const char*)g.Bt + (size_t)cur.pn * tstep;
    S.a_ready(cur);
    if constexpr (SP2) {
        PG8_STAGE(PG8_SB(0, 0), cB, voffB); PG8_STAGE(PG8_SB(0, 1), cB + hstep, voffB); PG8_STAGE(PG8_SA(0, 0), cA, voffA); PG8_STAGE(PG8_SA(0, 1), cA + hstep, voffA);
        if (wr == 1) PG8_BAR;
        PG8_WAIT_V(2); PG8_BAR;
        PG8_STAGE(PG8_SB(1, 0), cB + kstep, voffB); PG8_STAGE(PG8_SA(1, 0), cA + kstep, voffA); PG8_STAGE(PG8_SB(1, 1), cB + hstep + kstep, voffB);
        PG8_WAIT_V(6); PG8_BAR;
    } else {
        PG8_STAGE(PG8_SB(0, 0), cB, voffB); PG8_STAGE(PG8_SA(0, 0), cA, voffA); PG8_STAGE(PG8_SB(0, 1), cB + hstep, voffB); PG8_STAGE(PG8_SA(0, 1), cA + hstep, voffA);
        if (wr == 1) PG8_BAR;
        PG8_WAIT_V(4); PG8_BAR;
        PG8_STAGE(PG8_SB(1, 0), cB + kstep, voffB); PG8_STAGE(PG8_SA(1, 0), cA + kstep, voffA); PG8_STAGE(PG8_SB(1, 1), cB + hstep + kstep, voffB);
        PG8_WAIT_V(6); PG8_BAR;
    }
    for (;;) {
        const bool has_next = S.next(ui + 1, nxt);
        PG8_LAS unsigned char* const pfa = lds + PF_OFF + (ui & 1) * PF_BYTES;
        if constexpr (Epi::HAS_PRE) E.prefetch(cur, pfa, wid, lane);
        const char* nA = has_next ? (const char*)g.A + (size_t)nxt.pm * tstep : cA; const char* nB = has_next ? (const char*)g.Bt + (size_t)nxt.pn * tstep : cB;
        for (int t = 0; t < nt; t += 2) {
            const bool last = (t == nt - 2);
            const char* a1 = cA + (size_t)(t + 1) * kstep;
            const char* a2 = last ? nA : cA + (size_t)(t + 2) * kstep; const char* b2 = last ? nB : cB + (size_t)(t + 2) * kstep;
            const char* a3 = a2 + kstep; const char* b3 = b2 + kstep;
            if (last && has_next) S.a_ready(nxt);
            if constexpr (SP2) {
            PG8_LDB(B0, 0, 0); PG8_LDB(B1, 0, 1); PG8_SCHED; PG8_LDA(At, 0, 0); PG8_STAGE(PG8_SA(1, 1), a1 + hstep, voffA);
            PG8_WAIT_V(8); PG8_WAIT_L(0); PG8_BAR; PG8_MMA(0, 0, At, B0); PG8_MMA(0, 1, At, B1); PG8_BAR; PG8_SCHED;
            PG8_LDA(At, 0, 1); PG8_STAGE(PG8_SB(0, 0), b2, voffB); PG8_STAGE(PG8_SB(0, 1), b2 + hstep, voffB); PG8_STAGE(PG8_SA(0, 0), a2, voffA);
            PG8_WAIT_V(8); PG8_WAIT_L(0); PG8_BAR; PG8_MMA(1, 0, At, B0); PG8_MMA(1, 1, At, B1); PG8_BAR; PG8_SCHED;
            PG8_LDB(B0, 1, 0); PG8_LDB(B1, 1, 1); PG8_SCHED; PG8_LDA(At, 1, 0); PG8_STAGE(PG8_SA(0, 1), a2 + hstep, voffA);
            PG8_WAIT_V(8); PG8_WAIT_L(0); PG8_BAR; PG8_MMA(0, 0, At, B0); PG8_MMA(0, 1, At, B1); PG8_BAR; PG8_SCHED;
            PG8_LDA(At, 1, 1); PG8_STAGE(PG8_SB(1, 0), b3, voffB); PG8_STAGE(PG8_SB(1, 1), b3 + hstep, voffB); PG8_STAGE(PG8_SA(1, 0), a3, voffA);
            PG8_WAIT_V(8); PG8_WAIT_L(0); PG8_BAR; PG8_MMA(1, 0, At, B0); PG8_MMA(1, 1, At, B1); PG8_BAR; PG8_SCHED;
            } else {
            PG8_LDB(B0, 0, 0); PG8_SCHED; PG8_LDA(At, 0, 0); PG8_STAGE(PG8_SA(1, 1), a1 + hstep, voffA);
            PG8_WAIT_L(8); PG8_BAR; PG8_WAIT_L(0); PG8_MMA(0, 0, At, B0); PG8_BAR; PG8_SCHED;
            PG8_LDB(B1, 0, 1); PG8_STAGE(PG8_SB(0, 0), b2, voffB);
            PG8_BAR; PG8_WAIT_L(0); PG8_MMA(0, 1, At, B1); PG8_BAR;
            PG8_LDA(At, 0, 1); PG8_STAGE(PG8_SA(0, 0), a2, voffA);
            PG8_BAR; PG8_WAIT_L(0); PG8_MMA(1, 0, At, B0); PG8_BAR; PG8_SCHED;
            PG8_STAGE(PG8_SB(0, 1), b2 + hstep, voffB);
            PG8_WAIT_V(6); PG8_BAR; PG8_MMA(1, 1, At, B1); PG8_BAR;
            PG8_LDB(B0, 1, 0); PG8_SCHED; PG8_LDA(At, 1, 0); PG8_STAGE(PG8_SA(0, 1), a2 + hstep, voffA);
            PG8_WAIT_L(8); PG8_BAR; PG8_WAIT_L(0); PG8_MMA(0, 0, At, B0); PG8_BAR; PG8_SCHED;
            PG8_LDB(B1, 1, 1); PG8_STAGE(PG8_SB(1, 0), b3, voffB);
            PG8_BAR; PG8_WAIT_L(0); PG8_MMA(0, 1, At, B1); PG8_BAR;
            PG8_LDA(At, 1, 1); PG8_STAGE(PG8_SA(1, 0), a3, voffA);
            PG8_BAR; PG8_WAIT_L(0); PG8_MMA(1, 0, At, B0); PG8_BAR; PG8_SCHED;
            PG8_STAGE(PG8_SB(1, 1), b3 + hstep, voffB);
            PG8_WAIT_V(6); PG8_BAR; PG8_MMA(1, 1, At, B1); PG8_BAR;
            }
        }
        if constexpr (ALIGN_EPI) { if (wr == 0) PG8_BAR; }
        if constexpr (!Epi::AFTER_DRAIN) { if constexpr (Epi::HAS_PRE) E.pre(acc, cur, wr, wc, fr, fq, pfa); E(acc, cur, wr, wc, fr, fq); S.done(cur); }
        if (!has_next) break;
#pragma unroll
        for (int a = 0; a < 2; ++a)
#pragma unroll
            for (int b = 0; b < 2; ++b)
#pragma unroll
                for (int m = 0; m < 4; ++m)
#pragma unroll
                    for (int n = 0; n < 2; ++n) acc[a][b][m][n] = (f32x4){0.f, 0.f, 0.f, 0.f};
        cur = nxt; cA = nA; cB = nB; ++ui;
        if constexpr (ALIGN_EPI) { if (wr == 1) PG8_BAR; }
    }
    PG8_WAIT_V(0);
    if constexpr (!ALIGN_EPI) { if (wr == 0) PG8_BAR; }
    PG8_BAR;
    if constexpr (Epi::AFTER_DRAIN) { E.fused(acc, cur, wr, wc, fr, fq, lds, wid, lane); S.done(cur); }
#undef PG8_SA
#undef PG8_SB
#undef PG8_STAGE
#undef PG8_LDA
#undef PG8_LDB
#undef PG8_MMA
#undef PG8_WAIT_V
#undef PG8_WAIT_L
#undef PG8_BAR
#undef PG8_SCHED
}
}

constexpr int DM = 2048;
constexpr int T = 32768, TP = 16384;
constexpr int FFN = 5632;
constexpr float ALPHA = 1.6817928305074290f;
typedef unsigned short bf16;
typedef unsigned v4u __attribute__((ext_vector_type(4)));
typedef unsigned v2u __attribute__((ext_vector_type(2)));
typedef float f32x4 __attribute__((ext_vector_type(4)));
typedef float f32x16 __attribute__((ext_vector_type(16)));
typedef short bf16x8 __attribute__((ext_vector_type(8)));
typedef short s16x4 __attribute__((ext_vector_type(4)));

__device__ __forceinline__ int seq_pos(int r) { return r < TP ? (r & 8191) : (r & 2047); }
__device__ __forceinline__ unsigned pkbf(float lo, float hi) { return pg8::cvt_pk_bf16(lo, hi); }
__device__ __forceinline__ v4u pack8(f32x4 a, f32x4 b) { v4u w; w.x = pkbf(a[0], a[1]); w.y = pkbf(a[2], a[3]); w.z = pkbf(b[0], b[1]); w.w = pkbf(b[2], b[3]); return w; }
__device__ __forceinline__ float bf2f(unsigned short b) { return __builtin_bit_cast(float, (unsigned)b << 16); }
__device__ __forceinline__ float bflo(unsigned w) { return __builtin_bit_cast(float, w << 16); }
__device__ __forceinline__ float bfhi(unsigned w) { return __builtin_bit_cast(float, w & 0xffff0000u); }
typedef _Float16 h2_t __attribute__((ext_vector_type(2)));
typedef float f2_t __attribute__((ext_vector_type(2)));
__device__ __forceinline__ unsigned pkh(float a, float b) { const f2_t v = {a, b}; return __builtin_bit_cast(unsigned, __builtin_convertvector(v, h2_t)); }
__device__ __forceinline__ float hlo(unsigned w) { return (float)__builtin_bit_cast(h2_t, w).x; }
__device__ __forceinline__ float hhi(unsigned w) { return (float)__builtin_bit_cast(h2_t, w).y; }
typedef long long fx64;
__device__ __forceinline__ void fx_add(fx64* p, float v) { atomicAdd((unsigned long long*)p, (unsigned long long)(long long)(v * 4294967296.0f)); }
__device__ __forceinline__ float fx_val(fx64 x) { return (float)((double)x * (1.0 / 4294967296.0)); }
__device__ __forceinline__ float fx_load(const fx64* p) { return fx_val(__hip_atomic_load(p, __ATOMIC_RELAXED, __HIP_MEMORY_SCOPE_AGENT)); }

namespace pg8 {
struct LnCorr { const fx64* st; const float* cs; const float* b2; };
__device__ __forceinline__ void ln_prefetch(const LnCorr& L, const Unit& u, PG8_LAS unsigned char* pfa, int wid, int lane) {
    if (!L.st) return;
    if (wid < 4) __builtin_amdgcn_global_load_lds((const unsigned*)(L.st + 2 * (u.pm * BM + 64 * wid + lane)), (PG8_LAS unsigned*)(pfa + wid * 1024), 16, 0, 0);
    else if (wid < 6) { const float* v = (wid == 4 ? L.cs : L.b2) + u.pn * BM + 4 * lane; __builtin_amdgcn_global_load_lds((const unsigned*)v, (PG8_LAS unsigned*)(pfa + 4096 + (wid - 4) * 1024), 16, 0, 0); }
}
template <bool PERM, bool APERM = false> __device__ __forceinline__ void ln_correct(const LnCorr& L, f32x4 (&acc)[2][2][4][2], int wr, int wc, int fr, int fq, const PG8_LAS unsigned char* pfa) {
    if (!L.st) return;
    typedef long long ll2 __attribute__((ext_vector_type(2)));
    float rs[2][4], mr[2][4];
#pragma unroll
    for (int ai = 0; ai < 2; ++ai)
#pragma unroll
        for (int m = 0; m < 4; ++m) { const int lr = ai * HALF + wr * 64 + (APERM ? 4 * fr + m : m * 16 + fr);
            const ll2 sv = *(const PG8_LAS ll2*)(pfa + lr * 16);
            const float s1 = fx_val(sv.x), s2 = fx_val(sv.y);
            const float mu = s1 * (1.0f / DM), var = s2 * (1.0f / DM) - mu * mu; const float r_ = __builtin_amdgcn_rsqf(var + 1e-5f); rs[ai][m] = r_; mr[ai][m] = mu * r_; }
#pragma unroll
    for (int bj = 0; bj < 2; ++bj)
#pragma unroll
        for (int n = 0; n < 2; ++n) { const int lc = bj * HALF + wc * 32 + (PERM ? 8 * fq + 4 * n : 16 * n + 4 * fq);
            const f32x4 c4 = *(const PG8_LAS f32x4*)(pfa + 4096 + lc * 4), b4 = *(const PG8_LAS f32x4*)(pfa + 5120 + lc * 4);
#pragma unroll
            for (int ai = 0; ai < 2; ++ai)
#pragma unroll
                for (int m = 0; m < 4; ++m) acc[ai][bj][m][n] = acc[ai][bj][m][n] * rs[ai][m] - c4 * mr[ai][m] + b4; }
}
struct EpiRetIn {
    static constexpr bool PERM = true, AFTER_DRAIN = false, APERM = false, HAS_PRE = true, F16 = true;
    bf16_t *Q, *K, *V, *G; const float *cosT, *sinT; LnCorr lc;
    __device__ __forceinline__ void prefetch(const Unit& u, PG8_LAS unsigned char* pfa, int wid, int lane) const { ln_prefetch(lc, u, pfa, wid, lane); }
    __device__ __forceinline__ void pre(f32x4 (&acc)[2][2][4][2], const Unit& u, int wr, int wc, int fr, int fq, const PG8_LAS unsigned char* pfa) const { ln_correct<true>(lc, acc, wr, wc, fr, fq, pfa); }
    __device__ __forceinline__ void operator()(const f32x4 (&acc)[2][2][4][2], const Unit& u, int wr, int wc, int fr, int fq) const {
        const int row0 = u.pm * BM + wr * 64 + fr, cl = wc * 32 + 8 * fq;
        if (u.pn < 16) {
            bf16_t* base = (u.pn < 8 ? Q : K) + (size_t)(u.pn & 7) * 256 + cl;
#pragma unroll
            for (int ai = 0; ai < 2; ++ai)
#pragma unroll
                for (int m = 0; m < 4; ++m) {
                    const int r = row0 + ai * HALF + m * 16; const int pos = seq_pos(r);
                    const float* cp = cosT + (size_t)pos * 128 + cl; const float* sp = sinT + (size_t)pos * 128 + cl;
                    const f32x4 c0 = *(const f32x4*)cp, c1 = *(const f32x4*)(cp + 4), s0 = *(const f32x4*)sp, s1 = *(const f32x4*)(sp + 4);
                    const f32x4 x1a = acc[ai][0][m][0], x1b = acc[ai][0][m][1], x2a = acc[ai][1][m][0], x2b = acc[ai][1][m][1];
                    const f32x4 y1a = x1a * c0 - x2a * s0, y1b = x1b * c1 - x2b * s1, y2a = x1a * s0 + x2a * c0, y2b = x1b * s1 + x2b * c1;
                    bf16_t* rp = base + (size_t)r * 2048;
                    *(u32x4*)rp = pack8(y1a, y1b); *(u32x4*)(rp + 128) = pack8(y2a, y2b);
                    asm volatile("" ::: "memory"); }
        } else {
            bf16_t* base = (u.pn < 32 ? V + (size_t)(u.pn - 16) * 256 : G + (size_t)(u.pn - 32) * 256) + cl;
#pragma unroll
            for (int ai = 0; ai < 2; ++ai)
#pragma unroll
                for (int m = 0; m < 4; ++m) { bf16_t* rp = base + (size_t)(row0 + ai * HALF + m * 16) * 4096;
#pragma unroll
                    for (int bj = 0; bj < 2; ++bj) *(u32x4*)(rp + bj * HALF) = pack8(acc[ai][bj][m][0], acc[ai][bj][m][1]); }
        }
    }
};
struct EpiResid {
    static constexpr bool PERM = true, AFTER_DRAIN = false, APERM = false, HAS_PRE = true, F16 = false;
    bf16_t* XBs; float* Yf; fx64* st_new; const fx64* st_prev; const float* g; const float* b; const float* xin_p; const float* xin_s;
    __device__ __forceinline__ void prefetch(const Unit& u, PG8_LAS unsigned char* pfa, int wid, int lane) const { ln_prefetch(LnCorr{st_prev, g, b}, u, pfa, wid, lane); }
    __device__ __forceinline__ void operator()(const f32x4 (&acc)[2][2][4][2], const Unit& u, int wr, int wc, int fr, int fq) const {}
    __device__ __forceinline__ void pre(f32x4 (&acc)[2][2][4][2], const Unit& u, int wr, int wc, int fr, int fq, const PG8_LAS unsigned char* pfa) const {
        typedef long long ll2 __attribute__((ext_vector_type(2)));
        const int row0 = u.pm * BM + wr * 64 + fr, lc0 = wc * 32 + 8 * fq, col0 = u.pn * BM + lc0;
#pragma unroll
        for (int ai = 0; ai < 2; ++ai) {
            float mu[4], rs[4], s1[4], s2[4];
#pragma unroll
            for (int m = 0; m < 4; ++m) { s1[m] = 0.f; s2[m] = 0.f; mu[m] = 0.f; rs[m] = 1.f;
                if (st_prev) { const ll2 sv = *(const PG8_LAS ll2*)(pfa + (ai * HALF + wr * 64 + m * 16 + fr) * 16);
                    const float p1 = fx_val(sv.x), p2 = fx_val(sv.y); mu[m] = p1 * (1.0f / DM); const float var = p2 * (1.0f / DM) - mu[m] * mu[m]; rs[m] = __builtin_amdgcn_rsqf(var + 1e-5f); } }
#pragma unroll
            for (int bj = 0; bj < 2; ++bj) {
                f32x4 xv[4][2];
                if (!st_prev) {
#pragma unroll
                    for (int m = 0; m < 4; ++m) { const int r = row0 + ai * HALF + m * 16; const float* srcp = (r < TP ? xin_p + (size_t)r * DM : xin_s + (size_t)(r - TP) * DM) + col0 + bj * HALF;
                        xv[m][0] = *(const f32x4*)srcp; xv[m][1] = *(const f32x4*)(srcp + 4); }
                } else {
                    v4u w[4];
#pragma unroll
                    for (int m = 0; m < 4; ++m) w[m] = *(const v4u*)(XBs + (size_t)(row0 + ai * HALF + m * 16) * DM + col0 + bj * HALF);
                    const f32x4 g0 = *(const PG8_LAS f32x4*)(pfa + 4096 + (bj * HALF + lc0) * 4), g1 = *(const PG8_LAS f32x4*)(pfa + 4096 + (bj * HALF + lc0 + 4) * 4);
                    const f32x4 b0 = *(const PG8_LAS f32x4*)(pfa + 5120 + (bj * HALF + lc0) * 4), b1 = *(const PG8_LAS f32x4*)(pfa + 5120 + (bj * HALF + lc0 + 4) * 4);
#pragma unroll
                    for (int m = 0; m < 4; ++m) {
                        const f32x4 x0 = (f32x4){hlo(w[m].x), hhi(w[m].x), hlo(w[m].y), hhi(w[m].y)}, x1 = (f32x4){hlo(w[m].z), hhi(w[m].z), hlo(w[m].w), hhi(w[m].w)};
                        xv[m][0] = (x0 - mu[m]) * rs[m] * g0 + b0; xv[m][1] = (x1 - mu[m]) * rs[m] * g1 + b1; } }
#pragma unroll
                for (int m = 0; m < 4; ++m) { const int r = row0 + ai * HALF + m * 16;
                    const f32x4 y0 = xv[m][0] * ALPHA + acc[ai][bj][m][0], y1 = xv[m][1] * ALPHA + acc[ai][bj][m][1];
                    if (Yf) { float* yp = Yf + (size_t)r * DM + col0 + bj * HALF; *(f32x4*)yp = y0; *(f32x4*)(yp + 4) = y1; }
                    else { v4u w; w.x = pkh(y0[0], y0[1]); w.y = pkh(y0[2], y0[3]); w.z = pkh(y1[0], y1[1]); w.w = pkh(y1[2], y1[3]);
                        *(v4u*)(XBs + (size_t)r * DM + col0 + bj * HALF) = w;
                        const float a0 = hlo(w.x), a1 = hhi(w.x), a2 = hlo(w.y), a3 = hhi(w.y), a4 = hlo(w.z), a5 = hhi(w.z), a6 = hlo(w.w), a7 = hhi(w.w);
                        s1[m] += ((a0 + a1) + (a2 + a3)) + ((a4 + a5) + (a6 + a7)); s2[m] += ((a0 * a0 + a1 * a1) + (a2 * a2 + a3 * a3)) + ((a4 * a4 + a5 * a5) + (a6 * a6 + a7 * a7)); } }
                asm volatile("" ::: "memory"); }
            if (!Yf) {
#pragma unroll
                for (int m = 0; m < 4; ++m) { const int r = row0 + ai * HALF + m * 16; float t1 = s1[m], t2 = s2[m];
                    t1 += __shfl_xor(t1, 16); t1 += __shfl_xor(t1, 32); t2 += __shfl_xor(t2, 16); t2 += __shfl_xor(t2, 32);
                    if (fq == 0) { fx_add(st_new + 2 * r, t1); fx_add(st_new + 2 * r + 1, t2); } } }
        }
    }
};
struct EpiSplit {
    static constexpr bool PERM = true, AFTER_DRAIN = false, APERM = false, HAS_PRE = false, F16 = false;
    bf16_t *O0, *O1; int split, ldc;
    __device__ __forceinline__ void operator()(const f32x4 (&acc)[2][2][4][2], const Unit& u, int wr, int wc, int fr, int fq) const {
        const int row0 = u.pm * BM + wr * 64 + fr, cl = wc * 32 + 8 * fq;
        bf16_t* base = (u.pn < split ? O0 + (size_t)u.pn * 256 : O1 + (size_t)(u.pn - split) * 256) + cl;
#pragma unroll
        for (int ai = 0; ai < 2; ++ai)
#pragma unroll
            for (int m = 0; m < 4; ++m) { bf16_t* rp = base + (size_t)(row0 + ai * HALF + m * 16) * ldc;
#pragma unroll
                for (int bj = 0; bj < 2; ++bj) *(u32x4*)(rp + bj * HALF) = pack8(acc[ai][bj][m][0], acc[ai][bj][m][1]); }
    }
};
struct EpiMlaIn {
    static constexpr bool PERM = true, AFTER_DRAIN = false, APERM = false, HAS_PRE = true, F16 = true;
    bf16_t *CQ, *CKV, *KR; fx64 *ssq_q, *ssq_kv; const float *cosM, *sinM; LnCorr lc;
    __device__ __forceinline__ void prefetch(const Unit& u, PG8_LAS unsigned char* pfa, int wid, int lane) const { ln_prefetch(lc, u, pfa, wid, lane); }
    __device__ __forceinline__ void pre(f32x4 (&acc)[2][2][4][2], const Unit& u, int wr, int wc, int fr, int fq, const PG8_LAS unsigned char* pfa) const { ln_correct<true>(lc, acc, wr, wc, fr, fq, pfa); }
    __device__ __forceinline__ void operator()(const f32x4 (&acc)[2][2][4][2], const Unit& u, int wr, int wc, int fr, int fq) const {
        const int row0 = u.pm * BM + wr * 64 + fr, cl = wc * 32 + 8 * fq;
        if (u.pn < 8) {
            const bool isq = u.pn < 6; const int ldc = isq ? 1536 : 512;
            bf16_t* base = (isq ? CQ + (size_t)u.pn * 256 : CKV + (size_t)(u.pn - 6) * 256) + cl; fx64* ssq = isq ? ssq_q : ssq_kv;
#pragma unroll
            for (int ai = 0; ai < 2; ++ai)
#pragma unroll
                for (int m = 0; m < 4; ++m) { const int r = row0 + ai * HALF + m * 16; bf16_t* rp = base + (size_t)r * ldc; float s = 0.f;
#pragma unroll
                    for (int bj = 0; bj < 2; ++bj) { const f32x4 a = acc[ai][bj][m][0], b = acc[ai][bj][m][1];
                        s += (a[0] * a[0] + a[1] * a[1]) + (a[2] * a[2] + a[3] * a[3]) + (b[0] * b[0] + b[1] * b[1]) + (b[2] * b[2] + b[3] * b[3]);
                        *(u32x4*)(rp + bj * HALF) = pack8(a, b); }
                    s += __shfl_xor(s, 16); s += __shfl_xor(s, 32);
                    if (fq == 0) fx_add(ssq + r, s); }
        } else if (wc == 0) {
#pragma unroll
            for (int ai = 0; ai < 2; ++ai)
#pragma unroll
                for (int m = 0; m < 4; ++m) { const int r = row0 + ai * HALF + m * 16; const int pos = seq_pos(r);
                    const float* cp = cosM + (size_t)pos * 32 + 8 * fq; const float* sp = sinM + (size_t)pos * 32 + 8 * fq;
                    const f32x4 c0 = *(const f32x4*)cp, c1 = *(const f32x4*)(cp + 4), s0 = *(const f32x4*)sp, s1 = *(const f32x4*)(sp + 4);
                    const f32x4 x1a = acc[ai][0][m][0], x1b = acc[ai][0][m][1], x2a = acc[ai][1][m][0], x2b = acc[ai][1][m][1];
                    const f32x4 y1a = x1a * c0 - x2a * s0, y1b = x1b * c1 - x2b * s1, y2a = x1a * s0 + x2a * c0, y2b = x1b * s1 + x2b * c1;
                    bf16_t* rp = KR + (size_t)r * 64 + 8 * fq;
                    *(u32x4*)rp = pack8(y1a, y1b); *(u32x4*)(rp + 32) = pack8(y2a, y2b); }
        }
    }
};
struct EpiMlaUq {
    static constexpr bool PERM = true, AFTER_DRAIN = false, APERM = false, HAS_PRE = false, F16 = false;
    bf16_t* QA; const fx64* ssq_q; const float *cosM, *sinM;
    __device__ __forceinline__ void operator()(const f32x4 (&acc)[2][2][4][2], const Unit& u, int wr, int wc, int fr, int fq) const {
        const int row0 = u.pm * BM + wr * 64 + fr;
#pragma unroll
        for (int ai = 0; ai < 2; ++ai)
#pragma unroll
            for (int m = 0; m < 4; ++m) { const int r = row0 + ai * HALF + m * 16;
                const float ss = fx_load(ssq_q + r);
                const float rs = __builtin_amdgcn_rsqf(ss * (1.0f / 1536.0f) + 1e-6f);
                bf16_t* rp = QA + (size_t)r * 3072;
                if (u.pn < 8) {
#pragma unroll
                    for (int bj = 0; bj < 2; ++bj) *(u32x4*)(rp + (2 * u.pn + bj) * 192 + wc * 32 + 8 * fq) = pack8(acc[ai][bj][m][0] * rs, acc[ai][bj][m][1] * rs);
                } else {
                    const int head = 4 * (u.pn - 8) + wc; const int pos = seq_pos(r);
                    const float* cp = cosM + (size_t)pos * 32 + 8 * fq; const float* sp = sinM + (size_t)pos * 32 + 8 * fq;
                    const f32x4 c0 = *(const f32x4*)cp, c1 = *(const f32x4*)(cp + 4), s0 = *(const f32x4*)sp, s1 = *(const f32x4*)(sp + 4);
                    const f32x4 x1a = acc[ai][0][m][0] * rs, x1b = acc[ai][0][m][1] * rs, x2a = acc[ai][1][m][0] * rs, x2b = acc[ai][1][m][1] * rs;
                    const f32x4 y1a = x1a * c0 - x2a * s0, y1b = x1b * c1 - x2b * s1, y2a = x1a * s0 + x2a * c0, y2b = x1b * s1 + x2b * c1;
                    *(u32x4*)(rp + head * 192 + 128 + 8 * fq) = pack8(y1a, y1b); *(u32x4*)(rp + head * 192 + 160 + 8 * fq) = pack8(y2a, y2b);
                }
                asm volatile("" ::: "memory"); }
    }
};
struct EpiMlaUkv {
    static constexpr bool PERM = true, AFTER_DRAIN = false, APERM = false, HAS_PRE = false, F16 = false;
    bf16_t* KV; const fx64* ssq_kv;
    __device__ __forceinline__ void operator()(const f32x4 (&acc)[2][2][4][2], const Unit& u, int wr, int wc, int fr, int fq) const {
        const int row0 = u.pm * BM + wr * 64 + fr, cl = wc * 32 + 8 * fq;
#pragma unroll
        for (int ai = 0; ai < 2; ++ai)
#pragma unroll
            for (int m = 0; m < 4; ++m) { const int r = row0 + ai * HALF + m * 16;
                const float ss = fx_load(ssq_kv + r);
                const float rs = __builtin_amdgcn_rsqf(ss * (1.0f / 512.0f) + 1e-6f);
                bf16_t* rp = KV + (size_t)r * 4096 + (size_t)u.pn * 256 + cl;
#pragma unroll
                for (int bj = 0; bj < 2; ++bj) *(u32x4*)(rp + bj * HALF) = pack8(acc[ai][bj][m][0] * rs, acc[ai][bj][m][1] * rs); }
    }
};
#define DPP_ROR(x, n) __builtin_bit_cast(float, __builtin_amdgcn_update_dpp(0, __builtin_bit_cast(int, (float)(x)), 0x120 + (n), 0xf, 0xf, false))
struct EpiFfnUp {
    static constexpr bool PERM = true, AFTER_DRAIN = false, APERM = true, HAS_PRE = true, F16 = true;
    bf16_t *A, *EG, *EU; const float *cw, *cb; LnCorr lc;
    __device__ __forceinline__ void prefetch(const Unit& u, PG8_LAS unsigned char* pfa, int wid, int lane) const { ln_prefetch(lc, u, pfa, wid, lane); }
    __device__ __forceinline__ void pre(f32x4 (&acc)[2][2][4][2], const Unit& u, int wr, int wc, int fr, int fq, const PG8_LAS unsigned char* pfa) const { ln_correct<true, true>(lc, acc, wr, wc, fr, fq, pfa); }
    __device__ __forceinline__ void operator()(const f32x4 (&acc)[2][2][4][2], const Unit& u, int wr, int wc, int fr, int fq) const {
        const int ch0 = u.pn * 128 + wc * 32 + 8 * fq;
        f32x4 w0[2], w1[2], w2[2], bb[2];
#pragma unroll
        for (int n = 0; n < 2; ++n) { w0[n] = *(const f32x4*)(cw + ch0 + 4 * n); w1[n] = *(const f32x4*)(cw + FFN + ch0 + 4 * n); w2[n] = *(const f32x4*)(cw + 2 * FFN + ch0 + 4 * n); bb[n] = *(const f32x4*)(cb + ch0 + 4 * n); }
#pragma unroll
        for (int ai = 0; ai < 2; ++ai) {
            const int rblk = u.pm * BM + ai * HALF + wr * 64; const int blk = rblk >> 6;
            f32x4 P[2], Nx[2];
#pragma unroll
            for (int n = 0; n < 2; ++n)
#pragma unroll
                for (int e = 0; e < 4; ++e) { P[n][e] = DPP_ROR(acc[ai][1][3][n][e], 1); Nx[n][e] = DPP_ROR(acc[ai][1][0][n][e], 15); }
#pragma unroll
            for (int m = 0; m < 4; ++m) {
                f32x4 av[2];
#pragma unroll
                for (int n = 0; n < 2; ++n) {
                    const f32x4 gp = (m == 0) ? P[n] : acc[ai][1][m > 0 ? m - 1 : 0][n], gn = (m == 3) ? Nx[n] : acc[ai][1][m < 3 ? m + 1 : 3][n], gc = acc[ai][1][m][n];
                    f32x4 t = gp * w0[n] + gc * w1[n] + gn * w2[n] + bb[n];
#pragma unroll
                    for (int e = 0; e < 4; ++e) t[e] = t[e] * __builtin_amdgcn_rcpf(1.0f + __expf(-t[e]));
                    av[n] = t * acc[ai][0][m][n];
                }
                const int r = rblk + 4 * fr + m;
                const bool edge = (m == 0 && fr == 0) || (m == 3 && fr == 15);
                if (!edge) *(u32x4*)(A + (size_t)r * FFN + ch0) = pack8(av[0], av[1]);
                if (m < 2 && fr == 0) { *(u32x4*)(EG + ((size_t)blk * 4 + m) * FFN + ch0) = pack8(acc[ai][1][m][0], acc[ai][1][m][1]);
                    if (m == 0) *(u32x4*)(EU + ((size_t)blk * 2) * FFN + ch0) = pack8(acc[ai][0][0][0], acc[ai][0][0][1]); }
                if (m >= 2 && fr == 15) { *(u32x4*)(EG + ((size_t)blk * 4 + m) * FFN + ch0) = pack8(acc[ai][1][m][0], acc[ai][1][m][1]);
                    if (m == 3) *(u32x4*)(EU + ((size_t)blk * 2 + 1) * FFN + ch0) = pack8(acc[ai][0][3][0], acc[ai][0][3][1]); }
            }
        }
    }
};
}

typedef GAS unsigned gu32;
#define RLX_AGENT __ATOMIC_RELAXED, __HIP_MEMORY_SCOPE_AGENT
#define LDS_WAIT() asm volatile("s_waitcnt lgkmcnt(0)" ::: "memory")
#define VM_WAIT() asm volatile("s_waitcnt vmcnt(0)" ::: "memory")
#define SBAR() __builtin_amdgcn_sched_barrier(0)

#define XB_TMO      128
#define XB_XCNT(j)  (256  + 64 * (j))
#define XB_XSUB(j)  (1280 + 64 * (j))
#define XB_XGEN(j)  (2304 + 64 * (j))
#define XB_TOP      3328
#define XB_TOPGEN   3392
#define XCD_BAR_WORDS 3456
#define XB_SPIN_CAP (1u << 22)

__device__ __forceinline__ unsigned xb_ld(unsigned* p)              { return __hip_atomic_load(p, __ATOMIC_RELAXED, __HIP_MEMORY_SCOPE_AGENT); }
__device__ __forceinline__ unsigned xb_add(unsigned* p, unsigned v) { return __hip_atomic_fetch_add(p, v, __ATOMIC_RELAXED, __HIP_MEMORY_SCOPE_AGENT); }
__device__ __forceinline__ unsigned xb_xcc_id() { return (unsigned)__builtin_amdgcn_s_getreg((3 << 11) | 20) & 0xFu; }
#define XB_SPIN(cond, bar) do { unsigned _sp = 0; while (cond) { __builtin_amdgcn_s_sleep(1); \
    if ((++_sp & 255u) == 0u) { if (xb_ld(&(bar)[XB_TMO])) break; if (_sp > XB_SPIN_CAP) { atomicAdd(&(bar)[XB_TMO], 1u); break; } } } } while (0)

struct XcdBarrier {
    unsigned* bar; unsigned x;
    volatile LAS unsigned* st;
};

__device__ __forceinline__ XcdBarrier xcd_barrier_post(unsigned* bar, volatile LAS unsigned* st) {
    XcdBarrier b; b.bar = bar; b.x = xb_xcc_id(); b.st = st;
    if (threadIdx.x == 0) (void)xb_add(&bar[XB_XCNT(b.x)], 1u);
    return b;
}
__device__ __forceinline__ void xcd_barrier_complete(unsigned* bar, unsigned x, unsigned& nloc, unsigned& nx) {
    const unsigned G = gridDim.x * gridDim.y * gridDim.z;
    unsigned sum, cnt, mine, sp = 0u;
    for (;;) {
        sum = 0u; cnt = 0u; mine = 0u;
#pragma unroll
        for (unsigned j = 0; j < 16; ++j) { const unsigned c = xb_ld(&bar[XB_XCNT(j)]); sum += c; cnt += (c > 0u) ? 1u : 0u; mine = (j == x) ? c : mine; }
        if (sum == G) break;
        __builtin_amdgcn_s_sleep(1);
        if ((++sp & 255u) == 0u) { if (xb_ld(&bar[XB_TMO])) break; if (sp > XB_SPIN_CAP) { atomicAdd(&bar[XB_TMO], 1u); break; } }
    }
    nloc = mine > 0u ? mine : 1u; nx = cnt > 0u ? cnt : 1u;
}

__device__ __forceinline__ void xcd_barrier(const XcdBarrier& b) {
    asm volatile("s_waitcnt vmcnt(0)" ::: "memory");
    __syncthreads();
    if (threadIdx.x == 0) {
        unsigned* bar = b.bar;
        __builtin_amdgcn_s_waitcnt(0);
        unsigned nloc = b.st[0], nx = b.st[1];
        if (nloc == 0u) { xcd_barrier_complete(bar, b.x, nloc, nx); b.st[0] = nloc; b.st[1] = nx; }
        const unsigned old = xb_add(&bar[XB_XSUB(b.x)], 1u);
        const unsigned gen = old / nloc;
        if (old + 1u == (gen + 1u) * nloc) {
            __builtin_amdgcn_fence(__ATOMIC_RELEASE, "agent");
            asm volatile("s_waitcnt vmcnt(0)" ::: "memory");
            const unsigned og = xb_add(&bar[XB_TOP], 1u);
            const unsigned tg = og / nx;
            if (og + 1u == (tg + 1u) * nx) xb_add(&bar[XB_TOPGEN], 1u);
            else XB_SPIN(xb_ld(&bar[XB_TOPGEN]) == tg, bar);
            __builtin_amdgcn_fence(__ATOMIC_ACQUIRE, "agent");
            xb_add(&bar[XB_XGEN(b.x)], 1u);
            asm volatile("s_waitcnt vmcnt(0)" ::: "memory");
        } else {
            XB_SPIN(xb_ld(&bar[XB_XGEN(b.x)]) == gen, bar);
            __builtin_amdgcn_fence(__ATOMIC_ACQUIRE, "agent");
            asm volatile("s_waitcnt vmcnt(0)" ::: "memory");
        }
    }
    __syncthreads();
}


constexpr size_t MiB = 1u << 20;
constexpr size_t WS_CTL = 0, CTL_ZERO_BYTES = 8 * MiB;
constexpr int    CW_BAR = 4096;
constexpr size_t CTL_SSQ = 1 * MiB;
constexpr size_t CTL_LGTAB = 64 * 1024;
constexpr size_t CTL_STATS = 2 * MiB;
constexpr size_t CTL_CSB2 = 6 * MiB;
constexpr size_t CTL_CSF = 8 * MiB;
constexpr size_t WS_TAB = 9 * MiB;
constexpr size_t WS_W = 19 * MiB;
constexpr size_t WS_XB = 149 * MiB;
constexpr size_t WS_WD2 = 277 * MiB;
constexpr size_t WS_ACT = 357 * MiB;
constexpr size_t WS_END = WS_ACT + 1024 * MiB;
constexpr size_t W_RET_OUT = 0, W_UP = 16 * MiB, W_DOWN = 60 * MiB, W_RET_IN = 82 * MiB;
constexpr size_t W_MLA_OUT = 0, W_MLA_IN = 82 * MiB, W_MLA_UQ = 92 * MiB, W_MLA_UKV = 102 * MiB;
constexpr size_t A_RQ = 0, A_RK = 128 * MiB, A_RV = 256 * MiB, A_RG = 512 * MiB, A_RO = 768 * MiB;
constexpr size_t A_FU = 0, A_FG = 352 * MiB;
constexpr size_t A_MCQ = 0, A_MCKV = 96 * MiB, A_MKR = 128 * MiB, A_MQA = 132 * MiB, A_MKV = 324 * MiB, A_MO = 580 * MiB;

constexpr int RING_OFF = 0, RING_BYTES = 159744;
constexpr int LDSCTL_OFF = RING_BYTES, MISC_OFF = LDSCTL_OFF + 320;
constexpr int LDS_BYTES = 163840;
constexpr int NWAVES = 8;


struct Frame {
    LAS unsigned char* lds;
    int wave;
    int vcu, G;
    int gw, NGW;
};

#define PHASE_TID(tid, lane) int tid = threadIdx.x; asm volatile("" : "+v"(tid)); const int lane = tid & 63; int gw_ = F.gw; asm volatile("" : "+s"(gw_)); const int gw = gw_, NGW = 2048; (void)gw; (void)NGW

__device__ __forceinline__ float wave_sum(float v) {
#pragma unroll
    for (int o = 1; o < 64; o <<= 1) v += __shfl_xor(v, o);
    return v;
}

__device__ __forceinline__ void tr_item(const float* __restrict__ W, int K, int N, bf16* WT, int k0, int n0, int drow0, float sc, const float* __restrict__ ks, const float* __restrict__ bln, fx64* csp, fx64* b2p, bool f16, LAS float* scr, int lane) {
    float pc = 0.f, pb = 0.f;
#pragma unroll 8
    for (int i = 0; i < 32; ++i) { const int kk = 2 * i + (lane >> 5); const float w = W[(size_t)(k0 + kk) * N + n0 + (lane & 31)] * sc; float v = w; if (ks) v *= ks[k0 + kk]; scr[kk * 33 + (lane & 31)] = v;
        if (csp) { pc += v; pb += w * bln[k0 + kk]; } }
    if (csp) {
        pc += __shfl_xor(pc, 32); pb += __shfl_xor(pb, 32);
        if (lane < 32) { fx_add(csp + drow0 + lane, pc); fx_add(b2p + drow0 + lane, pb); } }
    LDS_WAIT(); asm volatile("" ::: "memory");
    const int c = lane & 7;
#pragma unroll
    for (int j = 0; j < 4; ++j) { const int n = (lane >> 3) + 8 * j; const LAS float* s = scr + (8 * c) * 33 + n;
        v4u o;
        if (f16) { o.x = pkh(s[0 * 33], s[1 * 33]); o.y = pkh(s[2 * 33], s[3 * 33]); o.z = pkh(s[4 * 33], s[5 * 33]); o.w = pkh(s[6 * 33], s[7 * 33]); }
        else { o.x = pkbf(s[0 * 33], s[1 * 33]); o.y = pkbf(s[2 * 33], s[3 * 33]); o.z = pkbf(s[4 * 33], s[5 * 33]); o.w = pkbf(s[6 * 33], s[7 * 33]); }
        *(GAS v4u*)(WT + (size_t)(drow0 + n) * K + k0 + 8 * c) = o; }
    LDS_WAIT(); asm volatile("" ::: "memory");
}
__device__ __forceinline__ int rowmap_mla_in(int nb) { return nb < 64 ? 32 * nb : (nb == 64 ? 2048 : 2048 + 128); }
__device__ __forceinline__ int rowmap_uq(int nb) { const int head = nb / 6, w = nb % 6; return w < 4 ? head * 128 + 32 * w : 2048 + (head >> 2) * 256 + (w == 5 ? 128 : 0) + (head & 3) * 32; }

__device__ __forceinline__ void convert_matrix(const Frame& F, const float* W, int K, int N, bf16* WT, int mode, float sc, const float* ks, const float* bln, fx64* csb, LAS float* scr) {
    PHASE_TID(tid, lane); (void)tid;
    const int nblk = N / 32, nitems = (K / 64) * nblk;
    const bool f16 = (mode == 1 || mode == 2 || mode == 4);
    for (int it = gw; it < nitems; it += NGW) {
        const int kb = it / nblk, nb = it % nblk;
        int drow = 32 * nb; float s = sc;
        if (mode == 1) { if (nb >= 64 && nb < 128) s = 0.0625f; }
        else if (mode == 2) drow = rowmap_mla_in(nb);
        else if (mode == 3) drow = rowmap_uq(nb);
        else if (mode == 4) drow = nb < 176 ? (nb >> 2) * 256 + 32 * (nb & 3) : ((nb - 176) >> 2) * 256 + 128 + 32 * ((nb - 176) & 3);
        tr_item(W, K, N, WT, 64 * kb, 32 * nb, drow, s, ks, bln, csb, csb + 16384, f16, scr, lane);
    }
}

__device__ __forceinline__ void csb2_finalize(const Frame& F, const fx64* src, float* dst, int n) {
    PHASE_TID(tid, lane); (void)tid;
    for (int i = gw * 64 + lane; i < n; i += NGW * 64) dst[i] = fx_load(src + i);
}

__device__ __forceinline__ void ln_pass(const Frame& F, float* Y, bf16* XB, float* stats, const float* __restrict__ g, const float* __restrict__ b, bool final) {
    PHASE_TID(tid, lane); (void)tid;
    for (int m = gw; m < T; m += NGW) {
        GAS f32x4* xr = (GAS f32x4*)(Y + (size_t)m * DM) + lane;
        f32x4 v[8]; float s = 0.f;
#pragma unroll
        for (int j = 0; j < 8; ++j) { v[j] = xr[64 * j]; s += (v[j].x + v[j].y) + (v[j].z + v[j].w); }
        const float mean = wave_sum(s) * (1.f / DM); float s2 = 0.f;
#pragma unroll
        for (int j = 0; j < 8; ++j) { v[j] = v[j] - mean; s2 += (v[j].x * v[j].x + v[j].y * v[j].y) + (v[j].z * v[j].z + v[j].w * v[j].w); }
        const float rstd = 1.0f / sqrtf(wave_sum(s2) * (1.f / DM) + 1e-5f);
        GAS v2u* o8 = (GAS v2u*)(XB + (size_t)m * DM) + lane;
        if (!final && lane == 0) { stats[2 * m] = mean; stats[2 * m + 1] = rstd; }
#pragma unroll
        for (int j = 0; j < 8; ++j) { const f32x4 gg = *((const f32x4*)g + 64 * j + lane), bb = *((const f32x4*)b + 64 * j + lane);
            const f32x4 y = v[j] * rstd * gg + bb;
            if (final) xr[64 * j] = y; else { v2u w; w.x = pkbf(y.x, y.y); w.y = pkbf(y.z, y.w); o8[64 * j] = w; } }
    }
}

__device__ __forceinline__ void gate_pass(const Frame& F, const bf16* O, const bf16* OB, bf16* G, bf16* D) {
    PHASE_TID(tid, lane); (void)tid;
    for (int m = gw; m < T; m += NGW) {
        const GAS v4u* orow = (const GAS v4u*)(O + (size_t)m * 4096) + lane; const GAS v4u* brow = (const GAS v4u*)(OB + (size_t)m * 4096) + lane; GAS v4u* grow = (GAS v4u*)(G + (size_t)m * 4096) + lane; GAS v4u* drow = (GAS v4u*)(D + (size_t)m * 4096) + lane;
#pragma unroll
        for (int hp = 0; hp < 8; hp += 4) {
            v4u ov[4], bv[4], gv[4];
#pragma unroll
            for (int h = 0; h < 4; ++h) { ov[h] = orow[64 * (hp + h)]; bv[h] = brow[64 * (hp + h)]; gv[h] = grow[64 * (hp + h)]; }
#pragma unroll
            for (int h = 0; h < 4; ++h) {
                float x[8]; x[0] = bflo(ov[h].x) + bflo(bv[h].x); x[1] = bfhi(ov[h].x) + bfhi(bv[h].x); x[2] = bflo(ov[h].y) + bflo(bv[h].y); x[3] = bfhi(ov[h].y) + bfhi(bv[h].y);
                x[4] = bflo(ov[h].z) + bflo(bv[h].z); x[5] = bfhi(ov[h].z) + bfhi(bv[h].z); x[6] = bflo(ov[h].w) + bflo(bv[h].w); x[7] = bfhi(ov[h].w) + bfhi(bv[h].w);
                float gt[8]; gt[0] = bflo(gv[h].x); gt[1] = bfhi(gv[h].x); gt[2] = bflo(gv[h].y); gt[3] = bfhi(gv[h].y); gt[4] = bflo(gv[h].z); gt[5] = bfhi(gv[h].z); gt[6] = bflo(gv[h].w); gt[7] = bfhi(gv[h].w);
                float s = 0.f;
#pragma unroll
                for (int e = 0; e < 8; ++e) s += x[e];
                const float mean = wave_sum(s) * (1.f / 512.f); float s2 = 0.f;
#pragma unroll
                for (int e = 0; e < 8; ++e) { x[e] -= mean; s2 += x[e] * x[e]; }
                const float rstd = __builtin_amdgcn_rsqf(wave_sum(s2) * (1.f / 512.f) + 1e-6f);
                float y[8];
#pragma unroll
                for (int e = 0; e < 8; ++e) { const float sg = gt[e] * __builtin_amdgcn_rcpf(1.0f + __expf(-gt[e])); y[e] = sg * x[e] * rstd; }
                v4u w; w.x = pkbf(y[0], y[1]); w.y = pkbf(y[2], y[3]); w.z = pkbf(y[4], y[5]); w.w = pkbf(y[6], y[7]);
                drow[64 * (hp + h)] = w;
            }
        }
    }
}

__device__ __forceinline__ void conv_pass(const Frame& F, bf16* U, const bf16* G, const float* __restrict__ cw, const float* __restrict__ cb) {
    PHASE_TID(tid, lane); (void)tid;
    constexpr int NCB = FFN / 512, NTB = T / 32;
    for (int it = gw; it < NCB * NTB; it += NGW) {
        const int cbk = it % NCB, tb = it / NCB; const int c0 = cbk * 512 + lane * 8, t0 = tb * 32;
        float w0[8], w1[8], w2[8], bb[8];
#pragma unroll
        for (int e = 0; e < 8; ++e) { w0[e] = cw[c0 + e]; w1[e] = cw[FFN + c0 + e]; w2[e] = cw[2 * FFN + c0 + e]; bb[e] = cb[c0 + e]; }
        const int p0 = seq_pos(t0), L = t0 < TP ? 8192 : 2048;
        const GAS v4u* gp = (const GAS v4u*)(G + (size_t)t0 * FFN + c0); GAS v4u* up = (GAS v4u*)(U + (size_t)t0 * FFN + c0);
        constexpr int RS = FFN / 8;
        const float fprev = p0 > 0 ? 1.f : 0.f;
        v4u prev = gp[p0 > 0 ? -RS : 0], cur = gp[0];
#pragma unroll 4
        for (int t = 0; t < 32; ++t) {
            const bool has_n = (p0 + t + 1 < L); const float fnext = has_n ? 1.f : 0.f; const float fp = (t == 0) ? fprev : 1.f;
            const v4u nxt = gp[(size_t)(has_n ? t + 1 : t) * RS]; const v4u uu = up[(size_t)t * RS];
            float a[8], c[8], n[8], u8[8], y[8];
            a[0] = bflo(prev.x); a[1] = bfhi(prev.x); a[2] = bflo(prev.y); a[3] = bfhi(prev.y); a[4] = bflo(prev.z); a[5] = bfhi(prev.z); a[6] = bflo(prev.w); a[7] = bfhi(prev.w);
            c[0] = bflo(cur.x); c[1] = bfhi(cur.x); c[2] = bflo(cur.y); c[3] = bfhi(cur.y); c[4] = bflo(cur.z); c[5] = bfhi(cur.z); c[6] = bflo(cur.w); c[7] = bfhi(cur.w);
            n[0] = bflo(nxt.x); n[1] = bfhi(nxt.x); n[2] = bflo(nxt.y); n[3] = bfhi(nxt.y); n[4] = bflo(nxt.z); n[5] = bfhi(nxt.z); n[6] = bflo(nxt.w); n[7] = bfhi(nxt.w);
            u8[0] = bflo(uu.x); u8[1] = bfhi(uu.x); u8[2] = bflo(uu.y); u8[3] = bfhi(uu.y); u8[4] = bflo(uu.z); u8[5] = bfhi(uu.z); u8[6] = bflo(uu.w); u8[7] = bfhi(uu.w);
#pragma unroll
            for (int e = 0; e < 8; ++e) { const float gcv = fp * a[e] * w0[e] + c[e] * w1[e] + fnext * n[e] * w2[e] + bb[e]; y[e] = gcv * __builtin_amdgcn_rcpf(1.0f + __expf(-gcv)) * u8[e]; }
            v4u w; w.x = pkbf(y[0], y[1]); w.y = pkbf(y[2], y[3]); w.z = pkbf(y[4], y[5]); w.w = pkbf(y[6], y[7]);
            up[(size_t)t * RS] = w; prev = cur; cur = nxt;
        }
    }
}


__device__ __forceinline__ void ffn_fixup(const Frame& F, bf16* A, const bf16* EG, const bf16* EU, const float* __restrict__ cw, const float* __restrict__ cb) {
    PHASE_TID(tid, lane); (void)tid;
    constexpr int NCB = FFN / 512, NER = (T / 64) * 2;
    for (int it = gw; it < NCB * NER; it += NGW) {
        const int cbk = it % NCB, er = it / NCB, blk = er >> 1, last = er & 1; const int c0 = cbk * 512 + lane * 8;
        const int r = blk * 64 + (last ? 63 : 0); const int pos = seq_pos(r), L = r < TP ? 8192 : 2048;
        const bool hasp = pos > 0, hasn = pos < L - 1;
        const size_t ip = last ? (size_t)blk * 4 + 2 : (hasp ? (size_t)(blk - 1) * 4 + 3 : (size_t)blk * 4);
        const size_t ic = last ? (size_t)blk * 4 + 3 : (size_t)blk * 4;
        const size_t in = last ? (hasn ? (size_t)(blk + 1) * 4 : (size_t)blk * 4 + 3) : (size_t)blk * 4 + 1;
        const float fp = (last || hasp) ? 1.f : 0.f, fn = (!last || hasn) ? 1.f : 0.f;
        const v4u gp = *(const GAS v4u*)(EG + ip * FFN + c0), gc = *(const GAS v4u*)(EG + ic * FFN + c0), gn = *(const GAS v4u*)(EG + in * FFN + c0);
        const v4u uu = *(const GAS v4u*)(EU + ((size_t)blk * 2 + last) * FFN + c0);
        float a[8], c[8], n[8], u8[8], y[8];
        a[0] = bflo(gp.x); a[1] = bfhi(gp.x); a[2] = bflo(gp.y); a[3] = bfhi(gp.y); a[4] = bflo(gp.z); a[5] = bfhi(gp.z); a[6] = bflo(gp.w); a[7] = bfhi(gp.w);
        c[0] = bflo(gc.x); c[1] = bfhi(gc.x); c[2] = bflo(gc.y); c[3] = bfhi(gc.y); c[4] = bflo(gc.z); c[5] = bfhi(gc.z); c[6] = bflo(gc.w); c[7] = bfhi(gc.w);
        n[0] = bflo(gn.x); n[1] = bfhi(gn.x); n[2] = bflo(gn.y); n[3] = bfhi(gn.y); n[4] = bflo(gn.z); n[5] = bfhi(gn.z); n[6] = bflo(gn.w); n[7] = bfhi(gn.w);
        u8[0] = bflo(uu.x); u8[1] = bfhi(uu.x); u8[2] = bflo(uu.y); u8[3] = bfhi(uu.y); u8[4] = bflo(uu.z); u8[5] = bfhi(uu.z); u8[6] = bflo(uu.w); u8[7] = bfhi(uu.w);
#pragma unroll
        for (int e = 0; e < 8; ++e) { const float gcv = fp * a[e] * cw[c0 + e] + c[e] * cw[FFN + c0 + e] + fn * n[e] * cw[2 * FFN + c0 + e] + cb[c0 + e]; y[e] = gcv * __builtin_amdgcn_rcpf(1.0f + __expf(-gcv)) * u8[e]; }
        v4u w; w.x = pkbf(y[0], y[1]); w.y = pkbf(y[2], y[3]); w.z = pkbf(y[4], y[5]); w.w = pkbf(y[6], y[7]);
        *(GAS v4u*)(A + (size_t)r * FFN + c0) = w;
    }
}

__device__ __forceinline__ float log2_sigmoid(float x) { return (float)(-log1p(exp(-(double)x)) * 1.4426950408889634); }
__device__ __forceinline__ void prologue(const Frame& F, const float* xp, const float* xs, float* X, bf16* XB, float* cosR, float* sinR, float* cosM, float* sinM, const float* dfw, const float* dbw, float* lgtab) {
    PHASE_TID(tid, lane); (void)tid;
    if (gw == 0 && lane < 32) { const int jl = lane >> 4, head = (lane >> 1) & 7; lgtab[lane] = log2_sigmoid((lane & 1) ? dbw[jl * 8 + head] : dfw[jl * 8 + head]); }
    const int gt = gw * 64 + lane, NGT = NGW * 64;
    for (int i = gt; i < 8192 * 128; i += NGT) { const int pos = i >> 7, d = i & 127;
        const float e = (float)d * (2.0f / 256.0f); const float inv = 1.0f / powf(10000.0f, e); const float ang = (float)pos * inv;
        cosR[i] = cosf(ang); sinR[i] = sinf(ang); }
    for (int i = gt; i < 8192 * 32; i += NGT) { const int pos = i >> 5, d = i & 31;
        const float e = (float)d * (2.0f / 64.0f); const float inv = 1.0f / powf(10000.0f, e); const float ang = (float)pos * inv;
        cosM[i] = cosf(ang); sinM[i] = sinf(ang); }
    for (int m = gw; m < T; m += NGW) {
        const GAS f32x4* src = (const GAS f32x4*)((m < TP ? xp + (size_t)m * DM : xs + (size_t)(m - TP) * DM)) + lane;
        GAS v2u* o8 = (GAS v2u*)(XB + (size_t)m * DM) + lane;
#pragma unroll
        for (int j = 0; j < 8; ++j) { const f32x4 v = src[64 * j]; v2u w; w.x = pkh(v.x, v.y); w.y = pkh(v.z, v.w); o8[64 * j] = w; }
    }
}

#ifndef RETD
#define RETD 0
#endif
namespace ret {
constexpr int C = 64, W = 128, LQ = 264, LV = 136, LP = 72;
constexpr int OFF_Q = 0, OFF_K = 33792, OFF_V = 67584, OFF_VZ = 84992, OFF_P = 102400, OFF_OS = 111616, LDS_END = 129024;
static_assert(LDS_END <= RING_BYTES, "retention LDS");
typedef float f4 __attribute__((ext_vector_type(4)));
typedef float f2v __attribute__((ext_vector_type(2)));
typedef __bf16 b2v __attribute__((ext_vector_type(2)));
__device__ __forceinline__ unsigned pkbf_c(float lo, float hi) { const f2v v = {lo, hi}; return __builtin_bit_cast(unsigned, __builtin_convertvector(v, b2v)); }

__device__ __forceinline__ bf16x8 frag_rm(const LAS unsigned char* lds, int off, int ld, int r0, int k0, int lane) {
    return *(const LAS bf16x8*)(lds + off + ((r0 + (lane & 15)) * ld + k0 + 8 * (lane >> 4)) * 2);
}
template <int LDB, int K0, int R0> __device__ __forceinline__ void frag_tr_issue(s16x4& lo, s16x4& hi, unsigned base) {
    asm volatile("ds_read_b64_tr_b16 %0, %1 offset:%2" : "=&v"(lo) : "v"(base), "i"(K0 * LDB + R0 * 2) : "memory");
    asm volatile("ds_read_b64_tr_b16 %0, %1 offset:%2" : "=&v"(hi) : "v"(base), "i"(K0 * LDB + R0 * 2 + 4 * LDB) : "memory");
}
#define RET_PK(L, H) (bf16x8){L[0], L[1], L[2], L[3], H[0], H[1], H[2], H[3]}
#define MFMA16(a, b, c) __builtin_amdgcn_mfma_f32_16x16x32_bf16(a, b, c, 0, 0, 0)
#define RET_LWAIT() asm volatile("s_waitcnt lgkmcnt(0)" ::: "memory")

struct Stg { v4u q[4], k[4], v[2]; };

template <bool FWD>
__device__ __forceinline__ void sweep(const Frame& F, const bf16* Qg, const bf16* Kg, const bf16* Vg, bf16* Og, int nchunks, float lgf, float lgb) {
    LAS unsigned char* lds = F.lds + RING_OFF;
    int tid_l = threadIdx.x; asm volatile("" : "+v"(tid_l));
    const int tid = tid_l, lane = tid & 63, wid = __builtin_amdgcn_readfirstlane(tid >> 6), g = lane >> 4, i = lane & 15;
    const int nb = wid >> 1, cb = wid & 1;
    const int dvw = 16 * wid;
    const float lg = FWD ? lgf : lgb;
    const float gch = __builtin_amdgcn_exp2f(lg * (float)C);
    const int vrow = tid >> 4, vch = tid & 15;
    const float zeta0 = __builtin_amdgcn_exp2f(lg * (FWD ? (float)(C - 1 - vrow) : (float)vrow));
    const float zeta1 = __builtin_amdgcn_exp2f(lg * (FWD ? (float)(C - 1 - 32 - vrow) : (float)(32 + vrow)));
    const unsigned ldsb = (unsigned)(uintptr_t)lds;
    const unsigned trK = ldsb + OFF_K + (unsigned)((8 * g + (i >> 2)) * (LQ * 2) + 8 * (i & 3));
    const unsigned trVZ = ldsb + OFF_VZ + (unsigned)((8 * g + (i >> 2)) * (LV * 2) + (dvw + 4 * (i & 3)) * 2);
    const unsigned trV = ldsb + OFF_V + (unsigned)((8 * g + (i >> 2)) * (LV * 2) + (dvw + 4 * (i & 3)) * 2);
    f4 S[16];
#pragma unroll
    for (int t = 0; t < 16; ++t) S[t] = (f4){0.f, 0.f, 0.f, 0.f};
    Stg st;
    const unsigned voffQ = (unsigned)((tid >> 5) * 4096 + (tid & 31) * 16), voffV = (unsigned)(vrow * 8192 + vch * 16);
#define RET_LOAD(j) do { const GAS unsigned char* qb_ = (const GAS unsigned char*)Qg + (size_t)(j) * (C * 4096); const GAS unsigned char* kb_ = (const GAS unsigned char*)Kg + (size_t)(j) * (C * 4096); \
        const GAS unsigned char* vb_ = (const GAS unsigned char*)Vg + (size_t)(j) * (C * 8192); \
        _Pragma("unroll") for (int a = 0; a < 4; ++a) { st.q[a] = *(const GAS v4u*)(qb_ + a * 65536 + voffQ); st.k[a] = *(const GAS v4u*)(kb_ + a * 65536 + voffQ); } \
        st.v[0] = *(const GAS v4u*)(vb_ + voffV); st.v[1] = *(const GAS v4u*)(vb_ + 262144 + voffV); } while (0)
#define RET_FLUSH(jj) do { GAS unsigned char* ob_ = (GAS unsigned char*)Og + (size_t)(jj) * (C * 8192); \
        _Pragma("unroll") for (int a = 0; a < 2; ++a) { const v4u w = *(const LAS v4u*)(lds + OFF_OS + ((vrow + 32 * a) * LV + vch * 8) * 2); \
        *(GAS v4u*)(ob_ + a * 262144 + voffV) = w; } } while (0)
    const int j0 = FWD ? 0 : nchunks - 1, dj = FWD ? 1 : -1;
    __syncthreads();
    RET_LOAD(j0);
    for (int s = 0; s < nchunks; ++s) {
        const int j = j0 + dj * s;
        const bool do_intra = FWD ? ((j & 1) == 0) : ((j & 1) == 1);
        __syncthreads();
#pragma unroll
        for (int a = 0; a < 4; ++a) { const int id = tid + 512 * a, row = id >> 5, ch = id & 31;
            *(LAS v4u*)(lds + OFF_Q + (row * LQ + ch * 8) * 2) = st.q[a]; *(LAS v4u*)(lds + OFF_K + (row * LQ + ch * 8) * 2) = st.k[a]; }
#pragma unroll
        for (int a = 0; a < 2; ++a) { const float zt = a ? zeta1 : zeta0; const v4u vv = st.v[a]; const int row = 32 * a + vrow;
            if (do_intra) *(LAS v4u*)(lds + OFF_V + (row * LV + vch * 8) * 2) = vv;
            v4u z; z.x = pkbf(bflo(vv.x) * zt, bfhi(vv.x) * zt); z.y = pkbf(bflo(vv.y) * zt, bfhi(vv.y) * zt);
            z.z = pkbf(bflo(vv.z) * zt, bfhi(vv.z) * zt); z.w = pkbf(bflo(vv.w) * zt, bfhi(vv.w) * zt);
            *(LAS v4u*)(lds + OFF_VZ + (row * LV + vch * 8) * 2) = z; }
        if (s > 0) RET_FLUSH(j - dj);
        __syncthreads();
        f4 o[4];
#pragma unroll
        for (int nt = 0; nt < 4; ++nt) o[nt] = (f4){0.f, 0.f, 0.f, 0.f};
#pragma unroll
        for (int s2 = 0; s2 < 8; ++s2) {
            v4u bw; bw.x = pkbf_c(S[2 * s2][0], S[2 * s2][1]); bw.y = pkbf_c(S[2 * s2][2], S[2 * s2][3]); bw.z = pkbf_c(S[2 * s2 + 1][0], S[2 * s2 + 1][1]); bw.w = pkbf_c(S[2 * s2 + 1][2], S[2 * s2 + 1][3]);
            const bf16x8 bfr = __builtin_bit_cast(bf16x8, bw);
#pragma unroll
            for (int nt = 0; nt < 4; ++nt) {
                const LAS unsigned char* qp = lds + OFF_Q + ((16 * nt + i) * LQ + 32 * s2 + 4 * g) * 2;
                const v2u a0 = *(const LAS v2u*)qp, a1 = *(const LAS v2u*)(qp + 32);
                v4u aw; aw.x = a0.x; aw.y = a0.y; aw.z = a1.x; aw.w = a1.y;
                if (!(RETD & 1)) o[nt] = MFMA16(__builtin_bit_cast(bf16x8, aw), bfr, o[nt]);
            }
        }
#pragma unroll
        for (int nt = 0; nt < 4; ++nt)
#pragma unroll
            for (int r = 0; r < 4; ++r) { const int n = 16 * nt + 4 * g + r; o[nt][r] *= __builtin_amdgcn_exp2f(lg * (FWD ? (float)(n + 1) : (float)(C - n))); }
        if (s + 1 < nchunks) RET_LOAD(j + dj);
        if (do_intra && !(RETD & 4)) {
            f4 s0 = {0.f, 0.f, 0.f, 0.f}, s1 = {0.f, 0.f, 0.f, 0.f};
#pragma unroll
            for (int ks = 0; ks < 8; ++ks) {
                const bf16x8 a = frag_rm(lds, OFF_Q, LQ, 16 * nb, 32 * ks, lane);
                const bf16x8 b0 = frag_rm(lds, OFF_K, LQ, 32 * cb, 32 * ks, lane), b1 = frag_rm(lds, OFF_K, LQ, 32 * cb + 16, 32 * ks, lane);
                s0 = MFMA16(a, b0, s0); s1 = MFMA16(a, b1, s1);
            }
#pragma unroll
            for (int r = 0; r < 4; ++r) { const int n = 16 * nb + 4 * g + r;
                const int m0 = 32 * cb + i, m1 = m0 + 16;
                const float d0 = (m0 <= n) ? __builtin_amdgcn_exp2f(lgf * (float)(n - m0)) : __builtin_amdgcn_exp2f(lgb * (float)(m0 - n));
                const float d1 = (m1 <= n) ? __builtin_amdgcn_exp2f(lgf * (float)(n - m1)) : __builtin_amdgcn_exp2f(lgb * (float)(m1 - n));
                const float p0v = (RETD & 32) ? (float)(n + 1) * 0.01f + (float)m0 * 0.001f : s0[r] * d0, p1v = (RETD & 32) ? (float)(n + 1) * 0.01f + (float)m1 * 0.001f : s1[r] * d1;
                *(LAS unsigned short*)(lds + OFF_P + (n * LP + m0) * 2) = (unsigned short)(pkbf(p0v, 0.f) & 0xffffu);
                *(LAS unsigned short*)(lds + OFF_P + (n * LP + m1) * 2) = (unsigned short)(pkbf(p1v, 0.f) & 0xffffu); }
        }
#pragma unroll
        for (int t = 0; t < 16; ++t) S[t] = S[t] * gch;
        {
            s16x4 bl[2], bh[2], al[2][4], ah[2][4];
            RET_LWAIT(); SBAR();
            frag_tr_issue<LV * 2, 0, 0>(bl[0], bh[0], trVZ);
#define RET_ISSUE_K(BUF, Q1) do { constexpr int ks1_ = (Q1) >> 2, t0_ = 4 * ((Q1) & 3); \
                frag_tr_issue<LQ * 2, 32 * ks1_, 16 * (t0_ + 0)>(al[BUF][0], ah[BUF][0], trK); frag_tr_issue<LQ * 2, 32 * ks1_, 16 * (t0_ + 1)>(al[BUF][1], ah[BUF][1], trK); \
                frag_tr_issue<LQ * 2, 32 * ks1_, 16 * (t0_ + 2)>(al[BUF][2], ah[BUF][2], trK); frag_tr_issue<LQ * 2, 32 * ks1_, 16 * (t0_ + 3)>(al[BUF][3], ah[BUF][3], trK); } while (0)
#define RET_GROUP(Q) do { constexpr int cur_ = (Q) & 1, ks_ = (Q) >> 2; \
                RET_LWAIT(); SBAR(); \
                if constexpr ((Q) + 1 == 4) frag_tr_issue<LV * 2, 32, 0>(bl[1], bh[1], trVZ); \
                if constexpr ((Q) < 7) RET_ISSUE_K(cur_ ^ 1, (Q) + 1); \
                { const bf16x8 b_ = RET_PK(bl[ks_], bh[ks_]); \
                  _Pragma("unroll") for (int t = 0; t < 4; ++t) if (!(RETD & 2)) S[4 * ((Q) & 3) + t] = MFMA16(RET_PK(al[cur_][t], ah[cur_][t]), b_, S[4 * ((Q) & 3) + t]); } \
                SBAR(); } while (0)
            RET_ISSUE_K(0, 0);
            RET_GROUP(0); RET_GROUP(1); RET_GROUP(2); RET_GROUP(3); RET_GROUP(4); RET_GROUP(5); RET_GROUP(6); RET_GROUP(7);
#undef RET_GROUP
#undef RET_ISSUE_K
        }
        __syncthreads();
        if (do_intra && !(RETD & 4)) {
#pragma unroll
            for (int ks = 0; ks < 2; ++ks) {
                s16x4 l0, h0;
                RET_LWAIT();
                if (ks == 0) frag_tr_issue<LV * 2, 0, 0>(l0, h0, trV); else frag_tr_issue<LV * 2, 32, 0>(l0, h0, trV);
                bf16x8 a[4];
#pragma unroll
                for (int nt = 0; nt < 4; ++nt) a[nt] = frag_rm(lds, OFF_P, LP, 16 * nt, 32 * ks, lane);
                RET_LWAIT(); SBAR();
                bf16x8 b = RET_PK(l0, h0);
                if (RETD & 8) { const short one = 0x3f80; b = (bf16x8){one, one, one, one, one, one, one, one}; }
#pragma unroll
                for (int nt = 0; nt < 4; ++nt) { bf16x8 aa = a[nt]; if (RETD & 16) { const short one = 0x3f80; aa = (bf16x8){one, one, one, one, one, one, one, one}; } o[nt] = MFMA16(aa, b, o[nt]); }
            }
        }
#pragma unroll
        for (int nt = 0; nt < 4; ++nt)
#pragma unroll
            for (int r = 0; r < 4; ++r) *(LAS unsigned short*)(lds + OFF_OS + ((16 * nt + 4 * g + r) * LV + dvw + i) * 2) = (unsigned short)(pkbf_c(o[nt][r], 0.f) & 0xffffu);
    }
    __syncthreads();
    RET_FLUSH(j0 + dj * (nchunks - 1));
#undef RET_LOAD
#undef RET_FLUSH
}

__device__ __forceinline__ void unit(const Frame& F, const bf16* Q, const bf16* K, const bf16* V, bf16* O, bf16* OB, int t0, int S, int u, const float* lgtab) {
    const int dir = u & 1, slice = (u >> 1) & 3, head = (u >> 3) & 7;
    const float lgf = __hip_atomic_load(lgtab + 2 * head, __ATOMIC_RELAXED, __HIP_MEMORY_SCOPE_AGENT), lgb = __hip_atomic_load(lgtab + 2 * head + 1, __ATOMIC_RELAXED, __HIP_MEMORY_SCOPE_AGENT);
    const bf16* Qg = Q + (size_t)t0 * 2048 + head * 256; const bf16* Kg = K + (size_t)t0 * 2048 + head * 256;
    const size_t voff = (size_t)t0 * 4096 + head * 512 + slice * W;
    if (dir == 0) sweep<true>(F, Qg, Kg, V + voff, O + voff, S / C, lgf, lgb);
    else          sweep<false>(F, Qg, Kg, V + voff, OB + voff, S / C, lgf, lgb);
}

__device__ __forceinline__ void phase(const Frame& F, const bf16* Q, const bf16* K, const bf16* V, bf16* O, bf16* OB, const float* lgtab) {
    int vcu = F.vcu; asm volatile("" : "+s"(vcu));
    if (vcu < 128) {
        unit(F, Q, K, V, O, OB, (vcu >> 6) * 8192, 8192, vcu & 63, lgtab);
    } else {
        for (int k = 0; k < 4; ++k) { const int u = (vcu - 128) * 4 + k; unit(F, Q, K, V, O, OB, TP + (u >> 6) * 2048, 2048, u & 63, lgtab); }
    }
}
}

#ifndef ATT_EARLY
#define ATT_EARLY 0
#endif
#ifndef ATT_VLATE
#define ATT_VLATE 0
#endif
#ifndef ATT_NPARK
#define ATT_NPARK 8
#endif
namespace att {
constexpr int NW = 8, QBLK = 32, KVBLK = 64, LDQ = 3072, LDKV = 4096, LDKR = 64, LDO = 2048;
constexpr int SHM_V = 16384, SHM_K = 24576, OFF_K = 2 * SHM_V, OFF_WS = OFF_K + 2 * SHM_K, NPARK = ATT_NPARK, OFF_QR = OFF_WS + NW * 64 * 4, SHM_ATTN = OFF_QR + NW * NPARK * 1024;
static_assert(SHM_ATTN <= RING_BYTES, "attention LDS");
constexpr float THR2 = 11.0f;
#define AKSWZ(row, colB) ((row) * 384 + ((colB) ^ (((row) & 7) << 4)))
__device__ __forceinline__ int crow(int r, int hi) { return (r & 3) + 8 * (r >> 2) + 4 * hi; }
__device__ __forceinline__ unsigned cvtpk(float lo, float hi) { unsigned r; asm volatile("v_cvt_pk_bf16_f32 %0, %1, %2" : "=v"(r) : "v"(lo), "v"(hi)); return r; }

__device__ __forceinline__ void partialSM(f32x16& p0, f32x16& p1, float& m_reg, float& mn, float& alpha) {
  float pmax = p0[0];
#pragma unroll
  for (int r = 1; r < 16; ++r) pmax = fmaxf(pmax, p0[r]);
#pragma unroll
  for (int r = 0; r < 16; ++r) pmax = fmaxf(pmax, p1[r]);
  { auto rr = __builtin_amdgcn_permlane32_swap(__float_as_uint(pmax), __float_as_uint(pmax), false, false);
    pmax = fmaxf(__uint_as_float(rr[0]), __uint_as_float(rr[1])); }
  if (__builtin_expect(__all(pmax - m_reg <= THR2), 1)) { mn = m_reg; alpha = 1.f; }
  else { mn = fmaxf(m_reg, pmax); alpha = __builtin_amdgcn_exp2f(m_reg - mn); m_reg = mn; }
#pragma unroll
  for (int r = 0; r < 16; ++r) p0[r] = p0[r] - mn;
#pragma unroll
  for (int r = 0; r < 16; ++r) p1[r] = p1[r] - mn;
#pragma unroll
  for (int r = 0; r < 16; ++r) p0[r] = __builtin_amdgcn_exp2f(p0[r]);
}
__device__ __forceinline__ void finishSM(f32x16& p0, f32x16& p1, float alpha, float& l_reg, bf16x8& pa0, bf16x8& pa1, bf16x8& pa2, bf16x8& pa3) {
#pragma unroll
  for (int r = 0; r < 16; ++r) p1[r] = __builtin_amdgcn_exp2f(p1[r]);
  float ps = 0;
#pragma unroll
  for (int r = 0; r < 16; ++r) ps += p0[r];
#pragma unroll
  for (int r = 0; r < 16; ++r) ps += p1[r];
  { auto rr = __builtin_amdgcn_permlane32_swap(__float_as_uint(ps), __float_as_uint(ps), false, false);
    ps = __uint_as_float(rr[0]) + __uint_as_float(rr[1]); }
  l_reg = l_reg * alpha + ps;
#define PK4(P, BASE, OUT) do { unsigned a0 = cvtpk(P[BASE + 0], P[BASE + 1]), a1 = cvtpk(P[BASE + 2], P[BASE + 3]);   \
    unsigned b0 = cvtpk(P[BASE + 4], P[BASE + 5]), b1 = cvtpk(P[BASE + 6], P[BASE + 7]);                              \
    auto r0 = __builtin_amdgcn_permlane32_swap(a0, b0, false, false); auto r1 = __builtin_amdgcn_permlane32_swap(a1, b1, false, false); \
    v4u w = {r0[0], r1[0], r0[1], r1[1]}; OUT = *reinterpret_cast<bf16x8*>(&w); } while (0)
  PK4(p0, 0, pa0); PK4(p0, 8, pa1); PK4(p1, 0, pa2); PK4(p1, 8, pa3);
#undef PK4
}
__device__ __forceinline__ void qkt(f32x16& p0, f32x16& p1, const LAS unsigned char* Ks, const bf16x8* qr, const LAS unsigned char* qrl, int r32, int hi) {
  p0 = f32x16{}; p1 = f32x16{};
#pragma unroll
  for (int d0 = 0; d0 < 12; ++d0) { const int cb = (d0 * 16 + hi * 8) * 2;
    const bf16x8 b0 = *reinterpret_cast<const LAS bf16x8*>(Ks + AKSWZ(r32, cb));
    const bf16x8 b1 = *reinterpret_cast<const LAS bf16x8*>(Ks + AKSWZ(32 + r32, cb));
    const bf16x8 q = d0 < 12 - NPARK ? qr[d0 < 12 - NPARK ? d0 : 0] : *reinterpret_cast<const LAS bf16x8*>(qrl + (d0 - (12 - NPARK)) * 1024);
    p0 = __builtin_amdgcn_mfma_f32_32x32x16_bf16(b0, q, p0, 0, 0, 0);
    p1 = __builtin_amdgcn_mfma_f32_32x32x16_bf16(b1, q, p1, 0, 0, 0); }
}
__device__ __forceinline__ int v_st(int k, int c) { const int kk = (k & ~0xC) | ((k & 4) << 1) | ((k & 8) >> 1); return ((kk >> 3) * 4 + (c >> 5)) * 512 + ((kk & 7) * 32 + (c & 31)) * 2; }
__device__ __forceinline__ int v_rd_base(int lane) { return ((lane & 3) << 3) | (((lane >> 2) & 3) << 6) | (((lane >> 4) & 1) << 5) | (((lane >> 5) & 1) << 8); }
constexpr int v_rd_off(int d0, int ks, int half) { return d0 * 512 + ks * 4096 + half * 2048; }
template <int OFF> __device__ __forceinline__ s16x4 tr_read(int vb) {
  s16x4 r; asm volatile("ds_read_b64_tr_b16 %0, %1 offset:%2" : "=&v"(r) : "v"(vb), "i"(OFF) : "memory"); return r;
}
template <int D0> __device__ __forceinline__ void pv_one(f32x16& od, int vb, bf16x8 pa0, bf16x8 pa1, bf16x8 pa2, bf16x8 pa3) {
  const s16x4 l0 = tr_read<v_rd_off(D0, 0, 0)>(vb), h0 = tr_read<v_rd_off(D0, 0, 1)>(vb), l1 = tr_read<v_rd_off(D0, 1, 0)>(vb), h1 = tr_read<v_rd_off(D0, 1, 1)>(vb);
  const s16x4 l2 = tr_read<v_rd_off(D0, 2, 0)>(vb), h2 = tr_read<v_rd_off(D0, 2, 1)>(vb), l3 = tr_read<v_rd_off(D0, 3, 0)>(vb), h3 = tr_read<v_rd_off(D0, 3, 1)>(vb);
  asm volatile("s_waitcnt lgkmcnt(0)" ::: "memory"); SBAR();
#define APK(L, H) (bf16x8){L[0], L[1], L[2], L[3], H[0], H[1], H[2], H[3]}
  od = __builtin_amdgcn_mfma_f32_32x32x16_bf16(pa0, APK(l0, h0), od, 0, 0, 0);
  od = __builtin_amdgcn_mfma_f32_32x32x16_bf16(pa1, APK(l1, h1), od, 0, 0, 0);
  od = __builtin_amdgcn_mfma_f32_32x32x16_bf16(pa2, APK(l2, h2), od, 0, 0, 0);
  od = __builtin_amdgcn_mfma_f32_32x32x16_bf16(pa3, APK(l3, h3), od, 0, 0, 0);
#undef APK
}
__device__ __forceinline__ void pv_d0(f32x16* o, int vb, bf16x8 pa0, bf16x8 pa1, bf16x8 pa2, bf16x8 pa3) {
  pv_one<0>(o[0], vb, pa0, pa1, pa2, pa3); pv_one<1>(o[1], vb, pa0, pa1, pa2, pa3); pv_one<2>(o[2], vb, pa0, pa1, pa2, pa3); pv_one<3>(o[3], vb, pa0, pa1, pa2, pa3);
}

__device__ __forceinline__ void attn_unit(const bf16* __restrict__ Qb, const bf16* __restrict__ Kn, const bf16* __restrict__ Kr, const bf16* __restrict__ Vh,
                                          bf16* __restrict__ Ob, int seq, LAS unsigned char* lds) {
  int tid_l = threadIdx.x; asm volatile("" : "+v"(tid_l));
  const int tid = tid_l, wid = tid >> 6, lane = tid & 63, r32 = lane & 31, hi = lane >> 5;
  LAS unsigned char* V_lds = lds; LAS unsigned char* K_lds = lds + OFF_K;
  LAS float* ws = (LAS float*)(lds + OFF_WS) + wid * 64; LAS float* li_l = ws; LAS float* al_l = ws + 32;
  float m_reg = -1e30f, l_reg = 0; f32x16 o[4] = {}; bf16x8 qr[12 - NPARK];
  const bf16* Qw = Qb + (size_t)(wid * QBLK + r32) * LDQ + hi * 8;
#pragma unroll
  for (int d0 = 0; d0 < 12 - NPARK; ++d0) qr[d0] = *reinterpret_cast<const bf16x8*>(Qw + d0 * 16);
  LAS unsigned char* qrl = lds + OFF_QR + wid * (NPARK * 1024) + hi * 512 + r32 * 16;
  __syncthreads();
#pragma unroll
  for (int d = 0; d < NPARK; ++d) *reinterpret_cast<LAS bf16x8*>(qrl + d * 1024) = *reinterpret_cast<const bf16x8*>(Qw + (12 - NPARK + d) * 16);
  const int sr = tid >> 4, sc = (tid & 15) * 8, vst0 = v_st(sr, sc), vst1 = v_st(32 + sr, sc);
  const int kr_r = tid >> 3, kr_c = (tid & 7) * 8;
  const int vb0 = (int)(unsigned)(uintptr_t)V_lds + v_rd_base(lane);
  bf16x8 vs0, vs1, ks0, ks1, kq0;
  const unsigned vo0 = (unsigned)(sr * LDKV + sc) * 2u, vo1 = vo0 + 32u * LDKV * 2u, vok = (unsigned)(kr_r * LDKR + kr_c) * 2u;
#define SLOAD_K(k0) do { const GAS unsigned char* kbp = (const GAS unsigned char*)Kn + (size_t)(k0) * (LDKV * 2); \
    const GAS unsigned char* rbp = (const GAS unsigned char*)Kr + (size_t)(k0) * (LDKR * 2); \
    ks0 = *reinterpret_cast<const GAS bf16x8*>(kbp + vo0); ks1 = *reinterpret_cast<const GAS bf16x8*>(kbp + vo1); \
    kq0 = *reinterpret_cast<const GAS bf16x8*>(rbp + vok); } while (0)
#define SLOAD_V(k0) do { const GAS unsigned char* vbp = (const GAS unsigned char*)Vh + (size_t)(k0) * (LDKV * 2); \
    vs0 = *reinterpret_cast<const GAS bf16x8*>(vbp + vo0); vs1 = *reinterpret_cast<const GAS bf16x8*>(vbp + vo1); } while (0)
#define SLOAD(k0) do { SLOAD_K(k0); SLOAD_V(k0); } while (0)
#define SWRITE(b) do { *(LAS bf16x8*)(V_lds + (b) * SHM_V + vst0) = vs0; *(LAS bf16x8*)(V_lds + (b) * SHM_V + vst1) = vs1; const int kc = sc * 2; \
    *(LAS bf16x8*)(K_lds + (b) * SHM_K + AKSWZ(sr, kc)) = ks0; *(LAS bf16x8*)(K_lds + (b) * SHM_K + AKSWZ(32 + sr, kc)) = ks1; \
    *(LAS bf16x8*)(K_lds + (b) * SHM_K + AKSWZ(kr_r, 256 + kr_c * 2)) = kq0; } while (0)
#define SWAIT() asm volatile("s_waitcnt vmcnt(0)" ::: "memory")
#define RESC(a) do { if (__any((a) < 1.f)) { if (hi == 0) al_l[r32] = (a); asm volatile("s_waitcnt lgkmcnt(0)" ::: "memory"); \
    _Pragma("unroll") for (int d = 0; d < 4; ++d) _Pragma("unroll") for (int r = 0; r < 16; ++r) o[d][r] *= al_l[crow(r, hi)]; } } while (0)
  f32x16 pA0, pA1, pB0, pB1; float mnA, mnB, alA, alB; bf16x8 pa0, pa1, pa2, pa3; const int NT = seq / KVBLK;
  SLOAD(0); SWAIT(); SWRITE(0); __syncthreads();
  qkt(pA0, pA1, K_lds, qr, qrl, r32, hi); partialSM(pA0, pA1, m_reg, mnA, alA);
  SLOAD(KVBLK);
  SWAIT(); SWRITE(1); __syncthreads();
  for (int j = 1; j + 1 < NT; j += 2) {
#if ATT_EARLY
    SLOAD((j + 1) * KVBLK);
#endif
    SBAR(); qkt(pB0, pB1, K_lds + SHM_K, qr, qrl, r32, hi);
    finishSM(pA0, pA1, alA, l_reg, pa0, pa1, pa2, pa3); SBAR();
#if ATT_EARLY
    pv_d0(o, vb0, pa0, pa1, pa2, pa3); partialSM(pB0, pB1, m_reg, mnB, alB);
#elif ATT_VLATE
    SLOAD_K((j + 1) * KVBLK); SBAR();
    pv_d0(o, vb0, pa0, pa1, pa2, pa3); SBAR(); SLOAD_V((j + 1) * KVBLK); SBAR(); partialSM(pB0, pB1, m_reg, mnB, alB);
#else
    SLOAD((j + 1) * KVBLK); SBAR();
    pv_d0(o, vb0, pa0, pa1, pa2, pa3); partialSM(pB0, pB1, m_reg, mnB, alB);
#endif
    __syncthreads(); SWAIT(); SWRITE(0);
    RESC(alB); __syncthreads();
#if ATT_EARLY
    SLOAD((j + 2) * KVBLK);
#endif
    SBAR(); qkt(pA0, pA1, K_lds, qr, qrl, r32, hi);
    finishSM(pB0, pB1, alB, l_reg, pa0, pa1, pa2, pa3); SBAR();
#if ATT_EARLY
    pv_d0(o, vb0 + SHM_V, pa0, pa1, pa2, pa3); partialSM(pA0, pA1, m_reg, mnA, alA);
#elif ATT_VLATE
    SLOAD_K((j + 2) * KVBLK); SBAR();
    pv_d0(o, vb0 + SHM_V, pa0, pa1, pa2, pa3); SBAR(); SLOAD_V((j + 2) * KVBLK); SBAR(); partialSM(pA0, pA1, m_reg, mnA, alA);
#else
    SLOAD((j + 2) * KVBLK); SBAR();
    pv_d0(o, vb0 + SHM_V, pa0, pa1, pa2, pa3); partialSM(pA0, pA1, m_reg, mnA, alA);
#endif
    __syncthreads(); SWAIT(); SWRITE(1);
    RESC(alA); __syncthreads();
  }
  SBAR(); qkt(pB0, pB1, K_lds + SHM_K, qr, qrl, r32, hi);
  finishSM(pA0, pA1, alA, l_reg, pa0, pa1, pa2, pa3); SBAR();
  pv_d0(o, vb0, pa0, pa1, pa2, pa3); partialSM(pB0, pB1, m_reg, mnB, alB);
  __syncthreads(); RESC(alB);
  finishSM(pB0, pB1, alB, l_reg, pa0, pa1, pa2, pa3); SBAR();
  pv_d0(o, vb0 + SHM_V, pa0, pa1, pa2, pa3);
  if (hi == 0) li_l[r32] = l_reg; asm volatile("s_waitcnt lgkmcnt(0)" ::: "memory");
  float rli[16];
#pragma unroll
  for (int r = 0; r < 16; ++r) rli[r] = __builtin_amdgcn_rcpf(li_l[crow(r, hi)]);
  __syncthreads();
  LAS unsigned short* stg = (LAS unsigned short*)(lds + wid * 8704);
#pragma unroll
  for (int r = 0; r < 16; ++r) { const int orow = crow(r, hi);
#pragma unroll
    for (int d0 = 0; d0 < 4; ++d0) stg[orow * 136 + d0 * 32 + r32] = (unsigned short)(cvtpk(o[d0][r] * rli[r], 0.f) & 0xffffu); }
  asm volatile("s_waitcnt lgkmcnt(0)" ::: "memory");
  bf16* Ow = Ob + (size_t)(wid * QBLK) * LDO;
#pragma unroll
  for (int i2 = 0; i2 < 8; ++i2) { const int id = i2 * 64 + lane, row = id >> 4, ch = id & 15;
    const v4u w = *(const LAS v4u*)((const LAS unsigned char*)stg + row * 272 + ch * 16);
    *(GAS v4u*)(Ow + (size_t)row * LDO + ch * 8) = w; }
#undef SLOAD
#undef SLOAD_K
#undef SLOAD_V
#undef SWRITE
#undef SWAIT
#undef RESC
}

__device__ __forceinline__ void phase(const Frame& F, const bf16* QA, const bf16* KV, const bf16* KR, bf16* O) {
  LAS unsigned char* lds = F.lds + RING_OFF;
  int vcu = F.vcu; asm volatile("" : "+s"(vcu));
  const int x = vcu >> 5, i = vcu & 31;
  for (int k = 0; k < 8; ++k) {
    int t0, S, head, qb;
    if (k < 4) { const int pair = 4 * x + k; t0 = (pair >> 4) * 8192; head = pair & 15; S = 8192; qb = i; }
    else { const int pair = 16 * x + 4 * (i >> 3) + (k - 4); t0 = TP + (pair >> 4) * 2048; head = pair & 15; S = 2048; qb = i & 7; }
    const bf16* Qb = QA + (size_t)(t0 + qb * 256) * LDQ + head * 192;
    const bf16* Kn = KV + (size_t)t0 * LDKV + head * 256; const bf16* Vh = Kn + 128; const bf16* Kr = KR + (size_t)t0 * LDKR;
    bf16* Ob = O + (size_t)(t0 + qb * 256) * LDO + head * 128;
    attn_unit(Qb, Kn, Kr, Vh, Ob, S, lds);
  }
}
}

#ifndef G_ALIGN
#define G_ALIGN true
#endif
#ifndef G_SP2
#define G_SP2 true
#endif
struct Args { const float* in[20]; float* out; unsigned char* ws; };

__device__ __forceinline__ const float* kin(int i) {
    unsigned long long kp = (unsigned long long)__builtin_amdgcn_kernarg_segment_ptr();
    asm volatile("" : "+s"(kp));
    return ((const float* const __attribute__((address_space(4)))*)kp)[i];
}
#define INP(i) kin(i)
#define WSB ((unsigned char*)kin(21))
#define X ((float*)kin(20))
#define XB ((bf16*)(WSB + WS_XB))
#define cosR ((float*)(WSB + WS_TAB))
#define sinR (cosR + 8192 * 128)
#define cosM (cosR + 2 * 8192 * 128)
#define sinM (cosR + 2 * 8192 * 128 + 8192 * 32)
#define ssq_base ((fx64*)(WSB + WS_CTL + CTL_SSQ))
#define STATS(k) ((fx64*)(WSB + WS_CTL + CTL_STATS) + (size_t)(k) * T * 2)
#define CSB2(k) ((fx64*)(WSB + WS_CTL + CTL_CSB2) + (size_t)(k) * 32768)
#define CSF(k) ((float*)(WSB + WS_CTL + CTL_CSF) + (size_t)(k) * 32768)
#define LGTAB ((float*)(WSB + WS_CTL + CTL_LGTAB))
#define wsW (WSB + WS_W)
#define wsA (WSB + WS_ACT)

__device__ __forceinline__ void convert_layer(const Frame& F, int layer, LAS float* scr) {
    const int j = layer >> 1; const int lp = layer > 0 ? layer - 1 : 0;
    const float* g2 = layer > 0 ? INP(14) + (size_t)lp * DM : nullptr; const float* b2 = layer > 0 ? INP(15) + (size_t)lp * DM : nullptr; fx64* cs_in = layer > 0 ? CSB2(2 * layer) : nullptr;
    if ((layer & 1) == 0) {
        convert_matrix(F, INP(2) + (size_t)j * 2048 * 12288, 2048, 12288, (bf16*)(wsW + W_RET_IN), 1, 1.0f, g2, b2, cs_in, scr);
        convert_matrix(F, INP(5) + (size_t)j * 4096 * 2048, 4096, 2048, (bf16*)(wsW + W_RET_OUT), 0, 1.0f, nullptr, nullptr, nullptr, scr);
    } else {
        convert_matrix(F, INP(6) + (size_t)j * 2048 * 2112, 2048, 2112, (bf16*)(wsW + W_MLA_IN), 2, 1.0f, g2, b2, cs_in, scr);
        { bf16* wt = (bf16*)(wsW + W_MLA_IN);
          PHASE_TID(tid, lane); (void)tid; const int gt = gw * 64 + lane, NGT = NGW * 64; unsigned zz = 0u; asm volatile("" : "+v"(zz));
          for (int e = gt; e < 192 * 2048 / 8; e += NGT) { const int rr = e / 256, cc = e % 256; const int row = 2048 + (rr < 96 ? 32 + rr : 160 + (rr - 96));
              *(GAS v4u*)(wt + (size_t)row * 2048 + cc * 8) = (v4u){zz, zz, zz, zz}; } }
        convert_matrix(F, INP(9) + (size_t)j * 1536 * 3072, 1536, 3072, (bf16*)(wsW + W_MLA_UQ), 3, 0.07216878364870322f * 1.4426950408889634f, INP(7) + (size_t)j * 1536, nullptr, nullptr, scr);
        convert_matrix(F, INP(10) + (size_t)j * 512 * 4096, 512, 4096, (bf16*)(wsW + W_MLA_UKV), 0, 1.0f, INP(8) + (size_t)j * 512, nullptr, nullptr, scr);
        convert_matrix(F, INP(11) + (size_t)j * 2048 * 2048, 2048, 2048, (bf16*)(wsW + W_MLA_OUT), 0, 1.0f, nullptr, nullptr, nullptr, scr);
    }
    convert_matrix(F, INP(16) + (size_t)layer * 2048 * 11264, 2048, 11264, (bf16*)(wsW + W_UP), 4, 1.0f, INP(12) + (size_t)layer * DM, INP(13) + (size_t)layer * DM, CSB2(2 * layer + 1), scr);
    convert_matrix(F, INP(19) + (size_t)layer * 5632 * 2048, 5632, 2048, (bf16*)((layer & 1) ? WSB + WS_WD2 : wsW + W_DOWN), 0, 1.0f, nullptr, nullptr, nullptr, scr);
}

__global__ void __launch_bounds__(NWAVES * 64, 2) fwd_kernel(Args args) {
    extern __shared__ __attribute__((aligned(16))) unsigned char lds_raw[];
    Frame F;
    F.lds = (LAS unsigned char*)lds_raw;
    F.wave = __builtin_amdgcn_readfirstlane((int)threadIdx.x >> 6);
    F.G = gridDim.x; { const int bx = blockIdx.x; F.vcu = (F.G % 8 == 0) ? (bx % 8) * (F.G / 8) + bx / 8 : bx; }
    F.gw = F.vcu * NWAVES + F.wave; F.NGW = F.G * NWAVES;
    volatile LAS unsigned* MISC = (volatile LAS unsigned*)(F.lds + MISC_OFF);
    for (int u = threadIdx.x; u < (LDS_BYTES - LDSCTL_OFF) / 4; u += NWAVES * 64) ((LAS unsigned*)(F.lds + LDSCTL_OFF))[u] = 0u;
    __syncthreads();
    XcdBarrier bar = xcd_barrier_post((unsigned*)(args.ws + WS_CTL) + CW_BAR, MISC + 8);
    LAS float* scr = (LAS float*)(F.lds + RING_OFF + F.wave * 16384);
    PG8_LAS unsigned char* ring = (PG8_LAS unsigned char*)(F.lds + RING_OFF);

#define GRID_BAR() do { XcdBarrier b2_ = bar; unsigned long long bp_ = (unsigned long long)b2_.bar; unsigned bx_ = b2_.x; asm volatile("" : "+s"(bp_), "+s"(bx_)); b2_.bar = (unsigned*)bp_; b2_.x = bx_; xcd_barrier(b2_); } while (0)

    prologue(F, INP(0), INP(1), X, XB, cosR, sinR, cosM, sinM, INP(3), INP(4), LGTAB);
    convert_layer(F, 0, scr);
    GRID_BAR();

#ifndef DIAG_LAYERS
#define DIAG_LAYERS 4
#endif
    for (int layer = 0; layer < DIAG_LAYERS; ++layer) {
        const int j = layer >> 1; const bool is_ret = (layer & 1) == 0;
        const bf16* Aout; const bf16* Wout; int Kout;
        if (is_ret) {
            bf16* RQ = (bf16*)(wsA + A_RQ); bf16* RK = (bf16*)(wsA + A_RK); bf16* RV = (bf16*)(wsA + A_RV); bf16* RG = (bf16*)(wsA + A_RG); bf16* RO = (bf16*)(wsA + A_RO); bf16* ROB = (bf16*)X;
            if (layer == 0) csb2_finalize(F, CSB2(0), CSF(0), 65536);
            {
                pg8::Gemm g{XB, (const bf16*)(wsW + W_RET_IN), T, 12288, 2048}; pg8::StaticOrder S; S.init(T, 12288, F.G, (int)blockIdx.x);
                pg8::EpiRetIn E{RQ, RK, RV, RG, cosR, sinR, pg8::LnCorr{layer > 0 ? STATS(2 * layer - 1) : nullptr, CSF(2 * layer), CSF(2 * layer) + 16384}};
                pg8::gemm_phase<pg8::EpiRetIn, pg8::StaticOrder, G_ALIGN, G_SP2>(ring, g, S, E);
#ifdef PROBE_DUP_R1
                __syncthreads();
                pg8::gemm_phase<pg8::EpiRetIn, pg8::StaticOrder, G_ALIGN, G_SP2>(ring, g, S, E);
#endif
            }
            GRID_BAR();
            ret::phase(F, RQ, RK, RV, RO, ROB, LGTAB + j * 16);
#ifdef PROBE_DUP_RET
            GRID_BAR();
            ret::phase(F, RQ, RK, RV, RO, ROB, LGTAB + j * 16);
#endif
            GRID_BAR();
            gate_pass(F, RO, ROB, RG, RG);
#ifdef PROBE_DUP_GATE
            GRID_BAR();
            gate_pass(F, RO, ROB, RG, RO);
#endif
            GRID_BAR();
            Aout = RG; Wout = (const bf16*)(wsW + W_RET_OUT); Kout = 4096;
        } else {
            bf16* CQ = (bf16*)(wsA + A_MCQ); bf16* CKV = (bf16*)(wsA + A_MCKV); bf16* KR = (bf16*)(wsA + A_MKR); bf16* QA = (bf16*)(wsA + A_MQA);
            bf16* KV = (bf16*)(wsA + A_MKV); bf16* MO = (bf16*)(wsA + A_MO);
            fx64* ssq_q = ssq_base + (size_t)j * T; fx64* ssq_kv = ssq_base + (size_t)(2 + j) * T;
            {
                pg8::Gemm g{XB, (const bf16*)(wsW + W_MLA_IN), T, 2304, 2048}; pg8::StaticOrder S; S.init(T, 2304, F.G, (int)blockIdx.x);
                pg8::EpiMlaIn E{CQ, CKV, KR, ssq_q, ssq_kv, cosM, sinM, pg8::LnCorr{STATS(2 * layer - 1), CSF(2 * layer), CSF(2 * layer) + 16384}};
                pg8::gemm_phase<pg8::EpiMlaIn, pg8::StaticOrder, G_ALIGN, G_SP2>(ring, g, S, E);
            }
            GRID_BAR();
            {
                pg8::Gemm g{CQ, (const bf16*)(wsW + W_MLA_UQ), T, 3072, 1536}; pg8::StaticOrder S; S.init(T, 3072, F.G, (int)blockIdx.x);
                pg8::EpiMlaUq E{QA, ssq_q, cosM, sinM};
                pg8::gemm_phase<pg8::EpiMlaUq, pg8::StaticOrder, G_ALIGN, G_SP2>(ring, g, S, E);
#ifdef PROBE_DUP_M2
                __syncthreads();
                pg8::gemm_phase<pg8::EpiMlaUq, pg8::StaticOrder, G_ALIGN, G_SP2>(ring, g, S, E);
#endif
            }
            __syncthreads();
            {
                pg8::Gemm g{CKV, (const bf16*)(wsW + W_MLA_UKV), T, 4096, 512}; pg8::StaticOrder S; S.init(T, 4096, F.G, (int)blockIdx.x);
                pg8::EpiMlaUkv E{KV, ssq_kv};
                pg8::gemm_phase<pg8::EpiMlaUkv, pg8::StaticOrder, G_ALIGN, G_SP2>(ring, g, S, E);
#ifdef PROBE_DUP_M2
                __syncthreads();
                pg8::gemm_phase<pg8::EpiMlaUkv, pg8::StaticOrder, G_ALIGN, G_SP2>(ring, g, S, E);
#endif
            }
            GRID_BAR();
            att::phase(F, QA, KV, KR, MO);
#ifdef PROBE_DUP_ATT
            GRID_BAR();
            att::phase(F, QA, KV, KR, MO);
#endif
            GRID_BAR();
            Aout = MO; Wout = (const bf16*)(wsW + W_MLA_OUT); Kout = 2048;
        }
        {
            pg8::Gemm g{Aout, Wout, T, 2048, Kout}; pg8::StaticOrder S; S.init(T, 2048, F.G, (int)blockIdx.x);
            const int lp = layer > 0 ? layer - 1 : 0;
            pg8::EpiResid E{XB, nullptr, STATS(2 * layer), layer > 0 ? STATS(2 * layer - 1) : nullptr, INP(14) + (size_t)lp * DM, INP(15) + (size_t)lp * DM, INP(0), INP(1)};
            pg8::gemm_phase<pg8::EpiResid, pg8::StaticOrder, G_ALIGN, G_SP2>(ring, g, S, E);
        }
        GRID_BAR();
#ifndef DIAG_NO_FFN
        bf16* FU = (bf16*)(wsA + A_FU); bf16* FG = (bf16*)(wsA + A_FG);
        {
            pg8::Gemm g{XB, (const bf16*)(wsW + W_UP), T, 11264, 2048}; pg8::StaticOrder S; S.init(T, 11264, F.G, (int)blockIdx.x);
            pg8::EpiFfnUp E{FU, FG, FG + (size_t)512 * 4 * FFN, INP(17) + (size_t)layer * 3 * FFN, INP(18) + (size_t)layer * FFN, pg8::LnCorr{STATS(2 * layer), CSF(2 * layer + 1), CSF(2 * layer + 1) + 16384}};
            pg8::gemm_phase<pg8::EpiFfnUp, pg8::StaticOrder, G_ALIGN, G_SP2>(ring, g, S, E);
#ifdef PROBE_DUP_F1
            __syncthreads();
            pg8::gemm_phase<pg8::EpiFfnUp, pg8::StaticOrder, G_ALIGN, G_SP2>(ring, g, S, E);
#endif
        }
        GRID_BAR();
        ffn_fixup(F, FU, FG, FG + (size_t)512 * 4 * FFN, INP(17) + (size_t)layer * 3 * FFN, INP(18) + (size_t)layer * FFN);
        if (layer < 3) convert_layer(F, layer + 1, scr);
        GRID_BAR();
        if (layer < 3) csb2_finalize(F, CSB2(2 * layer + 2), CSF(2 * layer + 2), 65536);
        {
            pg8::Gemm g{FU, (const bf16*)((layer & 1) ? WSB + WS_WD2 : wsW + W_DOWN), T, 2048, FFN}; pg8::StaticOrder S; S.init(T, 2048, F.G, (int)blockIdx.x);
            pg8::EpiResid E{XB, layer == DIAG_LAYERS - 1 ? X : nullptr, STATS(2 * layer + 1), STATS(2 * layer), INP(12) + (size_t)layer * DM, INP(13) + (size_t)layer * DM, nullptr, nullptr};
            pg8::gemm_phase<pg8::EpiResid, pg8::StaticOrder, G_ALIGN, G_SP2>(ring, g, S, E);
        }
        GRID_BAR();
#endif
#ifdef PROBE_EXTRA_BARS
        for (int eb = 0; eb < 10; ++eb) GRID_BAR();
#endif
    }
    ln_pass(F, X, XB, nullptr, INP(14) + (size_t)(DIAG_LAYERS - 1) * DM, INP(15) + (size_t)(DIAG_LAYERS - 1) * DM, true);
    GRID_BAR();
    if (xb_ld((unsigned*)(WSB + WS_CTL) + CW_BAR + XB_TMO) != 0u) {
        PHASE_TID(tid, lane); (void)tid; const float qn = __builtin_nanf("");
        for (int m = gw; m < T; m += NGW) { GAS f32x4* o = (GAS f32x4*)(X + (size_t)m * DM) + lane;
#pragma unroll
            for (int j2 = 0; j2 < 8; ++j2) o[64 * j2] = (f32x4){qn, qn, qn, qn}; }
    }
}

extern "C" void kernel_launch(void* const* d_in, const int* in_sizes, int n_in, void* d_out, int out_size, void* d_ws, size_t ws_size, hipStream_t stream) {
    static int grid = 0;
    if (grid == 0) {
        if (n_in != 20 || out_size != T * DM || ws_size < WS_END) { fprintf(stderr, "kernel_launch: unexpected shapes (n_in %d out %d ws %zu, need %zu)\n", n_in, out_size, ws_size, (size_t)WS_END); grid = -1; return; }
        int dev = 0, cus = 0, per_cu = 0;
        if (hipGetDevice(&dev) != hipSuccess || hipDeviceGetAttribute(&cus, hipDeviceAttributeMultiprocessorCount, dev) != hipSuccess) { grid = -1; return; }
        if (hipFuncSetAttribute((const void*)fwd_kernel, hipFuncAttributeMaxDynamicSharedMemorySize, LDS_BYTES) != hipSuccess) { fprintf(stderr, "kernel_launch: hipFuncSetAttribute failed\n"); grid = -1; return; }
        if (hipOccupancyMaxActiveBlocksPerMultiprocessor(&per_cu, (const void*)fwd_kernel, NWAVES * 64, LDS_BYTES) != hipSuccess || per_cu < 1)
            fprintf(stderr, "kernel_launch: occupancy query reports %d workgroups per CU\n", per_cu);
        (void)hipGetLastError();
        if (cus != 256) { fprintf(stderr, "kernel_launch: built for a 256-CU device, found %d\n", cus); grid = -1; return; }
        grid = cus;
    }
    if (grid < 0) return;
    if (hipMemsetAsync((char*)d_ws + WS_CTL, 0, CTL_ZERO_BYTES, stream) != hipSuccess) return;
    Args a{};
    for (int i = 0; i < 20; ++i) a.in[i] = (const float*)d_in[i];
    a.out = (float*)d_out; a.ws = (unsigned char*)d_ws;
    hipLaunchKernelGGL(fwd_kernel, dim3(grid), dim3(NWAVES * 64), LDS_BYTES, stream, a);
    const hipError_t le = hipPeekAtLastError();
    if (le != hipSuccess) fprintf(stderr, "kernel_launch: launch failed: %s\n", hipGetErrorName(le));
}
```

```cpp
#include <hip/hip_runtime.h>
#include <cstdio>
#include <cstdint>

#define GAS __attribute__((address_space(1)))
#define LAS __attribute__((address_space(3)))

namespace pg8 {
#define PG8_LAS __attribute__((address_space(3)))
typedef unsigned short bf16_t;
typedef short bf16x8 __attribute__((ext_vector_type(8)));
typedef float f32x4 __attribute__((ext_vector_type(4)));
typedef unsigned u32x4 __attribute__((ext_vector_type(4)));
constexpr int BM = 256, BK = 64, HALF = 128, HTB = HALF * BK * 2  , STAGE_BYTES = 8 * HTB, NXCD = 8, WGM = 8;
constexpr int PF_OFF = STAGE_BYTES, PF_BYTES = 6144;

__host__ __device__ __forceinline__ int lds_byte(int r, int c) { const int st = (r >> 4) * 2 + (c >> 5), rr = r & 15, cc = c & 31, ob = rr * 64 + cc * 2; return st * 1024 + (ob ^ (((ob >> 9) & 1) << 5)); }
__host__ __device__ __forceinline__ void stage_rc(int b, int& R, int& C) { const int st = b / 1024, sb = b % 1024, swz = sb ^ (((sb >> 9) & 1) << 5); R = (st >> 1) * 16 + swz / 64; C = (st & 1) * 32 + (swz % 64) / 2; }
__host__ __device__ __forceinline__ int perm32(int rho) { const int n = rho >> 4, i = rho & 15; return 8 * (i >> 2) + 4 * n + (i & 3); }

struct Unit { int pm, pn; };
struct Gemm { const bf16_t* A; const bf16_t* Bt; int M, N, K; };

struct StaticOrder {
    int nM, nN, nwg, G, c;
    __host__ __device__ void init(int M, int N, int G_, int c_) { nM = M / BM; nN = N / BM; nwg = nM * nN; G = G_; c = c_; }
    __host__ __device__ bool next(int i, Unit& u) const {
        const long L = (long)i * G + c; if (L >= nwg) return false;
        int wgid = (int)L; { const int q = nwg / NXCD, r = nwg % NXCD, xcd = wgid % NXCD, off = wgid / NXCD; wgid = (xcd < r ? xcd * (q + 1) : r * (q + 1) + (xcd - r) * q) + off; }
        const int nig = WGM * nN, gid = wgid / nig, fm = gid * WGM, gsz = (nM - fm) < WGM ? (nM - fm) : WGM;
        u.pm = fm + ((wgid % nig) % gsz); u.pn = (wgid % nig) / gsz; return true;
    }
    __device__ __forceinline__ void a_ready(const Unit&) const {}
    __device__ __forceinline__ void done(const Unit&) const {}
};
__device__ __forceinline__ unsigned cvt_pk_bf16(float lo, float hi) { unsigned r; asm volatile("v_cvt_pk_bf16_f32 %0, %1, %2" : "=v"(r) : "v"(lo), "v"(hi)); return r; }

template <class Epi, class Sched, bool ALIGN_EPI = false, bool SP2 = false>
__device__ __forceinline__ void gemm_phase(PG8_LAS unsigned char* lds, const Gemm g, const Sched& S, const Epi& E) {
    int tid_l = threadIdx.x; asm volatile("" : "+v"(tid_l));
    const int tid = tid_l, wid = __builtin_amdgcn_readfirstlane(tid >> 6), lane = tid & 63, wr = wid >> 2, wc = wid & 3, fr = lane & 15, fq = lane >> 4;
    const int K = g.K, nt = K / BK;
    unsigned voffA[2], voffB[2];
#pragma unroll
    for (int i = 0; i < 2; ++i) { int R, C; stage_rc(tid * 16 + i * 8192, R, C); const int Rb = Epi::PERM ? ((R & ~31) + perm32(R & 31)) : R;
        const int Ra = Epi::APERM ? ((R & ~63) + 4 * (R & 15) + ((R >> 4) & 3)) : R;
        voffA[i] = (unsigned)(Ra * K + C) * 2u; voffB[i] = (unsigned)(Rb * K + C) * 2u; }
    const size_t kstep = (size_t)(BK * 2);
    const size_t hstep = (size_t)HALF * K * 2;
    const size_t tstep = 2 * hstep;
    const unsigned ldsw = (unsigned)wid * 1024u;
    const int aoff = lds_byte(wr * 64 + fr, fq * 8), boff = lds_byte(wc * 32 + fr, fq * 8);
#define PG8_SA(b, h) (((b) * 2 + (h)) * HTB)
#define PG8_SB(b, h) ((4 + (b) * 2 + (h)) * HTB)
#define PG8_STAGE(bufoff, gbase, voff) do { _Pragma("unroll") for (int _i = 0; _i < 2; ++_i) \
        __builtin_amdgcn_global_load_lds((const unsigned*)((const char*)(gbase) + (voff)[_i]), (PG8_LAS unsigned*)(lds + (bufoff) + ldsw + _i * 8192), 16, 0, 0); } while (0)
#define PG8_LDA(dst, b, h) do { _Pragma("unroll") for (int m = 0; m < 4; ++m) _Pragma("unroll") for (int k = 0; k < 2; ++k) dst[m][k] = *(const PG8_LAS bf16x8*)(lds + PG8_SA(b, h) + aoff + m * 2048 + k * 1024); } while (0)
#define PG8_LDB(dst, b, h) do { _Pragma("unroll") for (int n = 0; n < 2; ++n) _Pragma("unroll") for (int k = 0; k < 2; ++k) dst[n][k] = *(const PG8_LAS bf16x8*)(lds + PG8_SB(b, h) + boff + n * 2048 + k * 1024); } while (0)
#define PG8_MMA(ai, bj, At, Bt) do { __builtin_amdgcn_s_setprio(1); _Pragma("unroll") for (int m = 0; m < 4; ++m) _Pragma("unroll") for (int n = 0; n < 2; ++n) _Pragma("unroll") for (int k = 0; k < 2; ++k) \
        acc[ai][bj][m][n] = __builtin_amdgcn_mfma_f32_16x16x32_bf16(Bt[n][k], At[m][k], acc[ai][bj][m][n], 0, 0, 0); __builtin_amdgcn_s_setprio(0); } while (0)
#define PG8_WAIT_V(n) asm volatile("s_waitcnt vmcnt(" #n ")" ::: "memory")
#define PG8_WAIT_L(n) asm volatile("s_waitcnt lgkmcnt(" #n ")" ::: "memory")
#define PG8_BAR __builtin_amdgcn_s_barrier()
#define PG8_SCHED __builtin_amdgcn_sched_barrier(0)
    Unit cur, nxt; int ui = 0;
    if (!S.next(0, cur)) return;
    f32x4 acc[2][2][4][2];
#pragma unroll
    for (int a = 0; a < 2; ++a)
#pragma unroll
        for (int b = 0; b < 2; ++b)
#pragma unroll
            for (int m = 0; m < 4; ++m)
#pragma unroll
                for (int n = 0; n < 2; ++n) acc[a][b][m][n] = (f32x4){0.f, 0.f, 0.f, 0.f};
    bf16x8 At[4][2], B0[2][2], B1[2][2];
    const char* cA = (const char*)g.A + (size_t)cur.pm * tstep; const char* cB = (const char*)g.Bt + (size_t)cur.pn * tstep;
    S.a_ready(cur);
    if constexpr (SP2) {
        PG8_STAGE(PG8_SB(0, 0), cB, voffB); PG8_STAGE(PG8_SB(0, 1), cB + hstep, voffB); PG8_STAGE(PG8_SA(0, 0), cA, voffA); PG8_STAGE(PG8_SA(0, 1), cA + hstep, voffA);
        if (wr == 1) PG8_BAR;
        PG8_WAIT_V(2); PG8_BAR;
        PG8_STAGE(PG8_SB(1, 0), cB + kstep, voffB); PG8_STAGE(PG8_SA(1, 0), cA + kstep, voffA); PG8_STAGE(PG8_SB(1, 1), cB + hstep + kstep, voffB);
        PG8_WAIT_V(6); PG8_BAR;
    } else {
        PG8_STAGE(PG8_SB(0, 0), cB, voffB); PG8_STAGE(PG8_SA(0, 0), cA, voffA); PG8_STAGE(PG8_SB(0, 1), cB + hstep, voffB); PG8_STAGE(PG8_SA(0, 1), cA + hstep, voffA);
        if (wr == 1) PG8_BAR;
        PG8_WAIT_V(4); PG8_BAR;
        PG8_STAGE(PG8_SB(1, 0), cB + kstep, voffB); PG8_STAGE(PG8_SA(1, 0), cA + kstep, voffA); PG8_STAGE(PG8_SB(1, 1), cB + hstep + kstep, voffB);
        PG8_WAIT_V(6); PG8_BAR;
    }
    for (;;) {
        const bool has_next = S.next(ui + 1, nxt);
        PG8_LAS unsigned char* const pfa = lds + PF_OFF + (ui & 1) * PF_BYTES;
        if constexpr (Epi::HAS_PRE) E.prefetch(cur, pfa, wid, lane);
        const char* nA = has_next ? (const char*)g.A + (size_t)nxt.pm * tstep : cA; const char* nB = has_next ? (const char*)g.Bt + (size_t)nxt.pn * tstep : cB;
        for (int t = 0; t < nt; t += 2) {
            const bool last = (t == nt - 2);
            const char* a1 = cA + (size_t)(t + 1) * kstep;
            const char* a2 = last ? nA : cA + (size_t)(t + 2) * kstep; const char* b2 = last ? nB : cB + (size_t)(t + 2) * kstep;
            const char* a3 = a2 + kstep; const char* b3 = b2 + kstep;
            if (last && has_next) S.a_ready(nxt);
            if constexpr (SP2) {
            PG8_LDB(B0, 0, 0); PG8_LDB(B1, 0, 1); PG8_SCHED; PG8_LDA(At, 0, 0); PG8_STAGE(PG8_SA(1, 1), a1 + hstep, voffA);
            PG8_WAIT_V(8); PG8_WAIT_L(0); PG8_BAR; PG8_MMA(0, 0, At, B0); PG8_MMA(0, 1, At, B1); PG8_BAR; PG8_SCHED;
            PG8_LDA(At, 0, 1); PG8_STAGE(PG8_SB(0, 0), b2, voffB); PG8_STAGE(PG8_SB(0, 1), b2 + hstep, voffB); PG8_STAGE(PG8_SA(0, 0), a2, voffA);
            PG8_WAIT_V(8); PG8_WAIT_L(0); PG8_BAR; PG8_MMA(1, 0, At, B0); PG8_MMA(1, 1, At, B1); PG8_BAR; PG8_SCHED;
            PG8_LDB(B0, 1, 0); PG8_LDB(B1, 1, 1); PG8_SCHED; PG8_LDA(At, 1, 0); PG8_STAGE(PG8_SA(0, 1), a2 + hstep, voffA);
            PG8_WAIT_V(8); PG8_WAIT_L(0); PG8_BAR; PG8_MMA(0, 0, At, B0); PG8_MMA(0, 1, At, B1); PG8_BAR; PG8_SCHED;
            PG8_LDA(At, 1, 1); PG8_STAGE(PG8_SB(1, 0), b3, voffB); PG8_STAGE(PG8_SB(1, 1), b3 + hstep, voffB); PG8_STAGE(PG8_SA(1, 0), a3, voffA);
            PG8_WAIT_V(8); PG8_WAIT_L(0); PG8_BAR; PG8_MMA(1, 0, At, B0); PG8_MMA(1, 1, At, B1); PG8_BAR; PG8_SCHED;
            } else {
            PG8_LDB(B0, 0, 0); PG8_SCHED; PG8_LDA(At, 0, 0); PG8_STAGE(PG8_SA(1, 1), a1 + hstep, voffA);
            PG8_WAIT_L(8); PG8_BAR; PG8_WAIT_L(0); PG8_MMA(0, 0, At, B0); PG8_BAR; PG8_SCHED;
            PG8_LDB(B1, 0, 1); PG8_STAGE(PG8_SB(0, 0), b2, voffB);
            PG8_BAR; PG8_WAIT_L(0); PG8_MMA(0, 1, At, B1); PG8_BAR;
            PG8_LDA(At, 0, 1); PG8_STAGE(PG8_SA(0, 0), a2, voffA);
            PG8_BAR; PG8_WAIT_L(0); PG8_MMA(1, 0, At, B0); PG8_BAR; PG8_SCHED;
            PG8_STAGE(PG8_SB(0, 1), b2 + hstep, voffB);
            PG8_WAIT_V(6); PG8_BAR; PG8_MMA(1, 1, At, B1); PG8_BAR;
            PG8_LDB(B0, 1, 0); PG8_SCHED; PG8_LDA(At, 1, 0); PG8_STAGE(PG8_SA(0, 1), a2 + hstep, voffA);
            PG8_WAIT_L(8); PG8_BAR; PG8_WAIT_L(0); PG8_MMA(0, 0, At, B0); PG8_BAR; PG8_SCHED;
            PG8_LDB(B1, 1, 1); PG8_STAGE(PG8_SB(1, 0), b3, voffB);
            PG8_BAR; PG8_WAIT_L(0); PG8_MMA(0, 1, At, B1); PG8_BAR;
            PG8_LDA(At, 1, 1); PG8_STAGE(PG8_SA(1, 0), a3, voffA);
            PG8_BAR; PG8_WAIT_L(0); PG8_MMA(1, 0, At, B0); PG8_BAR; PG8_SCHED;
            PG8_STAGE(PG8_SB(1, 1), b3 + hstep, voffB);
            PG8_WAIT_V(6); PG8_BAR; PG8_MMA(1, 1, At, B1); PG8_BAR;
            }
        }
        if constexpr (ALIGN_EPI) { if (wr == 0) PG8_BAR; }
        if constexpr (!Epi::AFTER_DRAIN) { if constexpr (Epi::HAS_PRE) E.pre(acc, cur, wr, wc, fr, fq, pfa); E(acc, cur, wr, wc, fr, fq); S.done(cur); }
        if (!has_next) break;
#pragma unroll
        for (int a = 0; a < 2; ++a)
#pragma unroll
            for (int b = 0; b < 2; ++b)
#pragma unroll
                for (int m = 0; m < 4; ++m)
#pragma unroll
                    for (int n = 0; n < 2; ++n) acc[a][b][m][n] = (f32x4){0.f, 0.f, 0.f, 0.f};
        cur = nxt; cA = nA; cB = nB; ++ui;
        if constexpr (ALIGN_EPI) { if (wr == 1) PG8_BAR; }
    }
    PG8_WAIT_V(0);
    if constexpr (!ALIGN_EPI) { if (wr == 0) PG8_BAR; }
    PG8_BAR;
    if constexpr (Epi::AFTER_DRAIN) { E.fused(acc, cur, wr, wc, fr, fq, lds, wid, lane); S.done(cur); }
#undef PG8_SA
#undef PG8_SB
#undef PG8_STAGE
#undef PG8_LDA
#undef PG8_LDB
#undef PG8_MMA
#undef PG8_WAIT_V
#undef PG8_WAIT_L
#undef PG8_BAR
#undef PG8_SCHED
}
}

constexpr int DM = 2048;
constexpr int T = 32768, TP = 16384;
constexpr int FFN = 5632;
constexpr float ALPHA = 1.6817928305074290f;
typedef unsigned short bf16;
typedef unsigned v4u __attribute__((ext_vector_type(4)));
typedef unsigned v2u __attribute__((ext_vector_type(2)));
typedef float f32x4 __attribute__((ext_vector_type(4)));
typedef float f32x16 __attribute__((ext_vector_type(16)));
typedef short bf16x8 __attribute__((ext_vector_type(8)));
typedef short s16x4 __attribute__((ext_vector_type(4)));

__device__ __forceinline__ int seq_pos(int r) { return r < TP ? (r & 8191) : (r & 2047); }
__device__ __forceinline__ unsigned pkbf(float lo, float hi) { return pg8::cvt_pk_bf16(lo, hi); }
__device__ __forceinline__ v4u pack8(f32x4 a, f32x4 b) { v4u w; w.x = pkbf(a[0], a[1]); w.y = pkbf(a[2], a[3]); w.z = pkbf(b[0], b[1]); w.w = pkbf(b[2], b[3]); return w; }
__device__ __forceinline__ float bf2f(unsigned short b) { return __builtin_bit_cast(float, (unsigned)b << 16); }
__device__ __forceinline__ float bflo(unsigned w) { return __builtin_bit_cast(float, w << 16); }
__device__ __forceinline__ float bfhi(unsigned w) { return __builtin_bit_cast(float, w & 0xffff0000u); }
typedef long long fx64;
__device__ __forceinline__ void fx_add(fx64* p, float v) { atomicAdd((unsigned long long*)p, (unsigned long long)(long long)(v * 4294967296.0f)); }
__device__ __forceinline__ float fx_val(fx64 x) { return (float)((double)x * (1.0 / 4294967296.0)); }
__device__ __forceinline__ float fx_load(const fx64* p) { return fx_val(__hip_atomic_load(p, __ATOMIC_RELAXED, __HIP_MEMORY_SCOPE_AGENT)); }

namespace pg8 {
__device__ __forceinline__ void st_nt(void* p, u32x4 v) { __builtin_nontemporal_store(v, (u32x4*)p); }
struct LnCorr { const fx64* st; const float* cs; const float* b2; };
__device__ __forceinline__ void ln_prefetch(const LnCorr& L, const Unit& u, PG8_LAS unsigned char* pfa, int wid, int lane) {
    if (!L.st) return;
    if (wid < 4) __builtin_amdgcn_global_load_lds((const unsigned*)(L.st + 2 * (u.pm * BM + 64 * wid + lane)), (PG8_LAS unsigned*)(pfa + wid * 1024), 16, 0, 0);
    else if (wid < 6) { const float* v = (wid == 4 ? L.cs : L.b2) + u.pn * BM + 4 * lane; __builtin_amdgcn_global_load_lds((const unsigned*)v, (PG8_LAS unsigned*)(pfa + 4096 + (wid - 4) * 1024), 16, 0, 0); }
}
template <bool PERM, bool APERM = false> __device__ __forceinline__ void ln_correct(const LnCorr& L, f32x4 (&acc)[2][2][4][2], int wr, int wc, int fr, int fq, const PG8_LAS unsigned char* pfa) {
    if (!L.st) return;
    typedef long long ll2 __attribute__((ext_vector_type(2)));
    float rs[2][4], mr[2][4];
#pragma unroll
    for (int ai = 0; ai < 2; ++ai)
#pragma unroll
        for (int m = 0; m < 4; ++m) { const int lr = ai * HALF + wr * 64 + (APERM ? 4 * fr + m : m * 16 + fr);
            const ll2 sv = *(const PG8_LAS ll2*)(pfa + lr * 16);
            const float s1 = fx_val(sv.x), s2 = fx_val(sv.y);
            const float mu = s1 * (1.0f / DM), var = s2 * (1.0f / DM) - mu * mu; const float r_ = __builtin_amdgcn_rsqf(var + 1e-5f); rs[ai][m] = r_; mr[ai][m] = mu * r_; }
#pragma unroll
    for (int bj = 0; bj < 2; ++bj)
#pragma unroll
        for (int n = 0; n < 2; ++n) { const int lc = bj * HALF + wc * 32 + (PERM ? 8 * fq + 4 * n : 16 * n + 4 * fq);
            const f32x4 c4 = *(const PG8_LAS f32x4*)(pfa + 4096 + lc * 4), b4 = *(const PG8_LAS f32x4*)(pfa + 5120 + lc * 4);
#pragma unroll
            for (int ai = 0; ai < 2; ++ai)
#pragma unroll
                for (int m = 0; m < 4; ++m) acc[ai][bj][m][n] = acc[ai][bj][m][n] * rs[ai][m] - c4 * mr[ai][m] + b4; }
}
struct EpiRetIn {
    static constexpr bool PERM = true, AFTER_DRAIN = false, APERM = false, HAS_PRE = true;
    bf16_t *Q, *K, *V, *G; const float *cosT, *sinT; LnCorr lc;
    __device__ __forceinline__ void prefetch(const Unit& u, PG8_LAS unsigned char* pfa, int wid, int lane) const { ln_prefetch(lc, u, pfa, wid, lane); }
    __device__ __forceinline__ void pre(f32x4 (&acc)[2][2][4][2], const Unit& u, int wr, int wc, int fr, int fq, const PG8_LAS unsigned char* pfa) const { ln_correct<true>(lc, acc, wr, wc, fr, fq, pfa); }
    __device__ __forceinline__ void operator()(const f32x4 (&acc)[2][2][4][2], const Unit& u, int wr, int wc, int fr, int fq) const {
        const int row0 = u.pm * BM + wr * 64 + fr, cl = wc * 32 + 8 * fq;
        if (u.pn < 16) {
            bf16_t* base = (u.pn < 8 ? Q : K) + (size_t)(u.pn & 7) * 256 + cl;
#pragma unroll
            for (int ai = 0; ai < 2; ++ai)
#pragma unroll
                for (int m = 0; m < 4; ++m) {
                    const int r = row0 + ai * HALF + m * 16; const int pos = seq_pos(r);
                    const float* cp = cosT + (size_t)pos * 128 + cl; const float* sp = sinT + (size_t)pos * 128 + cl;
                    const f32x4 c0 = *(const f32x4*)cp, c1 = *(const f32x4*)(cp + 4), s0 = *(const f32x4*)sp, s1 = *(const f32x4*)(sp + 4);
                    const f32x4 x1a = acc[ai][0][m][0], x1b = acc[ai][0][m][1], x2a = acc[ai][1][m][0], x2b = acc[ai][1][m][1];
                    const f32x4 y1a = x1a * c0 - x2a * s0, y1b = x1b * c1 - x2b * s1, y2a = x1a * s0 + x2a * c0, y2b = x1b * s1 + x2b * c1;
                    bf16_t* rp = base + (size_t)r * 2048;
                    st_nt(rp, pack8(y1a, y1b)); st_nt(rp + 128, pack8(y2a, y2b));
                    asm volatile("" ::: "memory"); }
        } else {
            bf16_t* base = (u.pn < 32 ? V + (size_t)(u.pn - 16) * 256 : G + (size_t)(u.pn - 32) * 256) + cl;
#pragma unroll
            for (int ai = 0; ai < 2; ++ai)
#pragma unroll
                for (int m = 0; m < 4; ++m) { bf16_t* rp = base + (size_t)(row0 + ai * HALF + m * 16) * 4096;
#pragma unroll
                    for (int bj = 0; bj < 2; ++bj) st_nt(rp + bj * HALF, pack8(acc[ai][bj][m][0], acc[ai][bj][m][1])); }
        }
    }
};
struct EpiResid {
    static constexpr bool PERM = true, AFTER_DRAIN = false, APERM = false, HAS_PRE = true;
    bf16_t* XBs; float* Yf; fx64* st_new; const fx64* st_prev; const float* g; const float* b; const float* xin_p; const float* xin_s;
    __device__ __forceinline__ void prefetch(const Unit& u, PG8_LAS unsigned char* pfa, int wid, int lane) const { ln_prefetch(LnCorr{st_prev, g, b}, u, pfa, wid, lane); }
    __device__ __forceinline__ void operator()(const f32x4 (&acc)[2][2][4][2], const Unit& u, int wr, int wc, int fr, int fq) const {}
    __device__ __forceinline__ void pre(f32x4 (&acc)[2][2][4][2], const Unit& u, int wr, int wc, int fr, int fq, const PG8_LAS unsigned char* pfa) const {
        typedef long long ll2 __attribute__((ext_vector_type(2)));
        const int row0 = u.pm * BM + wr * 64 + fr, lc0 = wc * 32 + 8 * fq, col0 = u.pn * BM + lc0;
#pragma unroll
        for (int ai = 0; ai < 2; ++ai) {
            float mu[4], rs[4], s1[4], s2[4];
#pragma unroll
            for (int m = 0; m < 4; ++m) { s1[m] = 0.f; s2[m] = 0.f; mu[m] = 0.f; rs[m] = 1.f;
                if (st_prev) { const ll2 sv = *(const PG8_LAS ll2*)(pfa + (ai * HALF + wr * 64 + m * 16 + fr) * 16);
                    const float p1 = fx_val(sv.x), p2 = fx_val(sv.y); mu[m] = p1 * (1.0f / DM); const float var = p2 * (1.0f / DM) - mu[m] * mu[m]; rs[m] = __builtin_amdgcn_rsqf(var + 1e-5f); } }
#pragma unroll
            for (int bj = 0; bj < 2; ++bj) {
                f32x4 xv[4][2];
                if (!st_prev) {
#pragma unroll
                    for (int m = 0; m < 4; ++m) { const int r = row0 + ai * HALF + m * 16; const float* srcp = (r < TP ? xin_p + (size_t)r * DM : xin_s + (size_t)(r - TP) * DM) + col0 + bj * HALF;
                        xv[m][0] = *(const f32x4*)srcp; xv[m][1] = *(const f32x4*)(srcp + 4); }
                } else {
                    v4u w[4];
#pragma unroll
                    for (int m = 0; m < 4; ++m) w[m] = *(const v4u*)(XBs + (size_t)(row0 + ai * HALF + m * 16) * DM + col0 + bj * HALF);
                    const f32x4 g0 = *(const PG8_LAS f32x4*)(pfa + 4096 + (bj * HALF + lc0) * 4), g1 = *(const PG8_LAS f32x4*)(pfa + 4096 + (bj * HALF + lc0 + 4) * 4);
                    const f32x4 b0 = *(const PG8_LAS f32x4*)(pfa + 5120 + (bj * HALF + lc0) * 4), b1 = *(const PG8_LAS f32x4*)(pfa + 5120 + (bj * HALF + lc0 + 4) * 4);
#pragma unroll
                    for (int m = 0; m < 4; ++m) {
                        const f32x4 x0 = (f32x4){bflo(w[m].x), bfhi(w[m].x), bflo(w[m].y), bfhi(w[m].y)}, x1 = (f32x4){bflo(w[m].z), bfhi(w[m].z), bflo(w[m].w), bfhi(w[m].w)};
                        xv[m][0] = (x0 - mu[m]) * rs[m] * g0 + b0; xv[m][1] = (x1 - mu[m]) * rs[m] * g1 + b1; } }
#pragma unroll
                for (int m = 0; m < 4; ++m) { const int r = row0 + ai * HALF + m * 16;
                    const f32x4 y0 = xv[m][0] * ALPHA + acc[ai][bj][m][0], y1 = xv[m][1] * ALPHA + acc[ai][bj][m][1];
                    if (Yf) { float* yp = Yf + (size_t)r * DM + col0 + bj * HALF; *(f32x4*)yp = y0; *(f32x4*)(yp + 4) = y1; }
                    else { v4u w; w.x = cvt_pk_bf16(y0[0], y0[1]); w.y = cvt_pk_bf16(y0[2], y0[3]); w.z = cvt_pk_bf16(y1[0], y1[1]); w.w = cvt_pk_bf16(y1[2], y1[3]);
                        *(v4u*)(XBs + (size_t)r * DM + col0 + bj * HALF) = w;
                        const float a0 = bflo(w.x), a1 = bfhi(w.x), a2 = bflo(w.y), a3 = bfhi(w.y), a4 = bflo(w.z), a5 = bfhi(w.z), a6 = bflo(w.w), a7 = bfhi(w.w);
                        s1[m] += ((a0 + a1) + (a2 + a3)) + ((a4 + a5) + (a6 + a7)); s2[m] += ((a0 * a0 + a1 * a1) + (a2 * a2 + a3 * a3)) + ((a4 * a4 + a5 * a5) + (a6 * a6 + a7 * a7)); } }
                asm volatile("" ::: "memory"); }
            if (!Yf) {
#pragma unroll
                for (int m = 0; m < 4; ++m) { const int r = row0 + ai * HALF + m * 16; float t1 = s1[m], t2 = s2[m];
                    t1 += __shfl_xor(t1, 16); t1 += __shfl_xor(t1, 32); t2 += __shfl_xor(t2, 16); t2 += __shfl_xor(t2, 32);
                    if (fq == 0) { fx_add(st_new + 2 * r, t1); fx_add(st_new + 2 * r + 1, t2); } } }
        }
    }
};
struct EpiSplit {
    static constexpr bool PERM = true, AFTER_DRAIN = false, APERM = false, HAS_PRE = false;
    bf16_t *O0, *O1; int split, ldc;
    __device__ __forceinline__ void operator()(const f32x4 (&acc)[2][2][4][2], const Unit& u, int wr, int wc, int fr, int fq) const {
        const int row0 = u.pm * BM + wr * 64 + fr, cl = wc * 32 + 8 * fq;
        bf16_t* base = (u.pn < split ? O0 + (size_t)u.pn * 256 : O1 + (size_t)(u.pn - split) * 256) + cl;
#pragma unroll
        for (int ai = 0; ai < 2; ++ai)
#pragma unroll
            for (int m = 0; m < 4; ++m) { bf16_t* rp = base + (size_t)(row0 + ai * HALF + m * 16) * ldc;
#pragma unroll
                for (int bj = 0; bj < 2; ++bj) *(u32x4*)(rp + bj * HALF) = pack8(acc[ai][bj][m][0], acc[ai][bj][m][1]); }
    }
};
struct EpiMlaIn {
    static constexpr bool PERM = true, AFTER_DRAIN = false, APERM = false, HAS_PRE = true;
    bf16_t *CQ, *CKV, *KR; fx64 *ssq_q, *ssq_kv; const float *cosM, *sinM; LnCorr lc;
    __device__ __forceinline__ void prefetch(const Unit& u, PG8_LAS unsigned char* pfa, int wid, int lane) const { ln_prefetch(lc, u, pfa, wid, lane); }
    __device__ __forceinline__ void pre(f32x4 (&acc)[2][2][4][2], const Unit& u, int wr, int wc, int fr, int fq, const PG8_LAS unsigned char* pfa) const { ln_correct<true>(lc, acc, wr, wc, fr, fq, pfa); }
    __device__ __forceinline__ void operator()(const f32x4 (&acc)[2][2][4][2], const Unit& u, int wr, int wc, int fr, int fq) const {
        const int row0 = u.pm * BM + wr * 64 + fr, cl = wc * 32 + 8 * fq;
        if (u.pn < 8) {
            const bool isq = u.pn < 6; const int ldc = isq ? 1536 : 512;
            bf16_t* base = (isq ? CQ + (size_t)u.pn * 256 : CKV + (size_t)(u.pn - 6) * 256) + cl; fx64* ssq = isq ? ssq_q : ssq_kv;
#pragma unroll
            for (int ai = 0; ai < 2; ++ai)
#pragma unroll
                for (int m = 0; m < 4; ++m) { const int r = row0 + ai * HALF + m * 16; bf16_t* rp = base + (size_t)r * ldc; float s = 0.f;
#pragma unroll
                    for (int bj = 0; bj < 2; ++bj) { const f32x4 a = acc[ai][bj][m][0], b = acc[ai][bj][m][1];
                        s += (a[0] * a[0] + a[1] * a[1]) + (a[2] * a[2] + a[3] * a[3]) + (b[0] * b[0] + b[1] * b[1]) + (b[2] * b[2] + b[3] * b[3]);
                        *(u32x4*)(rp + bj * HALF) = pack8(a, b); }
                    s += __shfl_xor(s, 16); s += __shfl_xor(s, 32);
                    if (fq == 0) fx_add(ssq + r, s); }
        } else if (wc == 0) {
#pragma unroll
            for (int ai = 0; ai < 2; ++ai)
#pragma unroll
                for (int m = 0; m < 4; ++m) { const int r = row0 + ai * HALF + m * 16; const int pos = seq_pos(r);
                    const float* cp = cosM + (size_t)pos * 32 + 8 * fq; const float* sp = sinM + (size_t)pos * 32 + 8 * fq;
                    const f32x4 c0 = *(const f32x4*)cp, c1 = *(const f32x4*)(cp + 4), s0 = *(const f32x4*)sp, s1 = *(const f32x4*)(sp + 4);
                    const f32x4 x1a = acc[ai][0][m][0], x1b = acc[ai][0][m][1], x2a = acc[ai][1][m][0], x2b = acc[ai][1][m][1];
                    const f32x4 y1a = x1a * c0 - x2a * s0, y1b = x1b * c1 - x2b * s1, y2a = x1a * s0 + x2a * c0, y2b = x1b * s1 + x2b * c1;
                    bf16_t* rp = KR + (size_t)r * 64 + 8 * fq;
                    *(u32x4*)rp = pack8(y1a, y1b); *(u32x4*)(rp + 32) = pack8(y2a, y2b); }
        }
    }
};
struct EpiMlaUq {
    static constexpr bool PERM = true, AFTER_DRAIN = false, APERM = false, HAS_PRE = false;
    bf16_t* QA; const fx64* ssq_q; const float *cosM, *sinM;
    __device__ __forceinline__ void operator()(const f32x4 (&acc)[2][2][4][2], const Unit& u, int wr, int wc, int fr, int fq) const {
        const int row0 = u.pm * BM + wr * 64 + fr;
#pragma unroll
        for (int ai = 0; ai < 2; ++ai)
#pragma unroll
            for (int m = 0; m < 4; ++m) { const int r = row0 + ai * HALF + m * 16;
                const float ss = fx_load(ssq_q + r);
                const float rs = __builtin_amdgcn_rsqf(ss * (1.0f / 1536.0f) + 1e-6f);
                bf16_t* rp = QA + (size_t)r * 3072;
                if (u.pn < 8) {
#pragma unroll
                    for (int bj = 0; bj < 2; ++bj) st_nt(rp + (2 * u.pn + bj) * 192 + wc * 32 + 8 * fq, pack8(acc[ai][bj][m][0] * rs, acc[ai][bj][m][1] * rs));
                } else {
                    const int head = 4 * (u.pn - 8) + wc; const int pos = seq_pos(r);
                    const float* cp = cosM + (size_t)pos * 32 + 8 * fq; const float* sp = sinM + (size_t)pos * 32 + 8 * fq;
                    const f32x4 c0 = *(const f32x4*)cp, c1 = *(const f32x4*)(cp + 4), s0 = *(const f32x4*)sp, s1 = *(const f32x4*)(sp + 4);
                    const f32x4 x1a = acc[ai][0][m][0] * rs, x1b = acc[ai][0][m][1] * rs, x2a = acc[ai][1][m][0] * rs, x2b = acc[ai][1][m][1] * rs;
                    const f32x4 y1a = x1a * c0 - x2a * s0, y1b = x1b * c1 - x2b * s1, y2a = x1a * s0 + x2a * c0, y2b = x1b * s1 + x2b * c1;
                    st_nt(rp + head * 192 + 128 + 8 * fq, pack8(y1a, y1b)); st_nt(rp + head * 192 + 160 + 8 * fq, pack8(y2a, y2b));
                }
                asm volatile("" ::: "memory"); }
    }
};
struct EpiMlaUkv {
    static constexpr bool PERM = true, AFTER_DRAIN = false, APERM = false, HAS_PRE = false;
    bf16_t* KV; const fx64* ssq_kv;
    __device__ __forceinline__ void operator()(const f32x4 (&acc)[2][2][4][2], const Unit& u, int wr, int wc, int fr, int fq) const {
        const int row0 = u.pm * BM + wr * 64 + fr, cl = wc * 32 + 8 * fq;
#pragma unroll
        for (int ai = 0; ai < 2; ++ai)
#pragma unroll
            for (int m = 0; m < 4; ++m) { const int r = row0 + ai * HALF + m * 16;
                const float ss = fx_load(ssq_kv + r);
                const float rs = __builtin_amdgcn_rsqf(ss * (1.0f / 512.0f) + 1e-6f);
                bf16_t* rp = KV + (size_t)r * 4096 + (size_t)u.pn * 256 + cl;
#pragma unroll
                for (int bj = 0; bj < 2; ++bj) st_nt(rp + bj * HALF, pack8(acc[ai][bj][m][0] * rs, acc[ai][bj][m][1] * rs)); }
    }
};
#define DPP_ROR(x, n) __builtin_bit_cast(float, __builtin_amdgcn_update_dpp(0, __builtin_bit_cast(int, (float)(x)), 0x120 + (n), 0xf, 0xf, false))
struct EpiFfnUp {
    static constexpr bool PERM = true, AFTER_DRAIN = false, APERM = true, HAS_PRE = true;
    bf16_t *A, *EG, *EU; const float *cw, *cb; LnCorr lc;
    __device__ __forceinline__ void prefetch(const Unit& u, PG8_LAS unsigned char* pfa, int wid, int lane) const { ln_prefetch(lc, u, pfa, wid, lane); }
    __device__ __forceinline__ void pre(f32x4 (&acc)[2][2][4][2], const Unit& u, int wr, int wc, int fr, int fq, const PG8_LAS unsigned char* pfa) const { ln_correct<true, true>(lc, acc, wr, wc, fr, fq, pfa); }
    __device__ __forceinline__ void operator()(const f32x4 (&acc)[2][2][4][2], const Unit& u, int wr, int wc, int fr, int fq) const {
        const int ch0 = u.pn * 128 + wc * 32 + 8 * fq;
        f32x4 w0[2], w1[2], w2[2], bb[2];
#pragma unroll
        for (int n = 0; n < 2; ++n) { w0[n] = *(const f32x4*)(cw + ch0 + 4 * n); w1[n] = *(const f32x4*)(cw + FFN + ch0 + 4 * n); w2[n] = *(const f32x4*)(cw + 2 * FFN + ch0 + 4 * n); bb[n] = *(const f32x4*)(cb + ch0 + 4 * n); }
#pragma unroll
        for (int ai = 0; ai < 2; ++ai) {
            const int rblk = u.pm * BM + ai * HALF + wr * 64; const int blk = rblk >> 6;
            f32x4 P[2], Nx[2];
#pragma unroll
            for (int n = 0; n < 2; ++n)
#pragma unroll
                for (int e = 0; e < 4; ++e) { P[n][e] = DPP_ROR(acc[ai][1][3][n][e], 1); Nx[n][e] = DPP_ROR(acc[ai][1][0][n][e], 15); }
#pragma unroll
            for (int m = 0; m < 4; ++m) {
                f32x4 av[2];
#pragma unroll
                for (int n = 0; n < 2; ++n) {
                    const f32x4 gp = (m == 0) ? P[n] : acc[ai][1][m > 0 ? m - 1 : 0][n], gn = (m == 3) ? Nx[n] : acc[ai][1][m < 3 ? m + 1 : 3][n], gc = acc[ai][1][m][n];
                    f32x4 t = gp * w0[n] + gc * w1[n] + gn * w2[n] + bb[n];
#pragma unroll
                    for (int e = 0; e < 4; ++e) t[e] = t[e] * __builtin_amdgcn_rcpf(1.0f + __expf(-t[e]));
                    av[n] = t * acc[ai][0][m][n];
                }
                const int r = rblk + 4 * fr + m;
                const bool edge = (m == 0 && fr == 0) || (m == 3 && fr == 15);
                if (!edge) st_nt(A + (size_t)r * FFN + ch0, pack8(av[0], av[1]));
                if (m < 2 && fr == 0) { *(u32x4*)(EG + ((size_t)blk * 4 + m) * FFN + ch0) = pack8(acc[ai][1][m][0], acc[ai][1][m][1]);
                    if (m == 0) *(u32x4*)(EU + ((size_t)blk * 2) * FFN + ch0) = pack8(acc[ai][0][0][0], acc[ai][0][0][1]); }
                if (m >= 2 && fr == 15) { *(u32x4*)(EG + ((size_t)blk * 4 + m) * FFN + ch0) = pack8(acc[ai][1][m][0], acc[ai][1][m][1]);
                    if (m == 3) *(u32x4*)(EU + ((size_t)blk * 2 + 1) * FFN + ch0) = pack8(acc[ai][0][3][0], acc[ai][0][3][1]); }
            }
        }
    }
};
}

typedef GAS unsigned gu32;
#define RLX_AGENT __ATOMIC_RELAXED, __HIP_MEMORY_SCOPE_AGENT
#define LDS_WAIT() asm volatile("s_waitcnt lgkmcnt(0)" ::: "memory")
#define VM_WAIT() asm volatile("s_waitcnt vmcnt(0)" ::: "memory")
#define SBAR() __builtin_amdgcn_sched_barrier(0)

#define XB_TMO      128
#define XB_XCNT(j)  (256  + 64 * (j))
#define XB_XSUB(j)  (1280 + 64 * (j))
#define XB_XGEN(j)  (2304 + 64 * (j))
#define XB_TOP      3328
#define XB_TOPGEN   3392
#define XCD_BAR_WORDS 3456
#define XB_SPIN_CAP (1u << 22)

__device__ __forceinline__ unsigned xb_ld(unsigned* p)              { return __hip_atomic_load(p, __ATOMIC_RELAXED, __HIP_MEMORY_SCOPE_AGENT); }
__device__ __forceinline__ unsigned xb_add(unsigned* p, unsigned v) { return __hip_atomic_fetch_add(p, v, __ATOMIC_RELAXED, __HIP_MEMORY_SCOPE_AGENT); }
__device__ __forceinline__ unsigned xb_xcc_id() { return (unsigned)__builtin_amdgcn_s_getreg((3 << 11) | 20) & 0xFu; }
#define XB_SPIN(cond, bar) do { unsigned _sp = 0; while (cond) { __builtin_amdgcn_s_sleep(1); \
    if ((++_sp & 255u) == 0u) { if (xb_ld(&(bar)[XB_TMO])) break; if (_sp > XB_SPIN_CAP) { atomicAdd(&(bar)[XB_TMO], 1u); break; } } } } while (0)

struct XcdBarrier {
    unsigned* bar; unsigned x;
    volatile LAS unsigned* st;
};

__device__ __forceinline__ XcdBarrier xcd_barrier_post(unsigned* bar, volatile LAS unsigned* st) {
    XcdBarrier b; b.bar = bar; b.x = xb_xcc_id(); b.st = st;
    if (threadIdx.x == 0) (void)xb_add(&bar[XB_XCNT(b.x)], 1u);
    return b;
}
__device__ __forceinline__ void xcd_barrier_complete(unsigned* bar, unsigned x, unsigned& nloc, unsigned& nx) {
    const unsigned G = gridDim.x * gridDim.y * gridDim.z;
    unsigned sum, cnt, mine, sp = 0u;
    for (;;) {
        sum = 0u; cnt = 0u; mine = 0u;
#pragma unroll
        for (unsigned j = 0; j < 16; ++j) { const unsigned c = xb_ld(&bar[XB_XCNT(j)]); sum += c; cnt += (c > 0u) ? 1u : 0u; mine = (j == x) ? c : mine; }
        if (sum == G) break;
        __builtin_amdgcn_s_sleep(1);
        if ((++sp & 255u) == 0u) { if (xb_ld(&bar[XB_TMO])) break; if (sp > XB_SPIN_CAP) { atomicAdd(&bar[XB_TMO], 1u); break; } }
    }
    nloc = mine > 0u ? mine : 1u; nx = cnt > 0u ? cnt : 1u;
}

__device__ __forceinline__ void xcd_barrier(const XcdBarrier& b) {
    asm volatile("s_waitcnt vmcnt(0)" ::: "memory");
    __syncthreads();
    if (threadIdx.x == 0) {
        unsigned* bar = b.bar;
        __builtin_amdgcn_s_waitcnt(0);
        unsigned nloc = b.st[0], nx = b.st[1];
        if (nloc == 0u) { xcd_barrier_complete(bar, b.x, nloc, nx); b.st[0] = nloc; b.st[1] = nx; }
        const unsigned old = xb_add(&bar[XB_XSUB(b.x)], 1u);
        const unsigned gen = old / nloc;
        if (old + 1u == (gen + 1u) * nloc) {
            __builtin_amdgcn_fence(__ATOMIC_RELEASE, "agent");
            asm volatile("s_waitcnt vmcnt(0)" ::: "memory");
            const unsigned og = xb_add(&bar[XB_TOP], 1u);
            const unsigned tg = og / nx;
            if (og + 1u == (tg + 1u) * nx) xb_add(&bar[XB_TOPGEN], 1u);
            else XB_SPIN(xb_ld(&bar[XB_TOPGEN]) == tg, bar);
            __builtin_amdgcn_fence(__ATOMIC_ACQUIRE, "agent");
            xb_add(&bar[XB_XGEN(b.x)], 1u);
            asm volatile("s_waitcnt vmcnt(0)" ::: "memory");
        } else {
            XB_SPIN(xb_ld(&bar[XB_XGEN(b.x)]) == gen, bar);
            __builtin_amdgcn_fence(__ATOMIC_ACQUIRE, "agent");
            asm volatile("s_waitcnt vmcnt(0)" ::: "memory");
        }
    }
    __syncthreads();
}


constexpr size_t MiB = 1u << 20;
constexpr size_t WS_CTL = 0, CTL_ZERO_BYTES = 8 * MiB;
constexpr int    CW_BAR = 4096;
constexpr size_t CTL_SSQ = 1 * MiB;
constexpr size_t CTL_LGTAB = 64 * 1024;
constexpr size_t CTL_STATS = 2 * MiB;
constexpr size_t CTL_CSB2 = 6 * MiB;
constexpr size_t CTL_CSF = 8 * MiB;
constexpr size_t WS_TAB = 9 * MiB;
constexpr size_t WS_W = 19 * MiB;
constexpr size_t WS_XB = 149 * MiB;
constexpr size_t WS_WD2 = 277 * MiB;
constexpr size_t WS_ACT = 357 * MiB;
constexpr size_t WS_END = WS_ACT + 1024 * MiB;
constexpr size_t W_RET_OUT = 0, W_UP = 16 * MiB, W_DOWN = 60 * MiB, W_RET_IN = 82 * MiB;
constexpr size_t W_MLA_OUT = 0, W_MLA_IN = 82 * MiB, W_MLA_UQ = 92 * MiB, W_MLA_UKV = 102 * MiB;
constexpr size_t A_RQ = 0, A_RK = 128 * MiB, A_RV = 256 * MiB, A_RG = 512 * MiB, A_RO = 768 * MiB;
constexpr size_t A_FU = 0, A_FG = 352 * MiB;
constexpr size_t A_MCQ = 0, A_MCKV = 96 * MiB, A_MKR = 128 * MiB, A_MQA = 132 * MiB, A_MKV = 324 * MiB, A_MO = 580 * MiB;

constexpr int RING_OFF = 0, RING_BYTES = 159744;
constexpr int LDSCTL_OFF = RING_BYTES, MISC_OFF = LDSCTL_OFF + 320;
constexpr int LDS_BYTES = 163840;
constexpr int NWAVES = 8;


struct Frame {
    LAS unsigned char* lds;
    int wave;
    int vcu, G;
    int gw, NGW;
};

#define PHASE_TID(tid, lane) int tid = threadIdx.x; asm volatile("" : "+v"(tid)); const int lane = tid & 63; int gw_ = F.gw; asm volatile("" : "+s"(gw_)); const int gw = gw_, NGW = 2048; (void)gw; (void)NGW

__device__ __forceinline__ float wave_sum(float v) {
#pragma unroll
    for (int o = 1; o < 64; o <<= 1) v += __shfl_xor(v, o);
    return v;
}

__device__ __forceinline__ void tr_item(const float* __restrict__ W, int K, int N, bf16* WT, int k0, int n0, int drow0, float sc, const float* __restrict__ ks, const float* __restrict__ bln, fx64* csp, fx64* b2p, LAS float* scr, int lane) {
    float pc = 0.f, pb = 0.f;
#pragma unroll 8
    for (int i = 0; i < 32; ++i) { const int kk = 2 * i + (lane >> 5); const float w = W[(size_t)(k0 + kk) * N + n0 + (lane & 31)] * sc; float v = w; if (ks) v *= ks[k0 + kk]; scr[kk * 33 + (lane & 31)] = v;
        if (csp) { pc += v; pb += w * bln[k0 + kk]; } }
    if (csp) {
        pc += __shfl_xor(pc, 32); pb += __shfl_xor(pb, 32);
        if (lane < 32) { fx_add(csp + drow0 + lane, pc); fx_add(b2p + drow0 + lane, pb); } }
    LDS_WAIT(); asm volatile("" ::: "memory");
    const int c = lane & 7;
#pragma unroll
    for (int j = 0; j < 4; ++j) { const int n = (lane >> 3) + 8 * j; const LAS float* s = scr + (8 * c) * 33 + n;
        v4u o; o.x = pkbf(s[0 * 33], s[1 * 33]); o.y = pkbf(s[2 * 33], s[3 * 33]); o.z = pkbf(s[4 * 33], s[5 * 33]); o.w = pkbf(s[6 * 33], s[7 * 33]);
        *(GAS v4u*)(WT + (size_t)(drow0 + n) * K + k0 + 8 * c) = o; }
    LDS_WAIT(); asm volatile("" ::: "memory");
}
__device__ __forceinline__ int rowmap_mla_in(int nb) { return nb < 64 ? 32 * nb : (nb == 64 ? 2048 : 2048 + 128); }
__device__ __forceinline__ int rowmap_uq(int nb) { const int head = nb / 6, w = nb % 6; return w < 4 ? head * 128 + 32 * w : 2048 + (head >> 2) * 256 + (w == 5 ? 128 : 0) + (head & 3) * 32; }

__device__ __forceinline__ void convert_matrix(const Frame& F, const float* W, int K, int N, bf16* WT, int mode, float sc, const float* ks, const float* bln, fx64* csb, LAS float* scr) {
    PHASE_TID(tid, lane); (void)tid;
    const int nblk = N / 32, nitems = (K / 64) * nblk;
    for (int it = gw; it < nitems; it += NGW) {
        const int kb = it / nblk, nb = it % nblk;
        int drow = 32 * nb; float s = sc;
        if (mode == 1) { if (nb >= 64 && nb < 128) s = 0.0625f; }
        else if (mode == 2) drow = rowmap_mla_in(nb);
        else if (mode == 3) drow = rowmap_uq(nb);
        else if (mode == 4) drow = nb < 176 ? (nb >> 2) * 256 + 32 * (nb & 3) : ((nb - 176) >> 2) * 256 + 128 + 32 * ((nb - 176) & 3);
        tr_item(W, K, N, WT, 64 * kb, 32 * nb, drow, s, ks, bln, csb, csb + 16384, scr, lane);
    }
}

__device__ __forceinline__ void csb2_finalize(const Frame& F, const fx64* src, float* dst, int n) {
    PHASE_TID(tid, lane); (void)tid;
    for (int i = gw * 64 + lane; i < n; i += NGW * 64) dst[i] = fx_load(src + i);
}

__device__ __forceinline__ void ln_pass(const Frame& F, float* Y, bf16* XB, float* stats, const float* __restrict__ g, const float* __restrict__ b, bool final) {
    PHASE_TID(tid, lane); (void)tid;
    for (int m = gw; m < T; m += NGW) {
        GAS f32x4* xr = (GAS f32x4*)(Y + (size_t)m * DM) + lane;
        f32x4 v[8]; float s = 0.f;
#pragma unroll
        for (int j = 0; j < 8; ++j) { v[j] = xr[64 * j]; s += (v[j].x + v[j].y) + (v[j].z + v[j].w); }
        const float mean = wave_sum(s) * (1.f / DM); float s2 = 0.f;
#pragma unroll
        for (int j = 0; j < 8; ++j) { v[j] = v[j] - mean; s2 += (v[j].x * v[j].x + v[j].y * v[j].y) + (v[j].z * v[j].z + v[j].w * v[j].w); }
        const float rstd = 1.0f / sqrtf(wave_sum(s2) * (1.f / DM) + 1e-5f);
        GAS v2u* o8 = (GAS v2u*)(XB + (size_t)m * DM) + lane;
        if (!final && lane == 0) { stats[2 * m] = mean; stats[2 * m + 1] = rstd; }
#pragma unroll
        for (int j = 0; j < 8; ++j) { const f32x4 gg = *((const f32x4*)g + 64 * j + lane), bb = *((const f32x4*)b + 64 * j + lane);
            const f32x4 y = v[j] * rstd * gg + bb;
            if (final) xr[64 * j] = y; else { v2u w; w.x = pkbf(y.x, y.y); w.y = pkbf(y.z, y.w); o8[64 * j] = w; } }
    }
}

__device__ __forceinline__ void gate_pass(const Frame& F, const bf16* O, const bf16* OB, bf16* G, bf16* D) {
    PHASE_TID(tid, lane); (void)tid;
    for (int m = gw; m < T; m += NGW) {
        const GAS v4u* orow = (const GAS v4u*)(O + (size_t)m * 4096) + lane; const GAS v4u* brow = (const GAS v4u*)(OB + (size_t)m * 4096) + lane; GAS v4u* grow = (GAS v4u*)(G + (size_t)m * 4096) + lane; GAS v4u* drow = (GAS v4u*)(D + (size_t)m * 4096) + lane;
#pragma unroll
        for (int hp = 0; hp < 8; hp += 4) {
            v4u ov[4], bv[4], gv[4];
#pragma unroll
            for (int h = 0; h < 4; ++h) { ov[h] = orow[64 * (hp + h)]; bv[h] = brow[64 * (hp + h)]; gv[h] = grow[64 * (hp + h)]; }
#pragma unroll
            for (int h = 0; h < 4; ++h) {
                float x[8]; x[0] = bflo(ov[h].x) + bflo(bv[h].x); x[1] = bfhi(ov[h].x) + bfhi(bv[h].x); x[2] = bflo(ov[h].y) + bflo(bv[h].y); x[3] = bfhi(ov[h].y) + bfhi(bv[h].y);
                x[4] = bflo(ov[h].z) + bflo(bv[h].z); x[5] = bfhi(ov[h].z) + bfhi(bv[h].z); x[6] = bflo(ov[h].w) + bflo(bv[h].w); x[7] = bfhi(ov[h].w) + bfhi(bv[h].w);
                float gt[8]; gt[0] = bflo(gv[h].x); gt[1] = bfhi(gv[h].x); gt[2] = bflo(gv[h].y); gt[3] = bfhi(gv[h].y); gt[4] = bflo(gv[h].z); gt[5] = bfhi(gv[h].z); gt[6] = bflo(gv[h].w); gt[7] = bfhi(gv[h].w);
                float s = 0.f;
#pragma unroll
                for (int e = 0; e < 8; ++e) s += x[e];
                const float mean = wave_sum(s) * (1.f / 512.f); float s2 = 0.f;
#pragma unroll
                for (int e = 0; e < 8; ++e) { x[e] -= mean; s2 += x[e] * x[e]; }
                const float rstd = __builtin_amdgcn_rsqf(wave_sum(s2) * (1.f / 512.f) + 1e-6f);
                float y[8];
#pragma unroll
                for (int e = 0; e < 8; ++e) { const float sg = gt[e] * __builtin_amdgcn_rcpf(1.0f + __expf(-gt[e])); y[e] = sg * x[e] * rstd; }
                v4u w; w.x = pkbf(y[0], y[1]); w.y = pkbf(y[2], y[3]); w.z = pkbf(y[4], y[5]); w.w = pkbf(y[6], y[7]);
                drow[64 * (hp + h)] = w;
            }
        }
    }
}

__device__ __forceinline__ void conv_pass(const Frame& F, bf16* U, const bf16* G, const float* __restrict__ cw, const float* __restrict__ cb) {
    PHASE_TID(tid, lane); (void)tid;
    constexpr int NCB = FFN / 512, NTB = T / 32;
    for (int it = gw; it < NCB * NTB; it += NGW) {
        const int cbk = it % NCB, tb = it / NCB; const int c0 = cbk * 512 + lane * 8, t0 = tb * 32;
        float w0[8], w1[8], w2[8], bb[8];
#pragma unroll
        for (int e = 0; e < 8; ++e) { w0[e] = cw[c0 + e]; w1[e] = cw[FFN + c0 + e]; w2[e] = cw[2 * FFN + c0 + e]; bb[e] = cb[c0 + e]; }
        const int p0 = seq_pos(t0), L = t0 < TP ? 8192 : 2048;
        const GAS v4u* gp = (const GAS v4u*)(G + (size_t)t0 * FFN + c0); GAS v4u* up = (GAS v4u*)(U + (size_t)t0 * FFN + c0);
        constexpr int RS = FFN / 8;
        const float fprev = p0 > 0 ? 1.f : 0.f;
        v4u prev = gp[p0 > 0 ? -RS : 0], cur = gp[0];
#pragma unroll 4
        for (int t = 0; t < 32; ++t) {
            const bool has_n = (p0 + t + 1 < L); const float fnext = has_n ? 1.f : 0.f; const float fp = (t == 0) ? fprev : 1.f;
            const v4u nxt = gp[(size_t)(has_n ? t + 1 : t) * RS]; const v4u uu = up[(size_t)t * RS];
            float a[8], c[8], n[8], u8[8], y[8];
            a[0] = bflo(prev.x); a[1] = bfhi(prev.x); a[2] = bflo(prev.y); a[3] = bfhi(prev.y); a[4] = bflo(prev.z); a[5] = bfhi(prev.z); a[6] = bflo(prev.w); a[7] = bfhi(prev.w);
            c[0] = bflo(cur.x); c[1] = bfhi(cur.x); c[2] = bflo(cur.y); c[3] = bfhi(cur.y); c[4] = bflo(cur.z); c[5] = bfhi(cur.z); c[6] = bflo(cur.w); c[7] = bfhi(cur.w);
            n[0] = bflo(nxt.x); n[1] = bfhi(nxt.x); n[2] = bflo(nxt.y); n[3] = bfhi(nxt.y); n[4] = bflo(nxt.z); n[5] = bfhi(nxt.z); n[6] = bflo(nxt.w); n[7] = bfhi(nxt.w);
            u8[0] = bflo(uu.x); u8[1] = bfhi(uu.x); u8[2] = bflo(uu.y); u8[3] = bfhi(uu.y); u8[4] = bflo(uu.z); u8[5] = bfhi(uu.z); u8[6] = bflo(uu.w); u8[7] = bfhi(uu.w);
#pragma unroll
            for (int e = 0; e < 8; ++e) { const float gcv = fp * a[e] * w0[e] + c[e] * w1[e] + fnext * n[e] * w2[e] + bb[e]; y[e] = gcv * __builtin_amdgcn_rcpf(1.0f + __expf(-gcv)) * u8[e]; }
            v4u w; w.x = pkbf(y[0], y[1]); w.y = pkbf(y[2], y[3]); w.z = pkbf(y[4], y[5]); w.w = pkbf(y[6], y[7]);
            up[(size_t)t * RS] = w; prev = cur; cur = nxt;
        }
    }
}


__device__ __forceinline__ void ffn_fixup(const Frame& F, bf16* A, const bf16* EG, const bf16* EU, const float* __restrict__ cw, const float* __restrict__ cb) {
    PHASE_TID(tid, lane); (void)tid;
    constexpr int NCB = FFN / 512, NER = (T / 64) * 2;
    for (int it = gw; it < NCB * NER; it += NGW) {
        const int cbk = it % NCB, er = it / NCB, blk = er >> 1, last = er & 1; const int c0 = cbk * 512 + lane * 8;
        const int r = blk * 64 + (last ? 63 : 0); const int pos = seq_pos(r), L = r < TP ? 8192 : 2048;
        const bool hasp = pos > 0, hasn = pos < L - 1;
        const size_t ip = last ? (size_t)blk * 4 + 2 : (hasp ? (size_t)(blk - 1) * 4 + 3 : (size_t)blk * 4);
        const size_t ic = last ? (size_t)blk * 4 + 3 : (size_t)blk * 4;
        const size_t in = last ? (hasn ? (size_t)(blk + 1) * 4 : (size_t)blk * 4 + 3) : (size_t)blk * 4 + 1;
        const float fp = (last || hasp) ? 1.f : 0.f, fn = (!last || hasn) ? 1.f : 0.f;
        const v4u gp = *(const GAS v4u*)(EG + ip * FFN + c0), gc = *(const GAS v4u*)(EG + ic * FFN + c0), gn = *(const GAS v4u*)(EG + in * FFN + c0);
        const v4u uu = *(const GAS v4u*)(EU + ((size_t)blk * 2 + last) * FFN + c0);
        float a[8], c[8], n[8], u8[8], y[8];
        a[0] = bflo(gp.x); a[1] = bfhi(gp.x); a[2] = bflo(gp.y); a[3] = bfhi(gp.y); a[4] = bflo(gp.z); a[5] = bfhi(gp.z); a[6] = bflo(gp.w); a[7] = bfhi(gp.w);
        c[0] = bflo(gc.x); c[1] = bfhi(gc.x); c[2] = bflo(gc.y); c[3] = bfhi(gc.y); c[4] = bflo(gc.z); c[5] = bfhi(gc.z); c[6] = bflo(gc.w); c[7] = bfhi(gc.w);
        n[0] = bflo(gn.x); n[1] = bfhi(gn.x); n[2] = bflo(gn.y); n[3] = bfhi(gn.y); n[4] = bflo(gn.z); n[5] = bfhi(gn.z); n[6] = bflo(gn.w); n[7] = bfhi(gn.w);
        u8[0] = bflo(uu.x); u8[1] = bfhi(uu.x); u8[2] = bflo(uu.y); u8[3] = bfhi(uu.y); u8[4] = bflo(uu.z); u8[5] = bfhi(uu.z); u8[6] = bflo(uu.w); u8[7] = bfhi(uu.w);
#pragma unroll
        for (int e = 0; e < 8; ++e) { const float gcv = fp * a[e] * cw[c0 + e] + c[e] * cw[FFN + c0 + e] + fn * n[e] * cw[2 * FFN + c0 + e] + cb[c0 + e]; y[e] = gcv * __builtin_amdgcn_rcpf(1.0f + __expf(-gcv)) * u8[e]; }
        v4u w; w.x = pkbf(y[0], y[1]); w.y = pkbf(y[2], y[3]); w.z = pkbf(y[4], y[5]); w.w = pkbf(y[6], y[7]);
        *(GAS v4u*)(A + (size_t)r * FFN + c0) = w;
    }
}

__device__ __forceinline__ float log2_sigmoid(float x) { return (float)(-log1p(exp(-(double)x)) * 1.4426950408889634); }
__device__ __forceinline__ void prologue(const Frame& F, const float* xp, const float* xs, float* X, bf16* XB, float* cosR, float* sinR, float* cosM, float* sinM, const float* dfw, const float* dbw, float* lgtab) {
    PHASE_TID(tid, lane); (void)tid;
    if (gw == 0 && lane < 32) { const int jl = lane >> 4, head = (lane >> 1) & 7; lgtab[lane] = log2_sigmoid((lane & 1) ? dbw[jl * 8 + head] : dfw[jl * 8 + head]); }
    const int gt = gw * 64 + lane, NGT = NGW * 64;
    for (int i = gt; i < 8192 * 128; i += NGT) { const int pos = i >> 7, d = i & 127;
        const float e = (float)d * (2.0f / 256.0f); const float inv = 1.0f / powf(10000.0f, e); const float ang = (float)pos * inv;
        cosR[i] = cosf(ang); sinR[i] = sinf(ang); }
    for (int i = gt; i < 8192 * 32; i += NGT) { const int pos = i >> 5, d = i & 31;
        const float e = (float)d * (2.0f / 64.0f); const float inv = 1.0f / powf(10000.0f, e); const float ang = (float)pos * inv;
        cosM[i] = cosf(ang); sinM[i] = sinf(ang); }
    for (int m = gw; m < T; m += NGW) {
        const GAS f32x4* src = (const GAS f32x4*)((m < TP ? xp + (size_t)m * DM : xs + (size_t)(m - TP) * DM)) + lane;
        GAS v2u* o8 = (GAS v2u*)(XB + (size_t)m * DM) + lane;
#pragma unroll
        for (int j = 0; j < 8; ++j) { const f32x4 v = src[64 * j]; v2u w; w.x = pkbf(v.x, v.y); w.y = pkbf(v.z, v.w); o8[64 * j] = w; }
    }
}

#ifndef RETD
#define RETD 0
#endif
namespace ret {
constexpr int C = 64, W = 128, LQ = 264, LV = 136, LP = 72;
constexpr int OFF_Q = 0, OFF_K = 33792, OFF_V = 67584, OFF_VZ = 84992, OFF_P = 102400, OFF_OS = 111616, LDS_END = 129024;
static_assert(LDS_END <= RING_BYTES, "retention LDS");
typedef float f4 __attribute__((ext_vector_type(4)));
typedef float f2v __attribute__((ext_vector_type(2)));
typedef __bf16 b2v __attribute__((ext_vector_type(2)));
__device__ __forceinline__ unsigned pkbf_c(float lo, float hi) { const f2v v = {lo, hi}; return __builtin_bit_cast(unsigned, __builtin_convertvector(v, b2v)); }

__device__ __forceinline__ bf16x8 frag_rm(const LAS unsigned char* lds, int off, int ld, int r0, int k0, int lane) {
    return *(const LAS bf16x8*)(lds + off + ((r0 + (lane & 15)) * ld + k0 + 8 * (lane >> 4)) * 2);
}
template <int LDB, int K0, int R0> __device__ __forceinline__ void frag_tr_issue(s16x4& lo, s16x4& hi, unsigned base) {
    asm volatile("ds_read_b64_tr_b16 %0, %1 offset:%2" : "=&v"(lo) : "v"(base), "i"(K0 * LDB + R0 * 2) : "memory");
    asm volatile("ds_read_b64_tr_b16 %0, %1 offset:%2" : "=&v"(hi) : "v"(base), "i"(K0 * LDB + R0 * 2 + 4 * LDB) : "memory");
}
#define RET_PK(L, H) (bf16x8){L[0], L[1], L[2], L[3], H[0], H[1], H[2], H[3]}
#define MFMA16(a, b, c) __builtin_amdgcn_mfma_f32_16x16x32_bf16(a, b, c, 0, 0, 0)
#define RET_LWAIT() asm volatile("s_waitcnt lgkmcnt(0)" ::: "memory")

struct Stg { v4u q[4], k[4], v[2]; };

template <bool FWD>
__device__ __forceinline__ void sweep(const Frame& F, const bf16* Qg, const bf16* Kg, const bf16* Vg, bf16* Og, int nchunks, float lgf, float lgb) {
    LAS unsigned char* lds = F.lds + RING_OFF;
    int tid_l = threadIdx.x; asm volatile("" : "+v"(tid_l));
    const int tid = tid_l, lane = tid & 63, wid = __builtin_amdgcn_readfirstlane(tid >> 6), g = lane >> 4, i = lane & 15;
    const int nb = wid >> 1, cb = wid & 1;
    const int dvw = 16 * wid;
    const float lg = FWD ? lgf : lgb;
    const float gch = __builtin_amdgcn_exp2f(lg * (float)C);
    const int vrow = tid >> 4, vch = tid & 15;
    const float zeta0 = __builtin_amdgcn_exp2f(lg * (FWD ? (float)(C - 1 - vrow) : (float)vrow));
    const float zeta1 = __builtin_amdgcn_exp2f(lg * (FWD ? (float)(C - 1 - 32 - vrow) : (float)(32 + vrow)));
    const unsigned ldsb = (unsigned)(uintptr_t)lds;
    const unsigned trK = ldsb + OFF_K + (unsigned)((8 * g + (i >> 2)) * (LQ * 2) + 8 * (i & 3));
    const unsigned trVZ = ldsb + OFF_VZ + (unsigned)((8 * g + (i >> 2)) * (LV * 2) + (dvw + 4 * (i & 3)) * 2);
    const unsigned trV = ldsb + OFF_V + (unsigned)((8 * g + (i >> 2)) * (LV * 2) + (dvw + 4 * (i & 3)) * 2);
    f4 S[16];
#pragma unroll
    for (int t = 0; t < 16; ++t) S[t] = (f4){0.f, 0.f, 0.f, 0.f};
    Stg st;
    const unsigned voffQ = (unsigned)((tid >> 5) * 4096 + (tid & 31) * 16), voffV = (unsigned)(vrow * 8192 + vch * 16);
#define RET_LOAD(j) do { const GAS unsigned char* qb_ = (const GAS unsigned char*)Qg + (size_t)(j) * (C * 4096); const GAS unsigned char* kb_ = (const GAS unsigned char*)Kg + (size_t)(j) * (C * 4096); \
        const GAS unsigned char* vb_ = (const GAS unsigned char*)Vg + (size_t)(j) * (C * 8192); \
        _Pragma("unroll") for (int a = 0; a < 4; ++a) { st.q[a] = *(const GAS v4u*)(qb_ + a * 65536 + voffQ); st.k[a] = *(const GAS v4u*)(kb_ + a * 65536 + voffQ); } \
        st.v[0] = *(const GAS v4u*)(vb_ + voffV); st.v[1] = *(const GAS v4u*)(vb_ + 262144 + voffV); } while (0)
#define RET_FLUSH(jj) do { GAS unsigned char* ob_ = (GAS unsigned char*)Og + (size_t)(jj) * (C * 8192); \
        _Pragma("unroll") for (int a = 0; a < 2; ++a) { const v4u w = *(const LAS v4u*)(lds + OFF_OS + ((vrow + 32 * a) * LV + vch * 8) * 2); \
        *(GAS v4u*)(ob_ + a * 262144 + voffV) = w; } } while (0)
    const int j0 = FWD ? 0 : nchunks - 1, dj = FWD ? 1 : -1;
    __syncthreads();
    RET_LOAD(j0);
    for (int s = 0; s < nchunks; ++s) {
        const int j = j0 + dj * s;
        const bool do_intra = FWD ? ((j & 1) == 0) : ((j & 1) == 1);
        __syncthreads();
#pragma unroll
        for (int a = 0; a < 4; ++a) { const int id = tid + 512 * a, row = id >> 5, ch = id & 31;
            *(LAS v4u*)(lds + OFF_Q + (row * LQ + ch * 8) * 2) = st.q[a]; *(LAS v4u*)(lds + OFF_K + (row * LQ + ch * 8) * 2) = st.k[a]; }
#pragma unroll
        for (int a = 0; a < 2; ++a) { const float zt = a ? zeta1 : zeta0; const v4u vv = st.v[a]; const int row = 32 * a + vrow;
            if (do_intra) *(LAS v4u*)(lds + OFF_V + (row * LV + vch * 8) * 2) = vv;
            v4u z; z.x = pkbf(bflo(vv.x) * zt, bfhi(vv.x) * zt); z.y = pkbf(bflo(vv.y) * zt, bfhi(vv.y) * zt);
            z.z = pkbf(bflo(vv.z) * zt, bfhi(vv.z) * zt); z.w = pkbf(bflo(vv.w) * zt, bfhi(vv.w) * zt);
            *(LAS v4u*)(lds + OFF_VZ + (row * LV + vch * 8) * 2) = z; }
        if (s > 0) RET_FLUSH(j - dj);
        __syncthreads();
        f4 o[4];
#pragma unroll
        for (int nt = 0; nt < 4; ++nt) o[nt] = (f4){0.f, 0.f, 0.f, 0.f};
#pragma unroll
        for (int s2 = 0; s2 < 8; ++s2) {
            v4u bw; bw.x = pkbf_c(S[2 * s2][0], S[2 * s2][1]); bw.y = pkbf_c(S[2 * s2][2], S[2 * s2][3]); bw.z = pkbf_c(S[2 * s2 + 1][0], S[2 * s2 + 1][1]); bw.w = pkbf_c(S[2 * s2 + 1][2], S[2 * s2 + 1][3]);
            const bf16x8 bfr = __builtin_bit_cast(bf16x8, bw);
#pragma unroll
            for (int nt = 0; nt < 4; ++nt) {
                const LAS unsigned char* qp = lds + OFF_Q + ((16 * nt + i) * LQ + 32 * s2 + 4 * g) * 2;
                const v2u a0 = *(const LAS v2u*)qp, a1 = *(const LAS v2u*)(qp + 32);
                v4u aw; aw.x = a0.x; aw.y = a0.y; aw.z = a1.x; aw.w = a1.y;
                if (!(RETD & 1)) o[nt] = MFMA16(__builtin_bit_cast(bf16x8, aw), bfr, o[nt]);
            }
        }
#pragma unroll
        for (int nt = 0; nt < 4; ++nt)
#pragma unroll
            for (int r = 0; r < 4; ++r) { const int n = 16 * nt + 4 * g + r; o[nt][r] *= __builtin_amdgcn_exp2f(lg * (FWD ? (float)(n + 1) : (float)(C - n))); }
        if (s + 1 < nchunks) RET_LOAD(j + dj);
        if (do_intra && !(RETD & 4)) {
            f4 s0 = {0.f, 0.f, 0.f, 0.f}, s1 = {0.f, 0.f, 0.f, 0.f};
#pragma unroll
            for (int ks = 0; ks < 8; ++ks) {
                const bf16x8 a = frag_rm(lds, OFF_Q, LQ, 16 * nb, 32 * ks, lane);
                const bf16x8 b0 = frag_rm(lds, OFF_K, LQ, 32 * cb, 32 * ks, lane), b1 = frag_rm(lds, OFF_K, LQ, 32 * cb + 16, 32 * ks, lane);
                s0 = MFMA16(a, b0, s0); s1 = MFMA16(a, b1, s1);
            }
#pragma unroll
            for (int r = 0; r < 4; ++r) { const int n = 16 * nb + 4 * g + r;
                const int m0 = 32 * cb + i, m1 = m0 + 16;
                const float d0 = (m0 <= n) ? __builtin_amdgcn_exp2f(lgf * (float)(n - m0)) : __builtin_amdgcn_exp2f(lgb * (float)(m0 - n));
                const float d1 = (m1 <= n) ? __builtin_amdgcn_exp2f(lgf * (float)(n - m1)) : __builtin_amdgcn_exp2f(lgb * (float)(m1 - n));
                const float p0v = (RETD & 32) ? (float)(n + 1) * 0.01f + (float)m0 * 0.001f : s0[r] * d0, p1v = (RETD & 32) ? (float)(n + 1) * 0.01f + (float)m1 * 0.001f : s1[r] * d1;
                *(LAS unsigned short*)(lds + OFF_P + (n * LP + m0) * 2) = (unsigned short)(pkbf(p0v, 0.f) & 0xffffu);
                *(LAS unsigned short*)(lds + OFF_P + (n * LP + m1) * 2) = (unsigned short)(pkbf(p1v, 0.f) & 0xffffu); }
        }
#pragma unroll
        for (int t = 0; t < 16; ++t) S[t] = S[t] * gch;
        {
            s16x4 bl[2], bh[2], al[2][4], ah[2][4];
            RET_LWAIT(); SBAR();
            frag_tr_issue<LV * 2, 0, 0>(bl[0], bh[0], trVZ);
#define RET_ISSUE_K(BUF, Q1) do { constexpr int ks1_ = (Q1) >> 2, t0_ = 4 * ((Q1) & 3); \
                frag_tr_issue<LQ * 2, 32 * ks1_, 16 * (t0_ + 0)>(al[BUF][0], ah[BUF][0], trK); frag_tr_issue<LQ * 2, 32 * ks1_, 16 * (t0_ + 1)>(al[BUF][1], ah[BUF][1], trK); \
                frag_tr_issue<LQ * 2, 32 * ks1_, 16 * (t0_ + 2)>(al[BUF][2], ah[BUF][2], trK); frag_tr_issue<LQ * 2, 32 * ks1_, 16 * (t0_ + 3)>(al[BUF][3], ah[BUF][3], trK); } while (0)
#define RET_GROUP(Q) do { constexpr int cur_ = (Q) & 1, ks_ = (Q) >> 2; \
                RET_LWAIT(); SBAR(); \
                if constexpr ((Q) + 1 == 4) frag_tr_issue<LV * 2, 32, 0>(bl[1], bh[1], trVZ); \
                if constexpr ((Q) < 7) RET_ISSUE_K(cur_ ^ 1, (Q) + 1); \
                { const bf16x8 b_ = RET_PK(bl[ks_], bh[ks_]); \
                  _Pragma("unroll") for (int t = 0; t < 4; ++t) if (!(RETD & 2)) S[4 * ((Q) & 3) + t] = MFMA16(RET_PK(al[cur_][t], ah[cur_][t]), b_, S[4 * ((Q) & 3) + t]); } \
                SBAR(); } while (0)
            RET_ISSUE_K(0, 0);
            RET_GROUP(0); RET_GROUP(1); RET_GROUP(2); RET_GROUP(3); RET_GROUP(4); RET_GROUP(5); RET_GROUP(6); RET_GROUP(7);
#undef RET_GROUP
#undef RET_ISSUE_K
        }
        __syncthreads();
        if (do_intra && !(RETD & 4)) {
#pragma unroll
            for (int ks = 0; ks < 2; ++ks) {
                s16x4 l0, h0;
                RET_LWAIT();
                if (ks == 0) frag_tr_issue<LV * 2, 0, 0>(l0, h0, trV); else frag_tr_issue<LV * 2, 32, 0>(l0, h0, trV);
                bf16x8 a[4];
#pragma unroll
                for (int nt = 0; nt < 4; ++nt) a[nt] = frag_rm(lds, OFF_P, LP, 16 * nt, 32 * ks, lane);
                RET_LWAIT(); SBAR();
                bf16x8 b = RET_PK(l0, h0);
                if (RETD & 8) { const short one = 0x3f80; b = (bf16x8){one, one, one, one, one, one, one, one}; }
#pragma unroll
                for (int nt = 0; nt < 4; ++nt) { bf16x8 aa = a[nt]; if (RETD & 16) { const short one = 0x3f80; aa = (bf16x8){one, one, one, one, one, one, one, one}; } o[nt] = MFMA16(aa, b, o[nt]); }
            }
        }
#pragma unroll
        for (int nt = 0; nt < 4; ++nt)
#pragma unroll
            for (int r = 0; r < 4; ++r) *(LAS unsigned short*)(lds + OFF_OS + ((16 * nt + 4 * g + r) * LV + dvw + i) * 2) = (unsigned short)(pkbf_c(o[nt][r], 0.f) & 0xffffu);
    }
    __syncthreads();
    RET_FLUSH(j0 + dj * (nchunks - 1));
#undef RET_LOAD
#undef RET_FLUSH
}

__device__ __forceinline__ void unit(const Frame& F, const bf16* Q, const bf16* K, const bf16* V, bf16* O, bf16* OB, int t0, int S, int u, const float* lgtab) {
    const int dir = u & 1, slice = (u >> 1) & 3, head = (u >> 3) & 7;
    const float lgf = __hip_atomic_load(lgtab + 2 * head, __ATOMIC_RELAXED, __HIP_MEMORY_SCOPE_AGENT), lgb = __hip_atomic_load(lgtab + 2 * head + 1, __ATOMIC_RELAXED, __HIP_MEMORY_SCOPE_AGENT);
    const bf16* Qg = Q + (size_t)t0 * 2048 + head * 256; const bf16* Kg = K + (size_t)t0 * 2048 + head * 256;
    const size_t voff = (size_t)t0 * 4096 + head * 512 + slice * W;
    if (dir == 0) sweep<true>(F, Qg, Kg, V + voff, O + voff, S / C, lgf, lgb);
    else          sweep<false>(F, Qg, Kg, V + voff, OB + voff, S / C, lgf, lgb);
}

__device__ __forceinline__ void phase(const Frame& F, const bf16* Q, const bf16* K, const bf16* V, bf16* O, bf16* OB, const float* lgtab) {
    int vcu = F.vcu; asm volatile("" : "+s"(vcu));
    if (vcu < 128) {
        unit(F, Q, K, V, O, OB, (vcu >> 6) * 8192, 8192, vcu & 63, lgtab);
    } else {
        for (int k = 0; k < 4; ++k) { const int u = (vcu - 128) * 4 + k; unit(F, Q, K, V, O, OB, TP + (u >> 6) * 2048, 2048, u & 63, lgtab); }
    }
}
}

#ifndef ATT_EARLY
#define ATT_EARLY 0
#endif
#ifndef ATT_VLATE
#define ATT_VLATE 0
#endif
#ifndef ATT_NPARK
#define ATT_NPARK 8
#endif
namespace att {
constexpr int NW = 8, QBLK = 32, KVBLK = 64, LDQ = 3072, LDKV = 4096, LDKR = 64, LDO = 2048;
constexpr int SHM_V = 16384, SHM_K = 24576, OFF_K = 2 * SHM_V, OFF_WS = OFF_K + 2 * SHM_K, NPARK = ATT_NPARK, OFF_QR = OFF_WS + NW * 64 * 4, SHM_ATTN = OFF_QR + NW * NPARK * 1024;
static_assert(SHM_ATTN <= RING_BYTES, "attention LDS");
constexpr float THR2 = 11.0f;
#define AKSWZ(row, colB) ((row) * 384 + ((colB) ^ (((row) & 7) << 4)))
__device__ __forceinline__ int crow(int r, int hi) { return (r & 3) + 8 * (r >> 2) + 4 * hi; }
__device__ __forceinline__ unsigned cvtpk(float lo, float hi) { unsigned r; asm volatile("v_cvt_pk_bf16_f32 %0, %1, %2" : "=v"(r) : "v"(lo), "v"(hi)); return r; }

__device__ __forceinline__ void partialSM(f32x16& p0, f32x16& p1, float& m_reg, float& mn, float& alpha) {
  float pmax = p0[0];
#pragma unroll
  for (int r = 1; r < 16; ++r) pmax = fmaxf(pmax, p0[r]);
#pragma unroll
  for (int r = 0; r < 16; ++r) pmax = fmaxf(pmax, p1[r]);
  { auto rr = __builtin_amdgcn_permlane32_swap(__float_as_uint(pmax), __float_as_uint(pmax), false, false);
    pmax = fmaxf(__uint_as_float(rr[0]), __uint_as_float(rr[1])); }
  if (__builtin_expect(__all(pmax - m_reg <= THR2), 1)) { mn = m_reg; alpha = 1.f; }
  else { mn = fmaxf(m_reg, pmax); alpha = __builtin_amdgcn_exp2f(m_reg - mn); m_reg = mn; }
#pragma unroll
  for (int r = 0; r < 16; ++r) p0[r] = p0[r] - mn;
#pragma unroll
  for (int r = 0; r < 16; ++r) p1[r] = p1[r] - mn;
#pragma unroll
  for (int r = 0; r < 16; ++r) p0[r] = __builtin_amdgcn_exp2f(p0[r]);
}
__device__ __forceinline__ void finishSM(f32x16& p0, f32x16& p1, float alpha, float& l_reg, bf16x8& pa0, bf16x8& pa1, bf16x8& pa2, bf16x8& pa3) {
#pragma unroll
  for (int r = 0; r < 16; ++r) p1[r] = __builtin_amdgcn_exp2f(p1[r]);
  float ps = 0;
#pragma unroll
  for (int r = 0; r < 16; ++r) ps += p0[r];
#pragma unroll
  for (int r = 0; r < 16; ++r) ps += p1[r];
  { auto rr = __builtin_amdgcn_permlane32_swap(__float_as_uint(ps), __float_as_uint(ps), false, false);
    ps = __uint_as_float(rr[0]) + __uint_as_float(rr[1]); }
  l_reg = l_reg * alpha + ps;
#define PK4(P, BASE, OUT) do { unsigned a0 = cvtpk(P[BASE + 0], P[BASE + 1]), a1 = cvtpk(P[BASE + 2], P[BASE + 3]);   \
    unsigned b0 = cvtpk(P[BASE + 4], P[BASE + 5]), b1 = cvtpk(P[BASE + 6], P[BASE + 7]);                              \
    auto r0 = __builtin_amdgcn_permlane32_swap(a0, b0, false, false); auto r1 = __builtin_amdgcn_permlane32_swap(a1, b1, false, false); \
    v4u w = {r0[0], r1[0], r0[1], r1[1]}; OUT = *reinterpret_cast<bf16x8*>(&w); } while (0)
  PK4(p0, 0, pa0); PK4(p0, 8, pa1); PK4(p1, 0, pa2); PK4(p1, 8, pa3);
#undef PK4
}
__device__ __forceinline__ void qkt(f32x16& p0, f32x16& p1, const LAS unsigned char* Ks, const bf16x8* qr, const LAS unsigned char* qrl, int r32, int hi) {
  p0 = f32x16{}; p1 = f32x16{};
#pragma unroll
  for (int d0 = 0; d0 < 12; ++d0) { const int cb = (d0 * 16 + hi * 8) * 2;
    const bf16x8 b0 = *reinterpret_cast<const LAS bf16x8*>(Ks + AKSWZ(r32, cb));
    const bf16x8 b1 = *reinterpret_cast<const LAS bf16x8*>(Ks + AKSWZ(32 + r32, cb));
    const bf16x8 q = d0 < 12 - NPARK ? qr[d0 < 12 - NPARK ? d0 : 0] : *reinterpret_cast<const LAS bf16x8*>(qrl + (d0 - (12 - NPARK)) * 1024);
    p0 = __builtin_amdgcn_mfma_f32_32x32x16_bf16(b0, q, p0, 0, 0, 0);
    p1 = __builtin_amdgcn_mfma_f32_32x32x16_bf16(b1, q, p1, 0, 0, 0); }
}
__device__ __forceinline__ int v_st(int k, int c) { const int kk = (k & ~0xC) | ((k & 4) << 1) | ((k & 8) >> 1); return ((kk >> 3) * 4 + (c >> 5)) * 512 + ((kk & 7) * 32 + (c & 31)) * 2; }
__device__ __forceinline__ int v_rd_base(int lane) { return ((lane & 3) << 3) | (((lane >> 2) & 3) << 6) | (((lane >> 4) & 1) << 5) | (((lane >> 5) & 1) << 8); }
constexpr int v_rd_off(int d0, int ks, int half) { return d0 * 512 + ks * 4096 + half * 2048; }
template <int OFF> __device__ __forceinline__ s16x4 tr_read(int vb) {
  s16x4 r; asm volatile("ds_read_b64_tr_b16 %0, %1 offset:%2" : "=&v"(r) : "v"(vb), "i"(OFF) : "memory"); return r;
}
template <int D0> __device__ __forceinline__ void pv_one(f32x16& od, int vb, bf16x8 pa0, bf16x8 pa1, bf16x8 pa2, bf16x8 pa3) {
  const s16x4 l0 = tr_read<v_rd_off(D0, 0, 0)>(vb), h0 = tr_read<v_rd_off(D0, 0, 1)>(vb), l1 = tr_read<v_rd_off(D0, 1, 0)>(vb), h1 = tr_read<v_rd_off(D0, 1, 1)>(vb);
  const s16x4 l2 = tr_read<v_rd_off(D0, 2, 0)>(vb), h2 = tr_read<v_rd_off(D0, 2, 1)>(vb), l3 = tr_read<v_rd_off(D0, 3, 0)>(vb), h3 = tr_read<v_rd_off(D0, 3, 1)>(vb);
  asm volatile("s_waitcnt lgkmcnt(0)" ::: "memory"); SBAR();
#define APK(L, H) (bf16x8){L[0], L[1], L[2], L[3], H[0], H[1], H[2], H[3]}
  od = __builtin_amdgcn_mfma_f32_32x32x16_bf16(pa0, APK(l0, h0), od, 0, 0, 0);
  od = __builtin_amdgcn_mfma_f32_32x32x16_bf16(pa1, APK(l1, h1), od, 0, 0, 0);
  od = __builtin_amdgcn_mfma_f32_32x32x16_bf16(pa2, APK(l2, h2), od, 0, 0, 0);
  od = __builtin_amdgcn_mfma_f32_32x32x16_bf16(pa3, APK(l3, h3), od, 0, 0, 0);
#undef APK
}
__device__ __forceinline__ void pv_d0(f32x16* o, int vb, bf16x8 pa0, bf16x8 pa1, bf16x8 pa2, bf16x8 pa3) {
  pv_one<0>(o[0], vb, pa0, pa1, pa2, pa3); pv_one<1>(o[1], vb, pa0, pa1, pa2, pa3); pv_one<2>(o[2], vb, pa0, pa1, pa2, pa3); pv_one<3>(o[3], vb, pa0, pa1, pa2, pa3);
}

__device__ __forceinline__ void attn_unit(const bf16* __restrict__ Qb, const bf16* __restrict__ Kn, const bf16* __restrict__ Kr, const bf16* __restrict__ Vh,
                                          bf16* __restrict__ Ob, int seq, LAS unsigned char* lds) {
  int tid_l = threadIdx.x; asm volatile("" : "+v"(tid_l));
  const int tid = tid_l, wid = tid >> 6, lane = tid & 63, r32 = lane & 31, hi = lane >> 5;
  LAS unsigned char* V_lds = lds; LAS unsigned char* K_lds = lds + OFF_K;
  LAS float* ws = (LAS float*)(lds + OFF_WS) + wid * 64; LAS float* li_l = ws; LAS float* al_l = ws + 32;
  float m_reg = -1e30f, l_reg = 0; f32x16 o[4] = {}; bf16x8 qr[12 - NPARK];
  const bf16* Qw = Qb + (size_t)(wid * QBLK + r32) * LDQ + hi * 8;
#pragma unroll
  for (int d0 = 0; d0 < 12 - NPARK; ++d0) qr[d0] = *reinterpret_cast<const bf16x8*>(Qw + d0 * 16);
  LAS unsigned char* qrl = lds + OFF_QR + wid * (NPARK * 1024) + hi * 512 + r32 * 16;
  __syncthreads();
#pragma unroll
  for (int d = 0; d < NPARK; ++d) *reinterpret_cast<LAS bf16x8*>(qrl + d * 1024) = *reinterpret_cast<const bf16x8*>(Qw + (12 - NPARK + d) * 16);
  const int sr = tid >> 4, sc = (tid & 15) * 8, vst0 = v_st(sr, sc), vst1 = v_st(32 + sr, sc);
  const int kr_r = tid >> 3, kr_c = (tid & 7) * 8;
  const int vb0 = (int)(unsigned)(uintptr_t)V_lds + v_rd_base(lane);
  bf16x8 vs0, vs1, ks0, ks1, kq0;
  const unsigned vo0 = (unsigned)(sr * LDKV + sc) * 2u, vo1 = vo0 + 32u * LDKV * 2u, vok = (unsigned)(kr_r * LDKR + kr_c) * 2u;
#define SLOAD_K(k0) do { const GAS unsigned char* kbp = (const GAS unsigned char*)Kn + (size_t)(k0) * (LDKV * 2); \
    const GAS unsigned char* rbp = (const GAS unsigned char*)Kr + (size_t)(k0) * (LDKR * 2); \
    ks0 = *reinterpret_cast<const GAS bf16x8*>(kbp + vo0); ks1 = *reinterpret_cast<const GAS bf16x8*>(kbp + vo1); \
    kq0 = *reinterpret_cast<const GAS bf16x8*>(rbp + vok); } while (0)
#define SLOAD_V(k0) do { const GAS unsigned char* vbp = (const GAS unsigned char*)Vh + (size_t)(k0) * (LDKV * 2); \
    vs0 = *reinterpret_cast<const GAS bf16x8*>(vbp + vo0); vs1 = *reinterpret_cast<const GAS bf16x8*>(vbp + vo1); } while (0)
#define SLOAD(k0) do { SLOAD_K(k0); SLOAD_V(k0); } while (0)
#define SWRITE(b) do { *(LAS bf16x8*)(V_lds + (b) * SHM_V + vst0) = vs0; *(LAS bf16x8*)(V_lds + (b) * SHM_V + vst1) = vs1; const int kc = sc * 2; \
    *(LAS bf16x8*)(K_lds + (b) * SHM_K + AKSWZ(sr, kc)) = ks0; *(LAS bf16x8*)(K_lds + (b) * SHM_K + AKSWZ(32 + sr, kc)) = ks1; \
    *(LAS bf16x8*)(K_lds + (b) * SHM_K + AKSWZ(kr_r, 256 + kr_c * 2)) = kq0; } while (0)
#define SWAIT() asm volatile("s_waitcnt vmcnt(0)" ::: "memory")
#define RESC(a) do { if (__any((a) < 1.f)) { if (hi == 0) al_l[r32] = (a); asm volatile("s_waitcnt lgkmcnt(0)" ::: "memory"); \
    _Pragma("unroll") for (int d = 0; d < 4; ++d) _Pragma("unroll") for (int r = 0; r < 16; ++r) o[d][r] *= al_l[crow(r, hi)]; } } while (0)
  f32x16 pA0, pA1, pB0, pB1; float mnA, mnB, alA, alB; bf16x8 pa0, pa1, pa2, pa3; const int NT = seq / KVBLK;
  SLOAD(0); SWAIT(); SWRITE(0); __syncthreads();
  qkt(pA0, pA1, K_lds, qr, qrl, r32, hi); partialSM(pA0, pA1, m_reg, mnA, alA);
  SLOAD(KVBLK);
  SWAIT(); SWRITE(1); __syncthreads();
  for (int j = 1; j + 1 < NT; j += 2) {
#if ATT_EARLY
    SLOAD((j + 1) * KVBLK);
#endif
    SBAR(); qkt(pB0, pB1, K_lds + SHM_K, qr, qrl, r32, hi);
    finishSM(pA0, pA1, alA, l_reg, pa0, pa1, pa2, pa3); SBAR();
#if ATT_EARLY
    pv_d0(o, vb0, pa0, pa1, pa2, pa3); partialSM(pB0, pB1, m_reg, mnB, alB);
#elif ATT_VLATE
    SLOAD_K((j + 1) * KVBLK); SBAR();
    pv_d0(o, vb0, pa0, pa1, pa2, pa3); SBAR(); SLOAD_V((j + 1) * KVBLK); SBAR(); partialSM(pB0, pB1, m_reg, mnB, alB);
#else
    SLOAD((j + 1) * KVBLK); SBAR();
    pv_d0(o, vb0, pa0, pa1, pa2, pa3); partialSM(pB0, pB1, m_reg, mnB, alB);
#endif
    __syncthreads(); SWAIT(); SWRITE(0);
    RESC(alB); __syncthreads();
#if ATT_EARLY
    SLOAD((j + 2) * KVBLK);
#endif
    SBAR(); qkt(pA0, pA1, K_lds, qr, qrl, r32, hi);
    finishSM(pB0, pB1, alB, l_reg, pa0, pa1, pa2, pa3); SBAR();
#if ATT_EARLY
    pv_d0(o, vb0 + SHM_V, pa0, pa1, pa2, pa3); partialSM(pA0, pA1, m_reg, mnA, alA);
#elif ATT_VLATE
    SLOAD_K((j + 2) * KVBLK); SBAR();
    pv_d0(o, vb0 + SHM_V, pa0, pa1, pa2, pa3); SBAR(); SLOAD_V((j + 2) * KVBLK); SBAR(); partialSM(pA0, pA1, m_reg, mnA, alA);
#else
    SLOAD((j + 2) * KVBLK); SBAR();
    pv_d0(o, vb0 + SHM_V, pa0, pa1, pa2, pa3); partialSM(pA0, pA1, m_reg, mnA, alA);
#endif
    __syncthreads(); SWAIT(); SWRITE(1);
    RESC(alA); __syncthreads();
  }
  SBAR(); qkt(pB0, pB1, K_lds + SHM_K, qr, qrl, r32, hi);
  finishSM(pA0, pA1, alA, l_reg, pa0, pa1, pa2, pa3); SBAR();
  pv_d0(o, vb0, pa0, pa1, pa2, pa3); partialSM(pB0, pB1, m_reg, mnB, alB);
  __syncthreads(); RESC(alB);
  finishSM(pB0, pB1, alB, l_reg, pa0, pa1, pa2, pa3); SBAR();
  pv_d0(o, vb0 + SHM_V, pa0, pa1, pa2, pa3);
  if (hi == 0) li_l[r32] = l_reg; asm volatile("s_waitcnt lgkmcnt(0)" ::: "memory");
  float rli[16];
#pragma unroll
  for (int r = 0; r < 16; ++r) rli[r] = __builtin_amdgcn_rcpf(li_l[crow(r, hi)]);
  __syncthreads();
  LAS unsigned short* stg = (LAS unsigned short*)(lds + wid * 8704);
#pragma unroll
  for (int r = 0; r < 16; ++r) { const int orow = crow(r, hi);
#pragma unroll
    for (int d0 = 0; d0 < 4; ++d0) stg[orow * 136 + d0 * 32 + r32] = (unsigned short)(cvtpk(o[d0][r] * rli[r], 0.f) & 0xffffu); }
  asm volatile("s_waitcnt lgkmcnt(0)" ::: "memory");
  bf16* Ow = Ob + (size_t)(wid * QBLK) * LDO;
#pragma unroll
  for (int i2 = 0; i2 < 8; ++i2) { const int id = i2 * 64 + lane, row = id >> 4, ch = id & 15;
    const v4u w = *(const LAS v4u*)((const LAS unsigned char*)stg + row * 272 + ch * 16);
    *(GAS v4u*)(Ow + (size_t)row * LDO + ch * 8) = w; }
#undef SLOAD
#undef SLOAD_K
#undef SLOAD_V
#undef SWRITE
#undef SWAIT
#undef RESC
}

__device__ __forceinline__ void phase(const Frame& F, const bf16* QA, const bf16* KV, const bf16* KR, bf16* O) {
  LAS unsigned char* lds = F.lds + RING_OFF;
  int vcu = F.vcu; asm volatile("" : "+s"(vcu));
  const int x = vcu >> 5, i = vcu & 31;
  for (int k = 0; k < 8; ++k) {
    int t0, S, head, qb;
    if (k < 4) { const int pair = 4 * x + k; t0 = (pair >> 4) * 8192; head = pair & 15; S = 8192; qb = i; }
    else { const int pair = 16 * x + 4 * (i >> 3) + (k - 4); t0 = TP + (pair >> 4) * 2048; head = pair & 15; S = 2048; qb = i & 7; }
    const bf16* Qb = QA + (size_t)(t0 + qb * 256) * LDQ + head * 192;
    const bf16* Kn = KV + (size_t)t0 * LDKV + head * 256; const bf16* Vh = Kn + 128; const bf16* Kr = KR + (size_t)t0 * LDKR;
    bf16* Ob = O + (size_t)(t0 + qb * 256) * LDO + head * 128;
    attn_unit(Qb, Kn, Kr, Vh, Ob, S, lds);
  }
}
}

#ifndef G_ALIGN
#define G_ALIGN true
#endif
#ifndef G_SP2
#define G_SP2 true
#endif
struct Args { const float* in[20]; float* out; unsigned char* ws; };

__device__ __forceinline__ const float* kin(int i) {
    unsigned long long kp = (unsigned long long)__builtin_amdgcn_kernarg_segment_ptr();
    asm volatile("" : "+s"(kp));
    return ((const float* const __attribute__((address_space(4)))*)kp)[i];
}
#define INP(i) kin(i)
#define WSB ((unsigned char*)kin(21))
#define X ((float*)kin(20))
#define XB ((bf16*)(WSB + WS_XB))
#define cosR ((float*)(WSB + WS_TAB))
#define sinR (cosR + 8192 * 128)
#define cosM (cosR + 2 * 8192 * 128)
#define sinM (cosR + 2 * 8192 * 128 + 8192 * 32)
#define ssq_base ((fx64*)(WSB + WS_CTL + CTL_SSQ))
#define STATS(k) ((fx64*)(WSB + WS_CTL + CTL_STATS) + (size_t)(k) * T * 2)
#define CSB2(k) ((fx64*)(WSB + WS_CTL + CTL_CSB2) + (size_t)(k) * 32768)
#define CSF(k) ((float*)(WSB + WS_CTL + CTL_CSF) + (size_t)(k) * 32768)
#define LGTAB ((float*)(WSB + WS_CTL + CTL_LGTAB))
#define wsW (WSB + WS_W)
#define wsA (WSB + WS_ACT)

__device__ __forceinline__ void convert_layer(const Frame& F, int layer, LAS float* scr) {
    const int j = layer >> 1; const int lp = layer > 0 ? layer - 1 : 0;
    const float* g2 = layer > 0 ? INP(14) + (size_t)lp * DM : nullptr; const float* b2 = layer > 0 ? INP(15) + (size_t)lp * DM : nullptr; fx64* cs_in = layer > 0 ? CSB2(2 * layer) : nullptr;
    if ((layer & 1) == 0) {
        convert_matrix(F, INP(2) + (size_t)j * 2048 * 12288, 2048, 12288, (bf16*)(wsW + W_RET_IN), 1, 1.0f, g2, b2, cs_in, scr);
        convert_matrix(F, INP(5) + (size_t)j * 4096 * 2048, 4096, 2048, (bf16*)(wsW + W_RET_OUT), 0, 1.0f, nullptr, nullptr, nullptr, scr);
    } else {
        convert_matrix(F, INP(6) + (size_t)j * 2048 * 2112, 2048, 2112, (bf16*)(wsW + W_MLA_IN), 2, 1.0f, g2, b2, cs_in, scr);
        { bf16* wt = (bf16*)(wsW + W_MLA_IN);
          PHASE_TID(tid, lane); (void)tid; const int gt = gw * 64 + lane, NGT = NGW * 64; unsigned zz = 0u; asm volatile("" : "+v"(zz));
          for (int e = gt; e < 192 * 2048 / 8; e += NGT) { const int rr = e / 256, cc = e % 256; const int row = 2048 + (rr < 96 ? 32 + rr : 160 + (rr - 96));
              *(GAS v4u*)(wt + (size_t)row * 2048 + cc * 8) = (v4u){zz, zz, zz, zz}; } }
        convert_matrix(F, INP(9) + (size_t)j * 1536 * 3072, 1536, 3072, (bf16*)(wsW + W_MLA_UQ), 3, 0.07216878364870322f * 1.4426950408889634f, INP(7) + (size_t)j * 1536, nullptr, nullptr, scr);
        convert_matrix(F, INP(10) + (size_t)j * 512 * 4096, 512, 4096, (bf16*)(wsW + W_MLA_UKV), 0, 1.0f, INP(8) + (size_t)j * 512, nullptr, nullptr, scr);
        convert_matrix(F, INP(11) + (size_t)j * 2048 * 2048, 2048, 2048, (bf16*)(wsW + W_MLA_OUT), 0, 1.0f, nullptr, nullptr, nullptr, scr);
    }
    convert_matrix(F, INP(16) + (size_t)layer * 2048 * 11264, 2048, 11264, (bf16*)(wsW + W_UP), 4, 1.0f, INP(12) + (size_t)layer * DM, INP(13) + (size_t)layer * DM, CSB2(2 * layer + 1), scr);
    convert_matrix(F, INP(19) + (size_t)layer * 5632 * 2048, 5632, 2048, (bf16*)((layer & 1) ? WSB + WS_WD2 : wsW + W_DOWN), 0, 1.0f, nullptr, nullptr, nullptr, scr);
}

__global__ void __launch_bounds__(NWAVES * 64, 2) fwd_kernel(Args args) {
    extern __shared__ __attribute__((aligned(16))) unsigned char lds_raw[];
    Frame F;
    F.lds = (LAS unsigned char*)lds_raw;
    F.wave = __builtin_amdgcn_readfirstlane((int)threadIdx.x >> 6);
    F.G = gridDim.x; { const int bx = blockIdx.x; F.vcu = (F.G % 8 == 0) ? (bx % 8) * (F.G / 8) + bx / 8 : bx; }
    F.gw = F.vcu * NWAVES + F.wave; F.NGW = F.G * NWAVES;
    volatile LAS unsigned* MISC = (volatile LAS unsigned*)(F.lds + MISC_OFF);
    for (int u = threadIdx.x; u < (LDS_BYTES - LDSCTL_OFF) / 4; u += NWAVES * 64) ((LAS unsigned*)(F.lds + LDSCTL_OFF))[u] = 0u;
    __syncthreads();
    XcdBarrier bar = xcd_barrier_post((unsigned*)(args.ws + WS_CTL) + CW_BAR, MISC + 8);
    LAS float* scr = (LAS float*)(F.lds + RING_OFF + F.wave * 16384);
    PG8_LAS unsigned char* ring = (PG8_LAS unsigned char*)(F.lds + RING_OFF);

#define GRID_BAR() do { XcdBarrier b2_ = bar; unsigned long long bp_ = (unsigned long long)b2_.bar; unsigned bx_ = b2_.x; asm volatile("" : "+s"(bp_), "+s"(bx_)); b2_.bar = (unsigned*)bp_; b2_.x = bx_; xcd_barrier(b2_); } while (0)

    prologue(F, INP(0), INP(1), X, XB, cosR, sinR, cosM, sinM, INP(3), INP(4), LGTAB);
    convert_layer(F, 0, scr);
    GRID_BAR();

#ifndef DIAG_LAYERS
#define DIAG_LAYERS 4
#endif
    for (int layer = 0; layer < DIAG_LAYERS; ++layer) {
        const int j = layer >> 1; const bool is_ret = (layer & 1) == 0;
        const bf16* Aout; const bf16* Wout; int Kout;
        if (is_ret) {
            bf16* RQ = (bf16*)(wsA + A_RQ); bf16* RK = (bf16*)(wsA + A_RK); bf16* RV = (bf16*)(wsA + A_RV); bf16* RG = (bf16*)(wsA + A_RG); bf16* RO = (bf16*)(wsA + A_RO); bf16* ROB = (bf16*)X;
            if (layer == 0) csb2_finalize(F, CSB2(0), CSF(0), 65536);
            {
                pg8::Gemm g{XB, (const bf16*)(wsW + W_RET_IN), T, 12288, 2048}; pg8::StaticOrder S; S.init(T, 12288, F.G, (int)blockIdx.x);
                pg8::EpiRetIn E{RQ, RK, RV, RG, cosR, sinR, pg8::LnCorr{layer > 0 ? STATS(2 * layer - 1) : nullptr, CSF(2 * layer), CSF(2 * layer) + 16384}};
                pg8::gemm_phase<pg8::EpiRetIn, pg8::StaticOrder, G_ALIGN, G_SP2>(ring, g, S, E);
#ifdef PROBE_DUP_R1
                __syncthreads();
                pg8::gemm_phase<pg8::EpiRetIn, pg8::StaticOrder, G_ALIGN, G_SP2>(ring, g, S, E);
#endif
            }
            GRID_BAR();
            ret::phase(F, RQ, RK, RV, RO, ROB, LGTAB + j * 16);
#ifdef PROBE_DUP_RET
            GRID_BAR();
            ret::phase(F, RQ, RK, RV, RO, ROB, LGTAB + j * 16);
#endif
            GRID_BAR();
            gate_pass(F, RO, ROB, RG, RG);
#ifdef PROBE_DUP_GATE
            GRID_BAR();
            gate_pass(F, RO, ROB, RG, RO);
#endif
            GRID_BAR();
            Aout = RG; Wout = (const bf16*)(wsW + W_RET_OUT); Kout = 4096;
        } else {
            bf16* CQ = (bf16*)(wsA + A_MCQ); bf16* CKV = (bf16*)(wsA + A_MCKV); bf16* KR = (bf16*)(wsA + A_MKR); bf16* QA = (bf16*)(wsA + A_MQA);
            bf16* KV = (bf16*)(wsA + A_MKV); bf16* MO = (bf16*)(wsA + A_MO);
            fx64* ssq_q = ssq_base + (size_t)j * T; fx64* ssq_kv = ssq_base + (size_t)(2 + j) * T;
            {
                pg8::Gemm g{XB, (const bf16*)(wsW + W_MLA_IN), T, 2304, 2048}; pg8::StaticOrder S; S.init(T, 2304, F.G, (int)blockIdx.x);
                pg8::EpiMlaIn E{CQ, CKV, KR, ssq_q, ssq_kv, cosM, sinM, pg8::LnCorr{STATS(2 * layer - 1), CSF(2 * layer), CSF(2 * layer) + 16384}};
                pg8::gemm_phase<pg8::EpiMlaIn, pg8::StaticOrder, G_ALIGN, G_SP2>(ring, g, S, E);
            }
            GRID_BAR();
            {
                pg8::Gemm g{CQ, (const bf16*)(wsW + W_MLA_UQ), T, 3072, 1536}; pg8::StaticOrder S; S.init(T, 3072, F.G, (int)blockIdx.x);
                pg8::EpiMlaUq E{QA, ssq_q, cosM, sinM};
                pg8::gemm_phase<pg8::EpiMlaUq, pg8::StaticOrder, G_ALIGN, G_SP2>(ring, g, S, E);
#ifdef PROBE_DUP_M2
                __syncthreads();
                pg8::gemm_phase<pg8::EpiMlaUq, pg8::StaticOrder, G_ALIGN, G_SP2>(ring, g, S, E);
#endif
            }
            __syncthreads();
            {
                pg8::Gemm g{CKV, (const bf16*)(wsW + W_MLA_UKV), T, 4096, 512}; pg8::StaticOrder S; S.init(T, 4096, F.G, (int)blockIdx.x);
                pg8::EpiMlaUkv E{KV, ssq_kv};
                pg8::gemm_phase<pg8::EpiMlaUkv, pg8::StaticOrder, G_ALIGN, G_SP2>(ring, g, S, E);
#ifdef PROBE_DUP_M2
                __syncthreads();
                pg8::gemm_phase<pg8::EpiMlaUkv, pg8::StaticOrder, G_ALIGN, G_SP2>(ring, g, S, E);
#endif
            }
            GRID_BAR();
            att::phase(F, QA, KV, KR, MO);
#ifdef PROBE_DUP_ATT
            GRID_BAR();
            att::phase(F, QA, KV, KR, MO);
#endif
            GRID_BAR();
            Aout = MO; Wout = (const bf16*)(wsW + W_MLA_OUT); Kout = 2048;
        }
        {
            pg8::Gemm g{Aout, Wout, T, 2048, Kout}; pg8::StaticOrder S; S.init(T, 2048, F.G, (int)blockIdx.x);
            const int lp = layer > 0 ? layer - 1 : 0;
            pg8::EpiResid E{XB, nullptr, STATS(2 * layer), layer > 0 ? STATS(2 * layer - 1) : nullptr, INP(14) + (size_t)lp * DM, INP(15) + (size_t)lp * DM, INP(0), INP(1)};
            pg8::gemm_phase<pg8::EpiResid, pg8::StaticOrder, G_ALIGN, G_SP2>(ring, g, S, E);
        }
        GRID_BAR();
#ifndef DIAG_NO_FFN
        bf16* FU = (bf16*)(wsA + A_FU); bf16* FG = (bf16*)(wsA + A_FG);
        {
            pg8::Gemm g{XB, (const bf16*)(wsW + W_UP), T, 11264, 2048}; pg8::StaticOrder S; S.init(T, 11264, F.G, (int)blockIdx.x);
            pg8::EpiFfnUp E{FU, FG, FG + (size_t)512 * 4 * FFN, INP(17) + (size_t)layer * 3 * FFN, INP(18) + (size_t)layer * FFN, pg8::LnCorr{STATS(2 * layer), CSF(2 * layer + 1), CSF(2 * layer + 1) + 16384}};
            pg8::gemm_phase<pg8::EpiFfnUp, pg8::StaticOrder, G_ALIGN, G_SP2>(ring, g, S, E);
#ifdef PROBE_DUP_F1
            __syncthreads();
            pg8::gemm_phase<pg8::EpiFfnUp, pg8::StaticOrder, G_ALIGN, G_SP2>(ring, g, S, E);
#endif
        }
        GRID_BAR();
        ffn_fixup(F, FU, FG, FG + (size_t)512 * 4 * FFN, INP(17) + (size_t)layer * 3 * FFN, INP(18) + (size_t)layer * FFN);
        if (layer < 3) convert_layer(F, layer + 1, scr);
        GRID_BAR();
        if (layer < 3) csb2_finalize(F, CSB2(2 * layer + 2), CSF(2 * layer + 2), 65536);
        {
            pg8::Gemm g{FU, (const bf16*)((layer & 1) ? WSB + WS_WD2 : wsW + W_DOWN), T, 2048, FFN}; pg8::StaticOrder S; S.init(T, 2048, F.G, (int)blockIdx.x);
            pg8::EpiResid E{XB, layer == DIAG_LAYERS - 1 ? X : nullptr, STATS(2 * layer + 1), STATS(2 * layer), INP(12) + (size_t)layer * DM, INP(13) + (size_t)layer * DM, nullptr, nullptr};
            pg8::gemm_phase<pg8::EpiResid, pg8::StaticOrder, G_ALIGN, G_SP2>(ring, g, S, E);
        }
        GRID_BAR();
#endif
#ifdef PROBE_EXTRA_BARS
        for (int eb = 0; eb < 10; ++eb) GRID_BAR();
#endif
    }
    ln_pass(F, X, XB, nullptr, INP(14) + (size_t)(DIAG_LAYERS - 1) * DM, INP(15) + (size_t)(DIAG_LAYERS - 1) * DM, true);
    GRID_BAR();
    if (xb_ld((unsigned*)(WSB + WS_CTL) + CW_BAR + XB_TMO) != 0u) {
        PHASE_TID(tid, lane); (void)tid; const float qn = __builtin_nanf("");
        for (int m = gw; m < T; m += NGW) { GAS f32x4* o = (GAS f32x4*)(X + (size_t)m * DM) + lane;
#pragma unroll
            for (int j2 = 0; j2 < 8; ++j2) o[64 * j2] = (f32x4){qn, qn, qn, qn}; }
    }
}

extern "C" void kernel_launch(void* const* d_in, const int* in_sizes, int n_in, void* d_out, int out_size, void* d_ws, size_t ws_size, hipStream_t stream) {
    static int grid = 0;
    if (grid == 0) {
        if (n_in != 20 || out_size != T * DM || ws_size < WS_END) { fprintf(stderr, "kernel_launch: unexpected shapes (n_in %d out %d ws %zu, need %zu)\n", n_in, out_size, ws_size, (size_t)WS_END); grid = -1; return; }
        int dev = 0, cus = 0, per_cu = 0;
        if (hipGetDevice(&dev) != hipSuccess || hipDeviceGetAttribute(&cus, hipDeviceAttributeMultiprocessorCount, dev) != hipSuccess) { grid = -1; return; }
        if (hipFuncSetAttribute((const void*)fwd_kernel, hipFuncAttributeMaxDynamicSharedMemorySize, LDS_BYTES) != hipSuccess) { fprintf(stderr, "kernel_launch: hipFuncSetAttribute failed\n"); grid = -1; return; }
        if (hipOccupancyMaxActiveBlocksPerMultiprocessor(&per_cu, (const void*)fwd_kernel, NWAVES * 64, LDS_BYTES) != hipSuccess || per_cu < 1)
            fprintf(stderr, "kernel_launch: occupancy query reports %d workgroups per CU\n", per_cu);
        (void)hipGetLastError();
        if (cus != 256) { fprintf(stderr, "kernel_launch: built for a 256-CU device, found %d\n", cus); grid = -1; return; }
        grid = cus;
    }
    if (grid < 0) return;
    if (hipMemsetAsync((char*)d_ws + WS_CTL, 0, CTL_ZERO_BYTES, stream) != hipSuccess) return;
    Args a{};
    for (int i = 0; i < 20; ++i) a.in[i] = (const float*)d_in[i];
    a.out = (float*)d_out; a.ws = (unsigned char*)d_ws;
    hipLaunchKernelGGL(fwd_kernel, dim3(grid), dim3(NWAVES * 64), LDS_BYTES, stream, a);
    const hipError_t le = hipPeekAtLastError();
    if (le != hipSuccess) fprintf(stderr, "kernel_launch: launch failed: %s\n", hipGetErrorName(le));
}
```

```cpp
#include <hip/hip_runtime.h>
#include <cstdio>
#include <cstdint>

#define GAS __attribute__((address_space(1)))
#define LAS __attribute__((address_space(3)))

namespace pg8 {
#define PG8_LAS __attribute__((address_space(3)))
typedef unsigned short bf16_t;
typedef short bf16x8 __attribute__((ext_vector_type(8)));
typedef float f32x4 __attribute__((ext_vector_type(4)));
typedef unsigned u32x4 __attribute__((ext_vector_type(4)));
typedef _Float16 f16x8 __attribute__((ext_vector_type(8)));
template <bool F16> __device__ __forceinline__ f32x4 mfma16(bf16x8 a, bf16x8 b, f32x4 c) {
    if constexpr (F16) return __builtin_amdgcn_mfma_f32_16x16x32_f16(__builtin_bit_cast(f16x8, a), __builtin_bit_cast(f16x8, b), c, 0, 0, 0);
    else return __builtin_amdgcn_mfma_f32_16x16x32_bf16(a, b, c, 0, 0, 0);
}
constexpr int BM = 256, BK = 64, HALF = 128, HTB = HALF * BK * 2  , STAGE_BYTES = 8 * HTB, NXCD = 8, WGM = 8;
constexpr int PF_OFF = STAGE_BYTES, PF_BYTES = 6144;

__host__ __device__ __forceinline__ int lds_byte(int r, int c) { const int st = (r >> 4) * 2 + (c >> 5), rr = r & 15, cc = c & 31, ob = rr * 64 + cc * 2; return st * 1024 + (ob ^ (((ob >> 9) & 1) << 5)); }
__host__ __device__ __forceinline__ void stage_rc(int b, int& R, int& C) { const int st = b / 1024, sb = b % 1024, swz = sb ^ (((sb >> 9) & 1) << 5); R = (st >> 1) * 16 + swz / 64; C = (st & 1) * 32 + (swz % 64) / 2; }
__host__ __device__ __forceinline__ int perm32(int rho) { const int n = rho >> 4, i = rho & 15; return 8 * (i >> 2) + 4 * n + (i & 3); }

struct Unit { int pm, pn; };
struct Gemm { const bf16_t* A; const bf16_t* Bt; int M, N, K; };

struct StaticOrder {
    int nM, nN, nwg, G, c;
    __host__ __device__ void init(int M, int N, int G_, int c_) { nM = M / BM; nN = N / BM; nwg = nM * nN; G = G_; c = c_; }
    __host__ __device__ bool next(int i, Unit& u) const {
        const long L = (long)i * G + c; if (L >= nwg) return false;
        int wgid = (int)L; { const int q = nwg / NXCD, r = nwg % NXCD, xcd = wgid % NXCD, off = wgid / NXCD; wgid = (xcd < r ? xcd * (q + 1) : r * (q + 1) + (xcd - r) * q) + off; }
        const int nig = WGM * nN, gid = wgid / nig, fm = gid * WGM, gsz = (nM - fm) < WGM ? (nM - fm) : WGM;
        u.pm = fm + ((wgid % nig) % gsz); u.pn = (wgid % nig) / gsz; return true;
    }
    __device__ __forceinline__ void a_ready(const Unit&) const {}
    __device__ __forceinline__ void done(const Unit&) const {}
};
__device__ __forceinline__ unsigned cvt_pk_bf16(float lo, float hi) { unsigned r; asm volatile("v_cvt_pk_bf16_f32 %0, %1, %2" : "=v"(r) : "v"(lo), "v"(hi)); return r; }

template <class Epi, class Sched, bool ALIGN_EPI = false, bool SP2 = false>
__device__ __forceinline__ void gemm_phase(PG8_LAS unsigned char* lds, const Gemm g, const Sched& S, const Epi& E) {
    int tid_l = threadIdx.x; asm volatile("" : "+v"(tid_l));
    const int tid = tid_l, wid = __builtin_amdgcn_readfirstlane(tid >> 6), lane = tid & 63, wr = wid >> 2, wc = wid & 3, fr = lane & 15, fq = lane >> 4;
    const int K = g.K, nt = K / BK;
    unsigned voffA[2], voffB[2];
#pragma unroll
    for (int i = 0; i < 2; ++i) { int R, C; stage_rc(tid * 16 + i * 8192, R, C); const int Rb = Epi::PERM ? ((R & ~31) + perm32(R & 31)) : R;
        const int Ra = Epi::APERM ? ((R & ~63) + 4 * (R & 15) + ((R >> 4) & 3)) : R;
        voffA[i] = (unsigned)(Ra * K + C) * 2u; voffB[i] = (unsigned)(Rb * K + C) * 2u; }
    const size_t kstep = (size_t)(BK * 2);
    const size_t hstep = (size_t)HALF * K * 2;
    const size_t tstep = 2 * hstep;
    const unsigned ldsw = (unsigned)wid * 1024u;
    const int aoff = lds_byte(wr * 64 + fr, fq * 8), boff = lds_byte(wc * 32 + fr, fq * 8);
#define PG8_SA(b, h) (((b) * 2 + (h)) * HTB)
#define PG8_SB(b, h) ((4 + (b) * 2 + (h)) * HTB)
#define PG8_STAGE(bufoff, gbase, voff) do { _Pragma("unroll") for (int _i = 0; _i < 2; ++_i) \
        __builtin_amdgcn_global_load_lds((const unsigned*)((const char*)(gbase) + (voff)[_i]), (PG8_LAS unsigned*)(lds + (bufoff) + ldsw + _i * 8192), 16, 0, 0); } while (0)
#define PG8_LDA(dst, b, h) do { _Pragma("unroll") for (int m = 0; m < 4; ++m) _Pragma("unroll") for (int k = 0; k < 2; ++k) dst[m][k] = *(const PG8_LAS bf16x8*)(lds + PG8_SA(b, h) + aoff + m * 2048 + k * 1024); } while (0)
#define PG8_LDB(dst, b, h) do { _Pragma("unroll") for (int n = 0; n < 2; ++n) _Pragma("unroll") for (int k = 0; k < 2; ++k) dst[n][k] = *(const PG8_LAS bf16x8*)(lds + PG8_SB(b, h) + boff + n * 2048 + k * 1024); } while (0)
#define PG8_MMA(ai, bj, At, Bt) do { __builtin_amdgcn_s_setprio(1); _Pragma("unroll") for (int m = 0; m < 4; ++m) _Pragma("unroll") for (int n = 0; n < 2; ++n) _Pragma("unroll") for (int k = 0; k < 2; ++k) \
        acc[ai][bj][m][n] = mfma16<Epi::F16>(Bt[n][k], At[m][k], acc[ai][bj][m][n]); __builtin_amdgcn_s_setprio(0); } while (0)
#define PG8_WAIT_V(n) asm volatile("s_waitcnt vmcnt(" #n ")" ::: "memory")
#define PG8_WAIT_L(n) asm volatile("s_waitcnt lgkmcnt(" #n ")" ::: "memory")
#define PG8_BAR __builtin_amdgcn_s_barrier()
#define PG8_SCHED __builtin_amdgcn_sched_barrier(0)
    Unit cur, nxt; int ui = 0;
    if (!S.next(0, cur)) return;
    f32x4 acc[2][2][4][2];
#pragma unroll
    for (int a = 0; a < 2; ++a)
#pragma unroll
        for (int b = 0; b < 2; ++b)
#pragma unroll
            for (int m = 0; m < 4; ++m)
#pragma unroll
                for (int n = 0; n < 2; ++n) acc[a][b][m][n] = (f32x4){0.f, 0.f, 0.f, 0.f};
    bf16x8 At[4][2], B0[2][2], B1[2][2];
    const char* cA = (const char*)g.A + (size_t)cur.pm * tstep; const char* cB = (const char*)g.Bt + (size_t)cur.pn * tstep;
    S.a_ready(cur);
    if constexpr (SP2) {
        PG8_STAGE(PG8_SB(0, 0), cB, voffB); PG8_STAGE(PG8_SB(0, 1), cB + hstep, voffB); PG8_STAGE(PG8_SA(0, 0), cA, voffA); PG8_STAGE(PG8_SA(0, 1), cA + hstep, voffA);
        if (wr == 1) PG8_BAR;
        PG8_WAIT_V(2); PG8_BAR;
        PG8_STAGE(PG8_SB(1, 0), cB + kstep, voffB); PG8_STAGE(PG8_SA(1, 0), cA + kstep, voffA); PG8_STAGE(PG8_SB(1, 1), cB + hstep + kstep, voffB);
        PG8_WAIT_V(6); PG8_BAR;
    } else {
        PG8_STAGE(PG8_SB(0, 0), cB, voffB); PG8_STAGE(PG8_SA(0, 0), cA, voffA); PG8_STAGE(PG8_SB(0, 1), cB + hstep, voffB); PG8_STAGE(PG8_SA(0, 1), cA + hstep, voffA);
        if (wr == 1) PG8_BAR;
        PG8_WAIT_V(4); PG8_BAR;
        PG8_STAGE(PG8_SB(1, 0), cB + kstep, voffB); PG8_STAGE(PG8_SA(1, 0), cA + kstep, voffA); PG8_STAGE(PG8_SB(1, 1), cB + hstep + kstep, voffB);
        PG8_WAIT_V(6); PG8_BAR;
    }
    for (;;) {
        const bool has_next = S.next(ui + 1, nxt);
        PG8_LAS unsigned char* const pfa = lds + PF_OFF + (ui & 1) * PF_BYTES;
        if constexpr (Epi::HAS_PRE) E.prefetch(cur, pfa, wid, lane);
        const char* nA = has_next ? (const char*)g.A + (size_t)nxt.pm * tstep : cA; const char* nB = has_next ? (const char*)g.Bt + (size_t)nxt.pn * tstep : cB;
        for (int t = 0; t < nt; t += 2) {
            const bool last = (t == nt - 2);
            const char* a1 = cA + (size_t)(t + 1) * kstep;
            const char* a2 = last ? nA : cA + (size_t)(t + 2) * kstep; const char* b2 = last ? nB : cB + (size_t)(t + 2) * kstep;
            const char* a3 = a2 + kstep; const char* b3 = b2 + kstep;
            if (last && has_next) S.a_ready(nxt);
            if constexpr (SP2) {
            PG8_LDB(B0, 0, 0); PG8_LDB(B1, 0, 1); PG8_SCHED; PG8_LDA(At, 0, 0); PG8_STAGE(PG8_SA(1, 1), a1 + hstep, voffA);
            PG8_WAIT_V(8); PG8_WAIT_L(0); PG8_BAR; PG8_MMA(0, 0, At, B0); PG8_MMA(0, 1, At, B1); PG8_BAR; PG8_SCHED;
            PG8_LDA(At, 0, 1); PG8_STAGE(PG8_SB(0, 0), b2, voffB); PG8_STAGE(PG8_SB(0, 1), b2 + hstep, voffB); PG8_STAGE(PG8_SA(0, 0), a2, voffA);
            PG8_WAIT_V(8); PG8_WAIT_L(0); PG8_BAR; PG8_MMA(1, 0, At, B0); PG8_MMA(1, 1, At, B1); PG8_BAR; PG8_SCHED;
            PG8_LDB(B0, 1, 0); PG8_LDB(B1, 1, 1); PG8_SCHED; PG8_LDA(At, 1, 0); PG8_STAGE(PG8_SA(0, 1), a2 + hstep, voffA);
            PG8_WAIT_V(8); PG8_WAIT_L(0); PG8_BAR; PG8_MMA(0, 0, At, B0); PG8_MMA(0, 1, At, B1); PG8_BAR; PG8_SCHED;
            PG8_LDA(At, 1, 1); PG8_STAGE(PG8_SB(1, 0), b3, voffB); PG8_STAGE(PG8_SB(1, 1), b3 + hstep, voffB); PG8_STAGE(PG8_SA(1, 0), a3, voffA);
            PG8_WAIT_V(8); PG8_WAIT_L(0); PG8_BAR; PG8_MMA(1, 0, At, B0); PG8_MMA(1, 1, At, B1); PG8_BAR; PG8_SCHED;
            } else {
            PG8_LDB(B0, 0, 0); PG8_SCHED; PG8_LDA(At, 0, 0); PG8_STAGE(PG8_SA(1, 1), a1 + hstep, voffA);
            PG8_WAIT_L(8); PG8_BAR; PG8_WAIT_L(0); PG8_MMA(0, 0, At, B0); PG8_BAR; PG8_SCHED;
            PG8_LDB(B1, 0, 1); PG8_STAGE(PG8_SB(0, 0), b2, voffB);
            PG8_BAR; PG8_WAIT_L(0); PG8_MMA(0, 1, At, B1); PG8_BAR;
            PG8_LDA(At, 0, 1); PG8_STAGE(PG8_SA(0, 0), a2, voffA);
            PG8_BAR; PG8_WAIT_L(0); PG8_MMA(1, 0, At, B0); PG8_BAR; PG8_SCHED;
            PG8_STAGE(PG8_SB(0, 1), b2 + hstep, voffB);
            PG8_WAIT_V(6); PG8_BAR; PG8_MMA(1, 1, At, B1); PG8_BAR;
            PG8_LDB(B0, 1, 0); PG8_SCHED; PG8_LDA(At, 1, 0); PG8_STAGE(PG8_SA(0, 1), a2 + hstep, voffA);
            PG8_WAIT_L(8); PG8_BAR; PG8_WAIT_L(0); PG8_MMA(0, 0, At, B0); PG8_BAR; PG8_SCHED;
            PG8_LDB(B1, 1, 1); PG8_STAGE(PG8_SB(1, 0), b3, voffB);
            PG8_BAR; PG8_WAIT_L(0); PG8_MMA(0, 1, At, B1); PG8_BAR;
            PG8_LDA(At, 1, 1); PG8_STAGE(PG8_SA(1, 0), a3, voffA);
            PG8_BAR; PG8_WAIT_L(0); PG8_MMA(1, 0, At, B0); PG8_BAR; PG8_SCHED;
            PG8_STAGE(PG8_SB(1, 1), b3 + hstep, voffB);
            PG8_WAIT_V(6); PG8_BAR; PG8_MMA(1, 1, At, B1); PG8_BAR;
            }
        }
        if constexpr (ALIGN_EPI) { if (wr == 0) PG8_BAR; }
        if constexpr (!Epi::AFTER_DRAIN) { if constexpr (Epi::HAS_PRE) E.pre(acc, cur, wr, wc, fr, fq, pfa); E(acc, cur, wr, wc, fr, fq); S.done(cur); }
        if (!has_next) break;
#pragma unroll
        for (int a = 0; a < 2; ++a)
#pragma unroll
            for (int b = 0; b < 2; ++b)
#pragma unroll
                for (int m = 0; m < 4; ++m)
#pragma unroll
                    for (int n = 0; n < 2; ++n) acc[a][b][m][n] = (f32x4){0.f, 0.f, 0.f, 0.f};
        cur = nxt; cA = nA; cB = nB; ++ui;
        if constexpr (ALIGN_EPI) { if (wr == 1) PG8_BAR; }
    }
    PG8_WAIT_V(0);
    if constexpr (!ALIGN_EPI) { if (wr == 0) PG8_BAR; }
    PG8_BAR;
    if constexpr (Epi::AFTER_DRAIN) { E.fused(acc, cur, wr, wc, fr, fq, lds, wid, lane); S.done(cur); }
#undef PG8_SA
#undef PG8_SB
#undef PG8_STAGE
#undef PG8_LDA
#undef PG8_LDB
#undef PG8_MMA
#undef PG8_WAIT_V
#undef PG8_WAIT_L
#undef PG8_BAR
#undef PG8_SCHED
}
}

constexpr int DM = 2048;
constexpr int T = 32768, TP = 16384;
constexpr int FFN = 5632;
constexpr float ALPHA = 1.6817928305074290f;
typedef unsigned short bf16;
typedef unsigned v4u __attribute__((ext_vector_type(4)));
typedef unsigned v2u __attribute__((ext_vector_type(2)));
typedef float f32x4 __attribute__((ext_vector_type(4)));
typedef float f32x16 __attribute__((ext_vector_type(16)));
typedef short bf16x8 __attribute__((ext_vector_type(8)));
typedef short s16x4 __attribute__((ext_vector_type(4)));

__device__ __forceinline__ int seq_pos(int r) { return r < TP ? (r & 8191) : (r & 2047); }
__device__ __forceinline__ unsigned pkbf(float lo, float hi) { return pg8::cvt_pk_bf16(lo, hi); }
__device__ __forceinline__ v4u pack8(f32x4 a, f32x4 b) { v4u w; w.x = pkbf(a[0], a[1]); w.y = pkbf(a[2], a[3]); w.z = pkbf(b[0], b[1]); w.w = pkbf(b[2], b[3]); return w; }
__device__ __forceinline__ float bf2f(unsigned short b) { return __builtin_bit_cast(float, (unsigned)b << 16); }
__device__ __forceinline__ float bflo(unsigned w) { return __builtin_bit_cast(float, w << 16); }
__device__ __forceinline__ float bfhi(unsigned w) { return __builtin_bit_cast(float, w & 0xffff0000u); }
typedef _Float16 h2_t __attribute__((ext_vector_type(2)));
typedef float f2_t __attribute__((ext_vector_type(2)));
__device__ __forceinline__ unsigned pkh(float a, float b) { const f2_t v = {a, b}; return __builtin_bit_cast(unsigned, __builtin_convertvector(v, h2_t)); }
__device__ __forceinline__ float hlo(unsigned w) { return (float)__builtin_bit_cast(h2_t, w).x; }
__device__ __forceinline__ float hhi(unsigned w) { return (float)__builtin_bit_cast(h2_t, w).y; }
typedef long long fx64;
__device__ __forceinline__ void fx_add(fx64* p, float v) { atomicAdd((unsigned long long*)p, (unsigned long long)(long long)(v * 4294967296.0f)); }
__device__ __forceinline__ float fx_val(fx64 x) { return (float)((double)x * (1.0 / 4294967296.0)); }
__device__ __forceinline__ float fx_load(const fx64* p) { return fx_val(__hip_atomic_load(p, __ATOMIC_RELAXED, __HIP_MEMORY_SCOPE_AGENT)); }

namespace pg8 {
struct LnCorr { const fx64* st; const float* cs; const float* b2; };
__device__ __forceinline__ void ln_prefetch(const LnCorr& L, const Unit& u, PG8_LAS unsigned char* pfa, int wid, int lane) {
    if (!L.st) return;
    if (wid < 4) __builtin_amdgcn_global_load_lds((const unsigned*)(L.st + 2 * (u.pm * BM + 64 * wid + lane)), (PG8_LAS unsigned*)(pfa + wid * 1024), 16, 0, 0);
    else if (wid < 6) { const float* v = (wid == 4 ? L.cs : L.b2) + u.pn * BM + 4 * lane; __builtin_amdgcn_global_load_lds((const unsigned*)v, (PG8_LAS unsigned*)(pfa + 4096 + (wid - 4) * 1024), 16, 0, 0); }
}
template <bool PERM, bool APERM = false> __device__ __forceinline__ void ln_correct(const LnCorr& L, f32x4 (&acc)[2][2][4][2], int wr, int wc, int fr, int fq, const PG8_LAS unsigned char* pfa) {
    if (!L.st) return;
    typedef long long ll2 __attribute__((ext_vector_type(2)));
    float rs[2][4], mr[2][4];
#pragma unroll
    for (int ai = 0; ai < 2; ++ai)
#pragma unroll
        for (int m = 0; m < 4; ++m) { const int lr = ai * HALF + wr * 64 + (APERM ? 4 * fr + m : m * 16 + fr);
            const ll2 sv = *(const PG8_LAS ll2*)(pfa + lr * 16);
            const float s1 = fx_val(sv.x), s2 = fx_val(sv.y);
            const float mu = s1 * (1.0f / DM), var = s2 * (1.0f / DM) - mu * mu; const float r_ = __builtin_amdgcn_rsqf(var + 1e-5f); rs[ai][m] = r_; mr[ai][m] = mu * r_; }
#pragma unroll
    for (int bj = 0; bj < 2; ++bj)
#pragma unroll
        for (int n = 0; n < 2; ++n) { const int lc = bj * HALF + wc * 32 + (PERM ? 8 * fq + 4 * n : 16 * n + 4 * fq);
            const f32x4 c4 = *(const PG8_LAS f32x4*)(pfa + 4096 + lc * 4), b4 = *(const PG8_LAS f32x4*)(pfa + 5120 + lc * 4);
#pragma unroll
            for (int ai = 0; ai < 2; ++ai)
#pragma unroll
                for (int m = 0; m < 4; ++m) acc[ai][bj][m][n] = acc[ai][bj][m][n] * rs[ai][m] - c4 * mr[ai][m] + b4; }
}
struct EpiRetIn {
    static constexpr bool PERM = true, AFTER_DRAIN = false, APERM = false, HAS_PRE = true, F16 = true;
    bf16_t *Q, *K, *V, *G; const float *cosT, *sinT; LnCorr lc;
    __device__ __forceinline__ void prefetch(const Unit& u, PG8_LAS unsigned char* pfa, int wid, int lane) const { ln_prefetch(lc, u, pfa, wid, lane); }
    __device__ __forceinline__ void pre(f32x4 (&acc)[2][2][4][2], const Unit& u, int wr, int wc, int fr, int fq, const PG8_LAS unsigned char* pfa) const { ln_correct<true>(lc, acc, wr, wc, fr, fq, pfa); }
    __device__ __forceinline__ void operator()(const f32x4 (&acc)[2][2][4][2], const Unit& u, int wr, int wc, int fr, int fq) const {
        const int row0 = u.pm * BM + wr * 64 + fr, cl = wc * 32 + 8 * fq;
        if (u.pn < 16) {
            bf16_t* base = (u.pn < 8 ? Q : K) + (size_t)(u.pn & 7) * 256 + cl;
#pragma unroll
            for (int ai = 0; ai < 2; ++ai)
#pragma unroll
                for (int m = 0; m < 4; ++m) {
                    const int r = row0 + ai * HALF + m * 16; const int pos = seq_pos(r);
                    const float* cp = cosT + (size_t)pos * 128 + cl; const float* sp = sinT + (size_t)pos * 128 + cl;
                    const f32x4 c0 = *(const f32x4*)cp, c1 = *(const f32x4*)(cp + 4), s0 = *(const f32x4*)sp, s1 = *(const f32x4*)(sp + 4);
                    const f32x4 x1a = acc[ai][0][m][0], x1b = acc[ai][0][m][1], x2a = acc[ai][1][m][0], x2b = acc[ai][1][m][1];
                    const f32x4 y1a = x1a * c0 - x2a * s0, y1b = x1b * c1 - x2b * s1, y2a = x1a * s0 + x2a * c0, y2b = x1b * s1 + x2b * c1;
                    bf16_t* rp = base + (size_t)r * 2048;
                    *(u32x4*)rp = pack8(y1a, y1b); *(u32x4*)(rp + 128) = pack8(y2a, y2b);
                    asm volatile("" ::: "memory"); }
        } else {
            bf16_t* base = (u.pn < 32 ? V + (size_t)(u.pn - 16) * 256 : G + (size_t)(u.pn - 32) * 256) + cl;
#pragma unroll
            for (int ai = 0; ai < 2; ++ai)
#pragma unroll
                for (int m = 0; m < 4; ++m) { bf16_t* rp = base + (size_t)(row0 + ai * HALF + m * 16) * 4096;
#pragma unroll
                    for (int bj = 0; bj < 2; ++bj) *(u32x4*)(rp + bj * HALF) = pack8(acc[ai][bj][m][0], acc[ai][bj][m][1]); }
        }
    }
};
struct EpiResid {
    static constexpr bool PERM = true, AFTER_DRAIN = false, APERM = false, HAS_PRE = true, F16 = false;
    bf16_t* XBs; float* Yf; fx64* st_new; const fx64* st_prev; const float* g; const float* b; const float* xin_p; const float* xin_s;
    __device__ __forceinline__ void prefetch(const Unit& u, PG8_LAS unsigned char* pfa, int wid, int lane) const { ln_prefetch(LnCorr{st_prev, g, b}, u, pfa, wid, lane); }
    __device__ __forceinline__ void operator()(const f32x4 (&acc)[2][2][4][2], const Unit& u, int wr, int wc, int fr, int fq) const {}
    __device__ __forceinline__ void pre(f32x4 (&acc)[2][2][4][2], const Unit& u, int wr, int wc, int fr, int fq, const PG8_LAS unsigned char* pfa) const {
        typedef long long ll2 __attribute__((ext_vector_type(2)));
        const int row0 = u.pm * BM + wr * 64 + fr, lc0 = wc * 32 + 8 * fq, col0 = u.pn * BM + lc0;
#pragma unroll
        for (int ai = 0; ai < 2; ++ai) {
            float mu[4], rs[4], s1[4], s2[4];
#pragma unroll
            for (int m = 0; m < 4; ++m) { s1[m] = 0.f; s2[m] = 0.f; mu[m] = 0.f; rs[m] = 1.f;
                if (st_prev) { const ll2 sv = *(const PG8_LAS ll2*)(pfa + (ai * HALF + wr * 64 + m * 16 + fr) * 16);
                    const float p1 = fx_val(sv.x), p2 = fx_val(sv.y); mu[m] = p1 * (1.0f / DM); const float var = p2 * (1.0f / DM) - mu[m] * mu[m]; rs[m] = __builtin_amdgcn_rsqf(var + 1e-5f); } }
#pragma unroll
            for (int bj = 0; bj < 2; ++bj) {
                f32x4 xv[4][2];
                if (!st_prev) {
#pragma unroll
                    for (int m = 0; m < 4; ++m) { const int r = row0 + ai * HALF + m * 16; const float* srcp = (r < TP ? xin_p + (size_t)r * DM : xin_s + (size_t)(r - TP) * DM) + col0 + bj * HALF;
                        xv[m][0] = *(const f32x4*)srcp; xv[m][1] = *(const f32x4*)(srcp + 4); }
                } else {
                    v4u w[4];
#pragma unroll
                    for (int m = 0; m < 4; ++m) w[m] = *(const v4u*)(XBs + (size_t)(row0 + ai * HALF + m * 16) * DM + col0 + bj * HALF);
                    const f32x4 g0 = *(const PG8_LAS f32x4*)(pfa + 4096 + (bj * HALF + lc0) * 4), g1 = *(const PG8_LAS f32x4*)(pfa + 4096 + (bj * HALF + lc0 + 4) * 4);
                    const f32x4 b0 = *(const PG8_LAS f32x4*)(pfa + 5120 + (bj * HALF + lc0) * 4), b1 = *(const PG8_LAS f32x4*)(pfa + 5120 + (bj * HALF + lc0 + 4) * 4);
#pragma unroll
                    for (int m = 0; m < 4; ++m) {
                        const f32x4 x0 = (f32x4){hlo(w[m].x), hhi(w[m].x), hlo(w[m].y), hhi(w[m].y)}, x1 = (f32x4){hlo(w[m].z), hhi(w[m].z), hlo(w[m].w), hhi(w[m].w)};
                        xv[m][0] = (x0 - mu[m]) * rs[m] * g0 + b0; xv[m][1] = (x1 - mu[m]) * rs[m] * g1 + b1; } }
#pragma unroll
                for (int m = 0; m < 4; ++m) { const int r = row0 + ai * HALF + m * 16;
                    const f32x4 y0 = xv[m][0] * ALPHA + acc[ai][bj][m][0], y1 = xv[m][1] * ALPHA + acc[ai][bj][m][1];
                    if (Yf) { float* yp = Yf + (size_t)r * DM + col0 + bj * HALF; *(f32x4*)yp = y0; *(f32x4*)(yp + 4) = y1; }
                    else { v4u w; w.x = pkh(y0[0], y0[1]); w.y = pkh(y0[2], y0[3]); w.z = pkh(y1[0], y1[1]); w.w = pkh(y1[2], y1[3]);
                        *(v4u*)(XBs + (size_t)r * DM + col0 + bj * HALF) = w;
                        const float a0 = hlo(w.x), a1 = hhi(w.x), a2 = hlo(w.y), a3 = hhi(w.y), a4 = hlo(w.z), a5 = hhi(w.z), a6 = hlo(w.w), a7 = hhi(w.w);
                        s1[m] += ((a0 + a1) + (a2 + a3)) + ((a4 + a5) + (a6 + a7)); s2[m] += ((a0 * a0 + a1 * a1) + (a2 * a2 + a3 * a3)) + ((a4 * a4 + a5 * a5) + (a6 * a6 + a7 * a7)); } }
                asm volatile("" ::: "memory"); }
            if (!Yf) {
#pragma unroll
                for (int m = 0; m < 4; ++m) { const int r = row0 + ai * HALF + m * 16; float t1 = s1[m], t2 = s2[m];
                    t1 += __shfl_xor(t1, 16); t1 += __shfl_xor(t1, 32); t2 += __shfl_xor(t2, 16); t2 += __shfl_xor(t2, 32);
                    if (fq == 0) { fx_add(st_new + 2 * r, t1); fx_add(st_new + 2 * r + 1, t2); } } }
        }
    }
};
struct EpiSplit {
    static constexpr bool PERM = true, AFTER_DRAIN = false, APERM = false, HAS_PRE = false, F16 = false;
    bf16_t *O0, *O1; int split, ldc;
    __device__ __forceinline__ void operator()(const f32x4 (&acc)[2][2][4][2], const Unit& u, int wr, int wc, int fr, int fq) const {
        const int row0 = u.pm * BM + wr * 64 + fr, cl = wc * 32 + 8 * fq;
        bf16_t* base = (u.pn < split ? O0 + (size_t)u.pn * 256 : O1 + (size_t)(u.pn - split) * 256) + cl;
#pragma unroll
        for (int ai = 0; ai < 2; ++ai)
#pragma unroll
            for (int m = 0; m < 4; ++m) { bf16_t* rp = base + (size_t)(row0 + ai * HALF + m * 16) * ldc;
#pragma unroll
                for (int bj = 0; bj < 2; ++bj) *(u32x4*)(rp + bj * HALF) = pack8(acc[ai][bj][m][0], acc[ai][bj][m][1]); }
    }
};
struct EpiMlaIn {
    static constexpr bool PERM = true, AFTER_DRAIN = false, APERM = false, HAS_PRE = true, F16 = true;
    bf16_t *CQ, *CKV, *KR; fx64 *ssq_q, *ssq_kv; const float *cosM, *sinM; LnCorr lc;
    __device__ __forceinline__ void prefetch(const Unit& u, PG8_LAS unsigned char* pfa, int wid, int lane) const { ln_prefetch(lc, u, pfa, wid, lane); }
    __device__ __forceinline__ void pre(f32x4 (&acc)[2][2][4][2], const Unit& u, int wr, int wc, int fr, int fq, const PG8_LAS unsigned char* pfa) const { ln_correct<true>(lc, acc, wr, wc, fr, fq, pfa); }
    __device__ __forceinline__ void operator()(const f32x4 (&acc)[2][2][4][2], const Unit& u, int wr, int wc, int fr, int fq) const {
        const int row0 = u.pm * BM + wr * 64 + fr, cl = wc * 32 + 8 * fq;
        if (u.pn < 8) {
            const bool isq = u.pn < 6; const int ldc = isq ? 1536 : 512;
            bf16_t* base = (isq ? CQ + (size_t)u.pn * 256 : CKV + (size_t)(u.pn - 6) * 256) + cl; fx64* ssq = isq ? ssq_q : ssq_kv;
#pragma unroll
            for (int ai = 0; ai < 2; ++ai)
#pragma unroll
                for (int m = 0; m < 4; ++m) { const int r = row0 + ai * HALF + m * 16; bf16_t* rp = base + (size_t)r * ldc; float s = 0.f;
#pragma unroll
                    for (int bj = 0; bj < 2; ++bj) { const f32x4 a = acc[ai][bj][m][0], b = acc[ai][bj][m][1];
                        s += (a[0] * a[0] + a[1] * a[1]) + (a[2] * a[2] + a[3] * a[3]) + (b[0] * b[0] + b[1] * b[1]) + (b[2] * b[2] + b[3] * b[3]);
                        *(u32x4*)(rp + bj * HALF) = pack8(a, b); }
                    s += __shfl_xor(s, 16); s += __shfl_xor(s, 32);
                    if (fq == 0) fx_add(ssq + r, s); }
        } else if (wc == 0) {
#pragma unroll
            for (int ai = 0; ai < 2; ++ai)
#pragma unroll
                for (int m = 0; m < 4; ++m) { const int r = row0 + ai * HALF + m * 16; const int pos = seq_pos(r);
                    const float* cp = cosM + (size_t)pos * 32 + 8 * fq; const float* sp = sinM + (size_t)pos * 32 + 8 * fq;
                    const f32x4 c0 = *(const f32x4*)cp, c1 = *(const f32x4*)(cp + 4), s0 = *(const f32x4*)sp, s1 = *(const f32x4*)(sp + 4);
                    const f32x4 x1a = acc[ai][0][m][0], x1b = acc[ai][0][m][1], x2a = acc[ai][1][m][0], x2b = acc[ai][1][m][1];
                    const f32x4 y1a = x1a * c0 - x2a * s0, y1b = x1b * c1 - x2b * s1, y2a = x1a * s0 + x2a * c0, y2b = x1b * s1 + x2b * c1;
                    bf16_t* rp = KR + (size_t)r * 64 + 8 * fq;
                    *(u32x4*)rp = pack8(y1a, y1b); *(u32x4*)(rp + 32) = pack8(y2a, y2b); }
        }
    }
};
__device__ __forceinline__ void ssq_prefetch(const fx64* ssq, const Unit& u, PG8_LAS unsigned char* pfa, int wid, int lane) {
    if (wid < 2) __builtin_amdgcn_global_load_lds((const unsigned*)(ssq + u.pm * BM + 128 * wid + 2 * lane), (PG8_LAS unsigned*)(pfa + wid * 1024), 16, 0, 0);
}
__device__ __forceinline__ void ssq_scale(f32x4 (&acc)[2][2][4][2], float inv_n, int wr, int fr, const PG8_LAS unsigned char* pfa) {
#pragma unroll
    for (int ai = 0; ai < 2; ++ai)
#pragma unroll
        for (int m = 0; m < 4; ++m) { const float rs = __builtin_amdgcn_rsqf(fx_val(*(const PG8_LAS fx64*)(pfa + (ai * HALF + wr * 64 + m * 16 + fr) * 8)) * inv_n + 1e-6f);
#pragma unroll
            for (int bj = 0; bj < 2; ++bj)
#pragma unroll
                for (int n = 0; n < 2; ++n) acc[ai][bj][m][n] = acc[ai][bj][m][n] * rs; }
}
struct EpiMlaUq {
    static constexpr bool PERM = true, AFTER_DRAIN = false, APERM = false, HAS_PRE = true, F16 = false;
    bf16_t* QA; const fx64* ssq_q; const float *cosM, *sinM;
    __device__ __forceinline__ void prefetch(const Unit& u, PG8_LAS unsigned char* pfa, int wid, int lane) const { ssq_prefetch(ssq_q, u, pfa, wid, lane); }
    __device__ __forceinline__ void pre(f32x4 (&acc)[2][2][4][2], const Unit& u, int wr, int wc, int fr, int fq, const PG8_LAS unsigned char* pfa) const { ssq_scale(acc, 1.0f / 1536.0f, wr, fr, pfa); }
    __device__ __forceinline__ void operator()(const f32x4 (&acc)[2][2][4][2], const Unit& u, int wr, int wc, int fr, int fq) const {
        const int row0 = u.pm * BM + wr * 64 + fr;
#pragma unroll
        for (int ai = 0; ai < 2; ++ai)
#pragma unroll
            for (int m = 0; m < 4; ++m) { const int r = row0 + ai * HALF + m * 16;
                bf16_t* rp = QA + (size_t)r * 3072;
                if (u.pn < 8) {
#pragma unroll
                    for (int bj = 0; bj < 2; ++bj) *(u32x4*)(rp + (2 * u.pn + bj) * 192 + wc * 32 + 8 * fq) = pack8(acc[ai][bj][m][0], acc[ai][bj][m][1]);
                } else {
                    const int head = 4 * (u.pn - 8) + wc; const int pos = seq_pos(r);
                    const float* cp = cosM + (size_t)pos * 32 + 8 * fq; const float* sp = sinM + (size_t)pos * 32 + 8 * fq;
                    const f32x4 c0 = *(const f32x4*)cp, c1 = *(const f32x4*)(cp + 4), s0 = *(const f32x4*)sp, s1 = *(const f32x4*)(sp + 4);
                    const f32x4 x1a = acc[ai][0][m][0], x1b = acc[ai][0][m][1], x2a = acc[ai][1][m][0], x2b = acc[ai][1][m][1];
                    const f32x4 y1a = x1a * c0 - x2a * s0, y1b = x1b * c1 - x2b * s1, y2a = x1a * s0 + x2a * c0, y2b = x1b * s1 + x2b * c1;
                    *(u32x4*)(rp + head * 192 + 128 + 8 * fq) = pack8(y1a, y1b); *(u32x4*)(rp + head * 192 + 160 + 8 * fq) = pack8(y2a, y2b);
                }
                asm volatile("" ::: "memory"); }
    }
};
struct EpiMlaUkv {
    static constexpr bool PERM = true, AFTER_DRAIN = false, APERM = false, HAS_PRE = true, F16 = false;
    bf16_t* KV; const fx64* ssq_kv;
    __device__ __forceinline__ void prefetch(const Unit& u, PG8_LAS unsigned char* pfa, int wid, int lane) const { ssq_prefetch(ssq_kv, u, pfa, wid, lane); }
    __device__ __forceinline__ void pre(f32x4 (&acc)[2][2][4][2], const Unit& u, int wr, int wc, int fr, int fq, const PG8_LAS unsigned char* pfa) const { ssq_scale(acc, 1.0f / 512.0f, wr, fr, pfa); }
    __device__ __forceinline__ void operator()(const f32x4 (&acc)[2][2][4][2], const Unit& u, int wr, int wc, int fr, int fq) const {
        const int row0 = u.pm * BM + wr * 64 + fr, cl = wc * 32 + 8 * fq;
#pragma unroll
        for (int ai = 0; ai < 2; ++ai)
#pragma unroll
            for (int m = 0; m < 4; ++m) { const int r = row0 + ai * HALF + m * 16;
                bf16_t* rp = KV + (size_t)r * 4096 + (size_t)u.pn * 256 + cl;
#pragma unroll
                for (int bj = 0; bj < 2; ++bj) *(u32x4*)(rp + bj * HALF) = pack8(acc[ai][bj][m][0], acc[ai][bj][m][1]); }
    }
};
#define DPP_ROR(x, n) __builtin_bit_cast(float, __builtin_amdgcn_update_dpp(0, __builtin_bit_cast(int, (float)(x)), 0x120 + (n), 0xf, 0xf, false))
struct EpiFfnUp {
    static constexpr bool PERM = true, AFTER_DRAIN = false, APERM = true, HAS_PRE = true, F16 = true;
    bf16_t *A, *EG, *EU; const float *cw, *cb; LnCorr lc;
    __device__ __forceinline__ void prefetch(const Unit& u, PG8_LAS unsigned char* pfa, int wid, int lane) const { ln_prefetch(lc, u, pfa, wid, lane); }
    __device__ __forceinline__ void pre(f32x4 (&acc)[2][2][4][2], const Unit& u, int wr, int wc, int fr, int fq, const PG8_LAS unsigned char* pfa) const { ln_correct<true, true>(lc, acc, wr, wc, fr, fq, pfa); }
    __device__ __forceinline__ void operator()(const f32x4 (&acc)[2][2][4][2], const Unit& u, int wr, int wc, int fr, int fq) const {
        const int ch0 = u.pn * 128 + wc * 32 + 8 * fq;
        f32x4 w0[2], w1[2], w2[2], bb[2];
#pragma unroll
        for (int n = 0; n < 2; ++n) { w0[n] = *(const f32x4*)(cw + ch0 + 4 * n); w1[n] = *(const f32x4*)(cw + FFN + ch0 + 4 * n); w2[n] = *(const f32x4*)(cw + 2 * FFN + ch0 + 4 * n); bb[n] = *(const f32x4*)(cb + ch0 + 4 * n); }
#pragma unroll
        for (int ai = 0; ai < 2; ++ai) {
            const int rblk = u.pm * BM + ai * HALF + wr * 64; const int blk = rblk >> 6;
            f32x4 P[2], Nx[2];
#pragma unroll
            for (int n = 0; n < 2; ++n)
#pragma unroll
                for (int e = 0; e < 4; ++e) { P[n][e] = DPP_ROR(acc[ai][1][3][n][e], 1); Nx[n][e] = DPP_ROR(acc[ai][1][0][n][e], 15); }
#pragma unroll
            for (int m = 0; m < 4; ++m) {
                f32x4 av[2];
#pragma unroll
                for (int n = 0; n < 2; ++n) {
                    const f32x4 gp = (m == 0) ? P[n] : acc[ai][1][m > 0 ? m - 1 : 0][n], gn = (m == 3) ? Nx[n] : acc[ai][1][m < 3 ? m + 1 : 3][n], gc = acc[ai][1][m][n];
                    f32x4 t = gp * w0[n] + gc * w1[n] + gn * w2[n] + bb[n];
#pragma unroll
                    for (int e = 0; e < 4; ++e) t[e] = t[e] * __builtin_amdgcn_rcpf(1.0f + __expf(-t[e]));
                    av[n] = t * acc[ai][0][m][n];
                }
                const int r = rblk + 4 * fr + m;
                const bool edge = (m == 0 && fr == 0) || (m == 3 && fr == 15);
                if (!edge) *(u32x4*)(A + (size_t)r * FFN + ch0) = pack8(av[0], av[1]);
                if (m < 2 && fr == 0) { *(u32x4*)(EG + ((size_t)blk * 4 + m) * FFN + ch0) = pack8(acc[ai][1][m][0], acc[ai][1][m][1]);
                    if (m == 0) *(u32x4*)(EU + ((size_t)blk * 2) * FFN + ch0) = pack8(acc[ai][0][0][0], acc[ai][0][0][1]); }
                if (m >= 2 && fr == 15) { *(u32x4*)(EG + ((size_t)blk * 4 + m) * FFN + ch0) = pack8(acc[ai][1][m][0], acc[ai][1][m][1]);
                    if (m == 3) *(u32x4*)(EU + ((size_t)blk * 2 + 1) * FFN + ch0) = pack8(acc[ai][0][3][0], acc[ai][0][3][1]); }
            }
        }
    }
};
}

typedef GAS unsigned gu32;
#define RLX_AGENT __ATOMIC_RELAXED, __HIP_MEMORY_SCOPE_AGENT
#define LDS_WAIT() asm volatile("s_waitcnt lgkmcnt(0)" ::: "memory")
#define VM_WAIT() asm volatile("s_waitcnt vmcnt(0)" ::: "memory")
#define SBAR() __builtin_amdgcn_sched_barrier(0)

#define XB_TMO      128
#define XB_XCNT(j)  (256  + 64 * (j))
#define XB_XSUB(j)  (1280 + 64 * (j))
#define XB_XGEN(j)  (2304 + 64 * (j))
#define XB_TOP      3328
#define XB_TOPGEN   3392
#define XCD_BAR_WORDS 3456
#define XB_SPIN_CAP (1u << 22)

__device__ __forceinline__ unsigned xb_ld(unsigned* p)              { return __hip_atomic_load(p, __ATOMIC_RELAXED, __HIP_MEMORY_SCOPE_AGENT); }
__device__ __forceinline__ unsigned xb_add(unsigned* p, unsigned v) { return __hip_atomic_fetch_add(p, v, __ATOMIC_RELAXED, __HIP_MEMORY_SCOPE_AGENT); }
__device__ __forceinline__ unsigned xb_xcc_id() { return (unsigned)__builtin_amdgcn_s_getreg((3 << 11) | 20) & 0xFu; }
#define XB_SPIN(cond, bar) do { unsigned _sp = 0; while (cond) { __builtin_amdgcn_s_sleep(1); \
    if ((++_sp & 255u) == 0u) { if (xb_ld(&(bar)[XB_TMO])) break; if (_sp > XB_SPIN_CAP) { atomicAdd(&(bar)[XB_TMO], 1u); break; } } } } while (0)

struct XcdBarrier {
    unsigned* bar; unsigned x;
    volatile LAS unsigned* st;
};

__device__ __forceinline__ XcdBarrier xcd_barrier_post(unsigned* bar, volatile LAS unsigned* st) {
    XcdBarrier b; b.bar = bar; b.x = xb_xcc_id(); b.st = st;
    if (threadIdx.x == 0) (void)xb_add(&bar[XB_XCNT(b.x)], 1u);
    return b;
}
__device__ __forceinline__ void xcd_barrier_complete(unsigned* bar, unsigned x, unsigned& nloc, unsigned& nx) {
    const unsigned G = gridDim.x * gridDim.y * gridDim.z;
    unsigned sum, cnt, mine, sp = 0u;
    for (;;) {
        sum = 0u; cnt = 0u; mine = 0u;
#pragma unroll
        for (unsigned j = 0; j < 16; ++j) { const unsigned c = xb_ld(&bar[XB_XCNT(j)]); sum += c; cnt += (c > 0u) ? 1u : 0u; mine = (j == x) ? c : mine; }
        if (sum == G) break;
        __builtin_amdgcn_s_sleep(1);
        if ((++sp & 255u) == 0u) { if (xb_ld(&bar[XB_TMO])) break; if (sp > XB_SPIN_CAP) { atomicAdd(&bar[XB_TMO], 1u); break; } }
    }
    nloc = mine > 0u ? mine : 1u; nx = cnt > 0u ? cnt : 1u;
}

__device__ __forceinline__ void xcd_barrier(const XcdBarrier& b) {
    asm volatile("s_waitcnt vmcnt(0)" ::: "memory");
    __syncthreads();
    if (threadIdx.x == 0) {
        unsigned* bar = b.bar;
        __builtin_amdgcn_s_waitcnt(0);
        unsigned nloc = b.st[0], nx = b.st[1];
        if (nloc == 0u) { xcd_barrier_complete(bar, b.x, nloc, nx); b.st[0] = nloc; b.st[1] = nx; }
        const unsigned old = xb_add(&bar[XB_XSUB(b.x)], 1u);
        const unsigned gen = old / nloc;
        if (old + 1u == (gen + 1u) * nloc) {
            __builtin_amdgcn_fence(__ATOMIC_RELEASE, "agent");
            asm volatile("s_waitcnt vmcnt(0)" ::: "memory");
            const unsigned og = xb_add(&bar[XB_TOP], 1u);
            const unsigned tg = og / nx;
            if (og + 1u == (tg + 1u) * nx) xb_add(&bar[XB_TOPGEN], 1u);
            else XB_SPIN(xb_ld(&bar[XB_TOPGEN]) == tg, bar);
            __builtin_amdgcn_fence(__ATOMIC_ACQUIRE, "agent");
            xb_add(&bar[XB_XGEN(b.x)], 1u);
            asm volatile("s_waitcnt vmcnt(0)" ::: "memory");
        } else {
            XB_SPIN(xb_ld(&bar[XB_XGEN(b.x)]) == gen, bar);
            __builtin_amdgcn_fence(__ATOMIC_ACQUIRE, "agent");
            asm volatile("s_waitcnt vmcnt(0)" ::: "memory");
        }
    }
    __syncthreads();
}


constexpr size_t MiB = 1u << 20;
constexpr size_t WS_CTL = 0, CTL_ZERO_BYTES = 8 * MiB;
constexpr int    CW_BAR = 4096;
constexpr size_t CTL_SSQ = 1 * MiB;
constexpr size_t CTL_LGTAB = 64 * 1024;
constexpr size_t CTL_STATS = 2 * MiB;
constexpr size_t CTL_CSB2 = 6 * MiB;
constexpr size_t CTL_CSF = 8 * MiB;
constexpr size_t WS_TAB = 9 * MiB;
constexpr size_t WS_W = 19 * MiB;
constexpr size_t WS_XB = 149 * MiB;
constexpr size_t WS_WD2 = 277 * MiB;
constexpr size_t WS_ACT = 357 * MiB;
constexpr size_t WS_END = WS_ACT + 1024 * MiB;
constexpr size_t W_RET_OUT = 0, W_UP = 16 * MiB, W_DOWN = 60 * MiB, W_RET_IN = 82 * MiB;
constexpr size_t W_MLA_OUT = 0, W_MLA_IN = 82 * MiB, W_MLA_UQ = 92 * MiB, W_MLA_UKV = 102 * MiB;
constexpr size_t A_RQ = 0, A_RK = 128 * MiB, A_RV = 256 * MiB, A_RG = 512 * MiB, A_RO = 768 * MiB;
constexpr size_t A_FU = 0, A_FG = 352 * MiB;
constexpr size_t A_MCQ = 0, A_MCKV = 96 * MiB, A_MKR = 128 * MiB, A_MQA = 132 * MiB, A_MKV = 324 * MiB, A_MO = 580 * MiB;

constexpr int RING_OFF = 0, RING_BYTES = 159744;
constexpr int LDSCTL_OFF = RING_BYTES, MISC_OFF = LDSCTL_OFF + 320;
constexpr int LDS_BYTES = 163840;
constexpr int NWAVES = 8;


struct Frame {
    LAS unsigned char* lds;
    int wave;
    int vcu, G;
    int gw, NGW;
};

#define PHASE_TID(tid, lane) int tid = threadIdx.x; asm volatile("" : "+v"(tid)); const int lane = tid & 63; int gw_ = F.gw; asm volatile("" : "+s"(gw_)); const int gw = gw_, NGW = 2048; (void)gw; (void)NGW

__device__ __forceinline__ float wave_sum(float v) {
#pragma unroll
    for (int o = 1; o < 64; o <<= 1) v += __shfl_xor(v, o);
    return v;
}

#ifndef WQ_DROP
#define WQ_DROP 1
#endif
__device__ __forceinline__ unsigned WQ(unsigned w) {
    if (WQ_DROP == 0) return w;
    const unsigned half = (1u << (WQ_DROP - 1)) - 1u, lsb = (w >> WQ_DROP) & 0x00010001u, msk = ~(((1u << WQ_DROP) - 1u) * 0x00010001u);
    return (w + half * 0x00010001u + lsb) & msk;
}
__device__ __forceinline__ void tr_item(const float* __restrict__ W, int K, int N, bf16* WT, int k0, int n0, int drow0, float sc, const float* __restrict__ ks, const float* __restrict__ bln, fx64* csp, fx64* b2p, bool f16, LAS float* scr, int lane) {
    const int r = lane >> 3, q = lane & 7;
    f32x4 wv[8];
#pragma unroll
    for (int i = 0; i < 8; ++i) wv[i] = *(const GAS f32x4*)(W + (size_t)(k0 + 8 * i + r) * N + n0 + 4 * q);
    f32x4 pc = {0.f, 0.f, 0.f, 0.f}, pb = {0.f, 0.f, 0.f, 0.f};
#pragma unroll
    for (int i = 0; i < 8; ++i) { const int kk = 8 * i + r; const f32x4 w = wv[i] * sc; f32x4 v = w; if (ks) v = v * ks[k0 + kk];
        LAS float* d = scr + kk * 33 + 4 * q; d[0] = v[0]; d[1] = v[1]; d[2] = v[2]; d[3] = v[3];
        if (csp) { pc += v; pb += w * bln[k0 + kk]; } }
    if (csp) {
#pragma unroll
        for (int e = 0; e < 4; ++e) { float a = pc[e], bb = pb[e];
            a += __shfl_xor(a, 8); a += __shfl_xor(a, 16); a += __shfl_xor(a, 32); bb += __shfl_xor(bb, 8); bb += __shfl_xor(bb, 16); bb += __shfl_xor(bb, 32);
            if (lane < 8) { fx_add(csp + drow0 + 4 * lane + e, a); fx_add(b2p + drow0 + 4 * lane + e, bb); } } }
    LDS_WAIT(); asm volatile("" ::: "memory");
    const int c = lane & 7;
#pragma unroll
    for (int j = 0; j < 4; ++j) { const int n = (lane >> 3) + 8 * j; const LAS float* s = scr + (8 * c) * 33 + n;
        v4u o;
        if (f16) {
            const unsigned w0 = WQ(pkbf(s[0 * 33], s[1 * 33])), w1 = WQ(pkbf(s[2 * 33], s[3 * 33])), w2 = WQ(pkbf(s[4 * 33], s[5 * 33])), w3 = WQ(pkbf(s[6 * 33], s[7 * 33]));
            o.x = pkh(bflo(w0), bfhi(w0)); o.y = pkh(bflo(w1), bfhi(w1)); o.z = pkh(bflo(w2), bfhi(w2)); o.w = pkh(bflo(w3), bfhi(w3)); }
        else { o.x = WQ(pkbf(s[0 * 33], s[1 * 33])); o.y = WQ(pkbf(s[2 * 33], s[3 * 33])); o.z = WQ(pkbf(s[4 * 33], s[5 * 33])); o.w = WQ(pkbf(s[6 * 33], s[7 * 33])); }
        *(GAS v4u*)(WT + (size_t)(drow0 + n) * K + k0 + 8 * c) = o; }
    LDS_WAIT(); asm volatile("" ::: "memory");
}
__device__ __forceinline__ int rowmap_mla_in(int nb) { return nb < 64 ? 32 * nb : (nb == 64 ? 2048 : 2048 + 128); }
__device__ __forceinline__ int rowmap_uq(int nb) { const int head = nb / 6, w = nb % 6; return w < 4 ? head * 128 + 32 * w : 2048 + (head >> 2) * 256 + (w == 5 ? 128 : 0) + (head & 3) * 32; }

__device__ __forceinline__ void convert_matrix(const Frame& F, const float* W, int K, int N, bf16* WT, int mode, float sc, const float* ks, const float* bln, fx64* csb, LAS float* scr, int& rot) {
    PHASE_TID(tid, lane); (void)tid;
    const int nblk = N / 32, nitems = (K / 64) * nblk;
    const bool f16 = (mode == 1 || mode == 2 || mode == 4);
    const int it0 = (gw - rot) & (NGW - 1); rot = (rot + nitems) & (NGW - 1);
    for (int it = it0; it < nitems; it += NGW) {
        const int kb = it / nblk, nb = it % nblk;
        int drow = 32 * nb; float s = sc;
        if (mode == 1) { if (nb >= 64 && nb < 128) s = 0.0625f; }
        else if (mode == 2) drow = rowmap_mla_in(nb);
        else if (mode == 3) drow = rowmap_uq(nb);
        else if (mode == 4) drow = nb < 176 ? (nb >> 2) * 256 + 32 * (nb & 3) : ((nb - 176) >> 2) * 256 + 128 + 32 * ((nb - 176) & 3);
        tr_item(W, K, N, WT, 64 * kb, 32 * nb, drow, s, ks, bln, csb, csb + 16384, f16, scr, lane);
    }
}

__device__ __forceinline__ void csb2_finalize(const Frame& F, const fx64* src, float* dst, int n) {
    PHASE_TID(tid, lane); (void)tid;
    for (int i = gw * 64 + lane; i < n; i += NGW * 64) dst[i] = fx_load(src + i);
}

__device__ __forceinline__ void ln_pass(const Frame& F, float* Y, bf16* XB, float* stats, const float* __restrict__ g, const float* __restrict__ b, bool final) {
    PHASE_TID(tid, lane); (void)tid;
    for (int m = gw; m < T; m += NGW) {
        GAS f32x4* xr = (GAS f32x4*)(Y + (size_t)m * DM) + lane;
        f32x4 v[8]; float s = 0.f;
#pragma unroll
        for (int j = 0; j < 8; ++j) { v[j] = xr[64 * j]; s += (v[j].x + v[j].y) + (v[j].z + v[j].w); }
        const float mean = wave_sum(s) * (1.f / DM); float s2 = 0.f;
#pragma unroll
        for (int j = 0; j < 8; ++j) { v[j] = v[j] - mean; s2 += (v[j].x * v[j].x + v[j].y * v[j].y) + (v[j].z * v[j].z + v[j].w * v[j].w); }
        const float rstd = 1.0f / sqrtf(wave_sum(s2) * (1.f / DM) + 1e-5f);
        GAS v2u* o8 = (GAS v2u*)(XB + (size_t)m * DM) + lane;
        if (!final && lane == 0) { stats[2 * m] = mean; stats[2 * m + 1] = rstd; }
#pragma unroll
        for (int j = 0; j < 8; ++j) { const f32x4 gg = *((const f32x4*)g + 64 * j + lane), bb = *((const f32x4*)b + 64 * j + lane);
            const f32x4 y = v[j] * rstd * gg + bb;
            if (final) xr[64 * j] = y; else { v2u w; w.x = pkbf(y.x, y.y); w.y = pkbf(y.z, y.w); o8[64 * j] = w; } }
    }
}

__device__ __forceinline__ void gate_pass(const Frame& F, const bf16* O, const bf16* OB, bf16* G, bf16* D) {
    PHASE_TID(tid, lane); (void)tid;
    for (int m = gw; m < T; m += NGW) {
        const GAS v4u* orow = (const GAS v4u*)(O + (size_t)m * 4096) + lane; const GAS v4u* brow = (const GAS v4u*)(OB + (size_t)m * 4096) + lane; GAS v4u* grow = (GAS v4u*)(G + (size_t)m * 4096) + lane; GAS v4u* drow = (GAS v4u*)(D + (size_t)m * 4096) + lane;
#pragma unroll
        for (int hp = 0; hp < 8; hp += 4) {
            v4u ov[4], bv[4], gv[4];
#pragma unroll
            for (int h = 0; h < 4; ++h) { ov[h] = orow[64 * (hp + h)]; bv[h] = brow[64 * (hp + h)]; gv[h] = grow[64 * (hp + h)]; }
#pragma unroll
            for (int h = 0; h < 4; ++h) {
                float x[8]; x[0] = bflo(ov[h].x) + bflo(bv[h].x); x[1] = bfhi(ov[h].x) + bfhi(bv[h].x); x[2] = bflo(ov[h].y) + bflo(bv[h].y); x[3] = bfhi(ov[h].y) + bfhi(bv[h].y);
                x[4] = bflo(ov[h].z) + bflo(bv[h].z); x[5] = bfhi(ov[h].z) + bfhi(bv[h].z); x[6] = bflo(ov[h].w) + bflo(bv[h].w); x[7] = bfhi(ov[h].w) + bfhi(bv[h].w);
                float gt[8]; gt[0] = bflo(gv[h].x); gt[1] = bfhi(gv[h].x); gt[2] = bflo(gv[h].y); gt[3] = bfhi(gv[h].y); gt[4] = bflo(gv[h].z); gt[5] = bfhi(gv[h].z); gt[6] = bflo(gv[h].w); gt[7] = bfhi(gv[h].w);
                float s = 0.f;
#pragma unroll
                for (int e = 0; e < 8; ++e) s += x[e];
                const float mean = wave_sum(s) * (1.f / 512.f); float s2 = 0.f;
#pragma unroll
                for (int e = 0; e < 8; ++e) { x[e] -= mean; s2 += x[e] * x[e]; }
                const float rstd = __builtin_amdgcn_rsqf(wave_sum(s2) * (1.f / 512.f) + 1e-6f);
                float y[8];
#pragma unroll
                for (int e = 0; e < 8; ++e) { const float sg = gt[e] * __builtin_amdgcn_rcpf(1.0f + __expf(-gt[e])); y[e] = sg * x[e] * rstd; }
                v4u w; w.x = pkbf(y[0], y[1]); w.y = pkbf(y[2], y[3]); w.z = pkbf(y[4], y[5]); w.w = pkbf(y[6], y[7]);
                drow[64 * (hp + h)] = w;
            }
        }
    }
}

__device__ __forceinline__ void conv_pass(const Frame& F, bf16* U, const bf16* G, const float* __restrict__ cw, const float* __restrict__ cb) {
    PHASE_TID(tid, lane); (void)tid;
    constexpr int NCB = FFN / 512, NTB = T / 32;
    for (int it = gw; it < NCB * NTB; it += NGW) {
        const int cbk = it % NCB, tb = it / NCB; const int c0 = cbk * 512 + lane * 8, t0 = tb * 32;
        float w0[8], w1[8], w2[8], bb[8];
#pragma unroll
        for (int e = 0; e < 8; ++e) { w0[e] = cw[c0 + e]; w1[e] = cw[FFN + c0 + e]; w2[e] = cw[2 * FFN + c0 + e]; bb[e] = cb[c0 + e]; }
        const int p0 = seq_pos(t0), L = t0 < TP ? 8192 : 2048;
        const GAS v4u* gp = (const GAS v4u*)(G + (size_t)t0 * FFN + c0); GAS v4u* up = (GAS v4u*)(U + (size_t)t0 * FFN + c0);
        constexpr int RS = FFN / 8;
        const float fprev = p0 > 0 ? 1.f : 0.f;
        v4u prev = gp[p0 > 0 ? -RS : 0], cur = gp[0];
#pragma unroll 4
        for (int t = 0; t < 32; ++t) {
            const bool has_n = (p0 + t + 1 < L); const float fnext = has_n ? 1.f : 0.f; const float fp = (t == 0) ? fprev : 1.f;
            const v4u nxt = gp[(size_t)(has_n ? t + 1 : t) * RS]; const v4u uu = up[(size_t)t * RS];
            float a[8], c[8], n[8], u8[8], y[8];
            a[0] = bflo(prev.x); a[1] = bfhi(prev.x); a[2] = bflo(prev.y); a[3] = bfhi(prev.y); a[4] = bflo(prev.z); a[5] = bfhi(prev.z); a[6] = bflo(prev.w); a[7] = bfhi(prev.w);
            c[0] = bflo(cur.x); c[1] = bfhi(cur.x); c[2] = bflo(cur.y); c[3] = bfhi(cur.y); c[4] = bflo(cur.z); c[5] = bfhi(cur.z); c[6] = bflo(cur.w); c[7] = bfhi(cur.w);
            n[0] = bflo(nxt.x); n[1] = bfhi(nxt.x); n[2] = bflo(nxt.y); n[3] = bfhi(nxt.y); n[4] = bflo(nxt.z); n[5] = bfhi(nxt.z); n[6] = bflo(nxt.w); n[7] = bfhi(nxt.w);
            u8[0] = bflo(uu.x); u8[1] = bfhi(uu.x); u8[2] = bflo(uu.y); u8[3] = bfhi(uu.y); u8[4] = bflo(uu.z); u8[5] = bfhi(uu.z); u8[6] = bflo(uu.w); u8[7] = bfhi(uu.w);
#pragma unroll
            for (int e = 0; e < 8; ++e) { const float gcv = fp * a[e] * w0[e] + c[e] * w1[e] + fnext * n[e] * w2[e] + bb[e]; y[e] = gcv * __builtin_amdgcn_rcpf(1.0f + __expf(-gcv)) * u8[e]; }
            v4u w; w.x = pkbf(y[0], y[1]); w.y = pkbf(y[2], y[3]); w.z = pkbf(y[4], y[5]); w.w = pkbf(y[6], y[7]);
            up[(size_t)t * RS] = w; prev = cur; cur = nxt;
        }
    }
}


__device__ __forceinline__ void ffn_fixup(const Frame& F, bf16* A, const bf16* EG, const bf16* EU, const float* __restrict__ cw, const float* __restrict__ cb) {
    PHASE_TID(tid, lane); (void)tid;
    constexpr int NCB = FFN / 512, NER = (T / 64) * 2;
    for (int it = gw; it < NCB * NER; it += NGW) {
        const int cbk = it % NCB, er = it / NCB, blk = er >> 1, last = er & 1; const int c0 = cbk * 512 + lane * 8;
        const int r = blk * 64 + (last ? 63 : 0); const int pos = seq_pos(r), L = r < TP ? 8192 : 2048;
        const bool hasp = pos > 0, hasn = pos < L - 1;
        const size_t ip = last ? (size_t)blk * 4 + 2 : (hasp ? (size_t)(blk - 1) * 4 + 3 : (size_t)blk * 4);
        const size_t ic = last ? (size_t)blk * 4 + 3 : (size_t)blk * 4;
        const size_t in = last ? (hasn ? (size_t)(blk + 1) * 4 : (size_t)blk * 4 + 3) : (size_t)blk * 4 + 1;
        const float fp = (last || hasp) ? 1.f : 0.f, fn = (!last || hasn) ? 1.f : 0.f;
        const v4u gp = *(const GAS v4u*)(EG + ip * FFN + c0), gc = *(const GAS v4u*)(EG + ic * FFN + c0), gn = *(const GAS v4u*)(EG + in * FFN + c0);
        const v4u uu = *(const GAS v4u*)(EU + ((size_t)blk * 2 + last) * FFN + c0);
        float a[8], c[8], n[8], u8[8], y[8];
        a[0] = bflo(gp.x); a[1] = bfhi(gp.x); a[2] = bflo(gp.y); a[3] = bfhi(gp.y); a[4] = bflo(gp.z); a[5] = bfhi(gp.z); a[6] = bflo(gp.w); a[7] = bfhi(gp.w);
        c[0] = bflo(gc.x); c[1] = bfhi(gc.x); c[2] = bflo(gc.y); c[3] = bfhi(gc.y); c[4] = bflo(gc.z); c[5] = bfhi(gc.z); c[6] = bflo(gc.w); c[7] = bfhi(gc.w);
        n[0] = bflo(gn.x); n[1] = bfhi(gn.x); n[2] = bflo(gn.y); n[3] = bfhi(gn.y); n[4] = bflo(gn.z); n[5] = bfhi(gn.z); n[6] = bflo(gn.w); n[7] = bfhi(gn.w);
        u8[0] = bflo(uu.x); u8[1] = bfhi(uu.x); u8[2] = bflo(uu.y); u8[3] = bfhi(uu.y); u8[4] = bflo(uu.z); u8[5] = bfhi(uu.z); u8[6] = bflo(uu.w); u8[7] = bfhi(uu.w);
#pragma unroll
        for (int e = 0; e < 8; ++e) { const float gcv = fp * a[e] * cw[c0 + e] + c[e] * cw[FFN + c0 + e] + fn * n[e] * cw[2 * FFN + c0 + e] + cb[c0 + e]; y[e] = gcv * __builtin_amdgcn_rcpf(1.0f + __expf(-gcv)) * u8[e]; }
        v4u w; w.x = pkbf(y[0], y[1]); w.y = pkbf(y[2], y[3]); w.z = pkbf(y[4], y[5]); w.w = pkbf(y[6], y[7]);
        *(GAS v4u*)(A + (size_t)r * FFN + c0) = w;
    }
}

__device__ __forceinline__ float log2_sigmoid(float x) { return (float)(-log1p(exp(-(double)x)) * 1.4426950408889634); }
__device__ __forceinline__ void prologue(const Frame& F, const float* xp, const float* xs, float* X, bf16* XB, float* cosR, float* sinR, float* cosM, float* sinM, const float* dfw, const float* dbw, float* lgtab) {
    PHASE_TID(tid, lane); (void)tid;
    if (gw == 0 && lane < 32) { const int jl = lane >> 4, head = (lane >> 1) & 7; lgtab[lane] = log2_sigmoid((lane & 1) ? dbw[jl * 8 + head] : dfw[jl * 8 + head]); }
    const int gt = gw * 64 + lane, NGT = NGW * 64;
    auto tables = [&]() {
        for (int i = gt; i < 8192 * 128; i += NGT) { const int pos = i >> 7, d = i & 127;
            const float e = (float)d * (2.0f / 256.0f); const float inv = 1.0f / powf(10000.0f, e); const float ang = (float)pos * inv;
            cosR[i] = cosf(ang); sinR[i] = sinf(ang); }
        for (int i = gt; i < 8192 * 32; i += NGT) { const int pos = i >> 5, d = i & 31;
            const float e = (float)d * (2.0f / 64.0f); const float inv = 1.0f / powf(10000.0f, e); const float ang = (float)pos * inv;
            cosM[i] = cosf(ang); sinM[i] = sinf(ang); } };
    auto copy = [&]() {
        for (int m = gw; m < T; m += NGW) {
            const GAS f32x4* src = (const GAS f32x4*)((m < TP ? xp + (size_t)m * DM : xs + (size_t)(m - TP) * DM)) + lane;
            GAS v2u* o8 = (GAS v2u*)(XB + (size_t)m * DM) + lane;
#pragma unroll
            for (int j = 0; j < 8; ++j) { const f32x4 v = src[64 * j]; v2u w; w.x = pkh(v.x, v.y); w.y = pkh(v.z, v.w); o8[64 * j] = w; }
        } };
    if (F.wave & 1) { copy(); tables(); } else { tables(); copy(); }
}

#ifndef RETD
#define RETD 0
#endif
namespace ret {
constexpr int C = 64, W = 128, LQ = 264, LV = 136, LP = 72;
constexpr int OFF_Q = 0, OFF_K = 33792, OFF_V = 67584, OFF_VZ = 84992, OFF_P = 102400, OFF_OS = 111616, LDS_END = 129024;
static_assert(LDS_END <= RING_BYTES, "retention LDS");
typedef float f4 __attribute__((ext_vector_type(4)));
typedef float f2v __attribute__((ext_vector_type(2)));
typedef __bf16 b2v __attribute__((ext_vector_type(2)));
__device__ __forceinline__ unsigned pkbf_c(float lo, float hi) { const f2v v = {lo, hi}; return __builtin_bit_cast(unsigned, __builtin_convertvector(v, b2v)); }

__device__ __forceinline__ bf16x8 frag_rm(const LAS unsigned char* lds, int off, int ld, int r0, int k0, int lane) {
    return *(const LAS bf16x8*)(lds + off + ((r0 + (lane & 15)) * ld + k0 + 8 * (lane >> 4)) * 2);
}
template <int LDB, int K0, int R0> __device__ __forceinline__ void frag_tr_issue(s16x4& lo, s16x4& hi, unsigned base) {
    asm volatile("ds_read_b64_tr_b16 %0, %1 offset:%2" : "=&v"(lo) : "v"(base), "i"(K0 * LDB + R0 * 2) : "memory");
    asm volatile("ds_read_b64_tr_b16 %0, %1 offset:%2" : "=&v"(hi) : "v"(base), "i"(K0 * LDB + R0 * 2 + 4 * LDB) : "memory");
}
#define RET_PK(L, H) (bf16x8){L[0], L[1], L[2], L[3], H[0], H[1], H[2], H[3]}
#define MFMA16(a, b, c) __builtin_amdgcn_mfma_f32_16x16x32_bf16(a, b, c, 0, 0, 0)
#define RET_LWAIT() asm volatile("s_waitcnt lgkmcnt(0)" ::: "memory")

struct Stg { v4u q[4], k[4], v[2]; };

template <bool FWD>
__device__ __forceinline__ void sweep(const Frame& F, const bf16* Qg, const bf16* Kg, const bf16* Vg, bf16* Og, int nchunks, float lgf, float lgb) {
    LAS unsigned char* lds = F.lds + RING_OFF;
    int tid_l = threadIdx.x; asm volatile("" : "+v"(tid_l));
    const int tid = tid_l, lane = tid & 63, wid = __builtin_amdgcn_readfirstlane(tid >> 6), g = lane >> 4, i = lane & 15;
    const int nb = wid >> 1, cb = wid & 1;
    const int dvw = 16 * wid;
    const float lg = FWD ? lgf : lgb;
    const float gch = __builtin_amdgcn_exp2f(lg * (float)C);
    const int vrow = tid >> 4, vch = tid & 15;
    const float zeta0 = __builtin_amdgcn_exp2f(lg * (FWD ? (float)(C - 1 - vrow) : (float)vrow));
    const float zeta1 = __builtin_amdgcn_exp2f(lg * (FWD ? (float)(C - 1 - 32 - vrow) : (float)(32 + vrow)));
    const unsigned ldsb = (unsigned)(uintptr_t)lds;
    const unsigned trK = ldsb + OFF_K + (unsigned)((8 * g + (i >> 2)) * (LQ * 2) + 8 * (i & 3));
    const unsigned trVZ = ldsb + OFF_VZ + (unsigned)((8 * g + (i >> 2)) * (LV * 2) + (dvw + 4 * (i & 3)) * 2);
    const unsigned trV = ldsb + OFF_V + (unsigned)((8 * g + (i >> 2)) * (LV * 2) + (dvw + 4 * (i & 3)) * 2);
    f4 S[16];
#pragma unroll
    for (int t = 0; t < 16; ++t) S[t] = (f4){0.f, 0.f, 0.f, 0.f};
    Stg st;
    const unsigned voffQ = (unsigned)((tid >> 5) * 4096 + (tid & 31) * 16), voffV = (unsigned)(vrow * 8192 + vch * 16);
#define RET_LOAD(j) do { const GAS unsigned char* qb_ = (const GAS unsigned char*)Qg + (size_t)(j) * (C * 4096); const GAS unsigned char* kb_ = (const GAS unsigned char*)Kg + (size_t)(j) * (C * 4096); \
        const GAS unsigned char* vb_ = (const GAS unsigned char*)Vg + (size_t)(j) * (C * 8192); \
        _Pragma("unroll") for (int a = 0; a < 4; ++a) { st.q[a] = *(const GAS v4u*)(qb_ + a * 65536 + voffQ); st.k[a] = *(const GAS v4u*)(kb_ + a * 65536 + voffQ); } \
        st.v[0] = *(const GAS v4u*)(vb_ + voffV); st.v[1] = *(const GAS v4u*)(vb_ + 262144 + voffV); } while (0)
#define RET_FLUSH(jj) do { GAS unsigned char* ob_ = (GAS unsigned char*)Og + (size_t)(jj) * (C * 8192); \
        _Pragma("unroll") for (int a = 0; a < 2; ++a) { const v4u w = *(const LAS v4u*)(lds + OFF_OS + ((vrow + 32 * a) * LV + vch * 8) * 2); \
        *(GAS v4u*)(ob_ + a * 262144 + voffV) = w; } } while (0)
    const int j0 = FWD ? 0 : nchunks - 1, dj = FWD ? 1 : -1;
    __syncthreads();
    RET_LOAD(j0);
    for (int s = 0; s < nchunks; ++s) {
        const int j = j0 + dj * s;
        const bool do_intra = FWD ? ((j & 1) == 0) : ((j & 1) == 1);
        __syncthreads();
#pragma unroll
        for (int a = 0; a < 4; ++a) { const int id = tid + 512 * a, row = id >> 5, ch = id & 31;
            *(LAS v4u*)(lds + OFF_Q + (row * LQ + ch * 8) * 2) = st.q[a]; *(LAS v4u*)(lds + OFF_K + (row * LQ + ch * 8) * 2) = st.k[a]; }
#pragma unroll
        for (int a = 0; a < 2; ++a) { const float zt = a ? zeta1 : zeta0; const v4u vv = st.v[a]; const int row = 32 * a + vrow;
            if (do_intra) *(LAS v4u*)(lds + OFF_V + (row * LV + vch * 8) * 2) = vv;
            v4u z; z.x = pkbf(bflo(vv.x) * zt, bfhi(vv.x) * zt); z.y = pkbf(bflo(vv.y) * zt, bfhi(vv.y) * zt);
            z.z = pkbf(bflo(vv.z) * zt, bfhi(vv.z) * zt); z.w = pkbf(bflo(vv.w) * zt, bfhi(vv.w) * zt);
            *(LAS v4u*)(lds + OFF_VZ + (row * LV + vch * 8) * 2) = z; }
        if (s > 0) RET_FLUSH(j - dj);
        __syncthreads();
        f4 o[4];
#pragma unroll
        for (int nt = 0; nt < 4; ++nt) o[nt] = (f4){0.f, 0.f, 0.f, 0.f};
#pragma unroll
        for (int s2 = 0; s2 < 8; ++s2) {
            v4u bw; bw.x = pkbf_c(S[2 * s2][0], S[2 * s2][1]); bw.y = pkbf_c(S[2 * s2][2], S[2 * s2][3]); bw.z = pkbf_c(S[2 * s2 + 1][0], S[2 * s2 + 1][1]); bw.w = pkbf_c(S[2 * s2 + 1][2], S[2 * s2 + 1][3]);
            const bf16x8 bfr = __builtin_bit_cast(bf16x8, bw);
#pragma unroll
            for (int nt = 0; nt < 4; ++nt) {
                const LAS unsigned char* qp = lds + OFF_Q + ((16 * nt + i) * LQ + 32 * s2 + 4 * g) * 2;
                const v2u a0 = *(const LAS v2u*)qp, a1 = *(const LAS v2u*)(qp + 32);
                v4u aw; aw.x = a0.x; aw.y = a0.y; aw.z = a1.x; aw.w = a1.y;
                if (!(RETD & 1)) o[nt] = MFMA16(__builtin_bit_cast(bf16x8, aw), bfr, o[nt]);
            }
        }
#pragma unroll
        for (int nt = 0; nt < 4; ++nt)
#pragma unroll
            for (int r = 0; r < 4; ++r) { const int n = 16 * nt + 4 * g + r; o[nt][r] *= __builtin_amdgcn_exp2f(lg * (FWD ? (float)(n + 1) : (float)(C - n))); }
        if (s + 1 < nchunks) RET_LOAD(j + dj);
        if (do_intra && !(RETD & 4)) {
            f4 s0 = {0.f, 0.f, 0.f, 0.f}, s1 = {0.f, 0.f, 0.f, 0.f};
#pragma unroll
            for (int ks = 0; ks < 8; ++ks) {
                const bf16x8 a = frag_rm(lds, OFF_Q, LQ, 16 * nb, 32 * ks, lane);
                const bf16x8 b0 = frag_rm(lds, OFF_K, LQ, 32 * cb, 32 * ks, lane), b1 = frag_rm(lds, OFF_K, LQ, 32 * cb + 16, 32 * ks, lane);
                s0 = MFMA16(a, b0, s0); s1 = MFMA16(a, b1, s1);
            }
#pragma unroll
            for (int r = 0; r < 4; ++r) { const int n = 16 * nb + 4 * g + r;
                const int m0 = 32 * cb + i, m1 = m0 + 16;
                const float d0 = (m0 <= n) ? __builtin_amdgcn_exp2f(lgf * (float)(n - m0)) : __builtin_amdgcn_exp2f(lgb * (float)(m0 - n));
                const float d1 = (m1 <= n) ? __builtin_amdgcn_exp2f(lgf * (float)(n - m1)) : __builtin_amdgcn_exp2f(lgb * (float)(m1 - n));
                const float p0v = (RETD & 32) ? (float)(n + 1) * 0.01f + (float)m0 * 0.001f : s0[r] * d0, p1v = (RETD & 32) ? (float)(n + 1) * 0.01f + (float)m1 * 0.001f : s1[r] * d1;
                *(LAS unsigned short*)(lds + OFF_P + (n * LP + m0) * 2) = (unsigned short)(pkbf(p0v, 0.f) & 0xffffu);
                *(LAS unsigned short*)(lds + OFF_P + (n * LP + m1) * 2) = (unsigned short)(pkbf(p1v, 0.f) & 0xffffu); }
        }
#pragma unroll
        for (int t = 0; t < 16; ++t) S[t] = S[t] * gch;
        {
            s16x4 bl[2], bh[2], al[2][4], ah[2][4];
            RET_LWAIT(); SBAR();
            frag_tr_issue<LV * 2, 0, 0>(bl[0], bh[0], trVZ);
#define RET_ISSUE_K(BUF, Q1) do { constexpr int ks1_ = (Q1) >> 2, t0_ = 4 * ((Q1) & 3); \
                frag_tr_issue<LQ * 2, 32 * ks1_, 16 * (t0_ + 0)>(al[BUF][0], ah[BUF][0], trK); frag_tr_issue<LQ * 2, 32 * ks1_, 16 * (t0_ + 1)>(al[BUF][1], ah[BUF][1], trK); \
                frag_tr_issue<LQ * 2, 32 * ks1_, 16 * (t0_ + 2)>(al[BUF][2], ah[BUF][2], trK); frag_tr_issue<LQ * 2, 32 * ks1_, 16 * (t0_ + 3)>(al[BUF][3], ah[BUF][3], trK); } while (0)
#define RET_GROUP(Q) do { constexpr int cur_ = (Q) & 1, ks_ = (Q) >> 2; \
                RET_LWAIT(); SBAR(); \
                if constexpr ((Q) + 1 == 4) frag_tr_issue<LV * 2, 32, 0>(bl[1], bh[1], trVZ); \
                if constexpr ((Q) < 7) RET_ISSUE_K(cur_ ^ 1, (Q) + 1); \
                { const bf16x8 b_ = RET_PK(bl[ks_], bh[ks_]); \
                  _Pragma("unroll") for (int t = 0; t < 4; ++t) if (!(RETD & 2)) S[4 * ((Q) & 3) + t] = MFMA16(RET_PK(al[cur_][t], ah[cur_][t]), b_, S[4 * ((Q) & 3) + t]); } \
                SBAR(); } while (0)
            RET_ISSUE_K(0, 0);
            RET_GROUP(0); RET_GROUP(1); RET_GROUP(2); RET_GROUP(3); RET_GROUP(4); RET_GROUP(5); RET_GROUP(6); RET_GROUP(7);
#undef RET_GROUP
#undef RET_ISSUE_K
        }
        __syncthreads();
        if (do_intra && !(RETD & 4)) {
#pragma unroll
            for (int ks = 0; ks < 2; ++ks) {
                s16x4 l0, h0;
                RET_LWAIT();
                if (ks == 0) frag_tr_issue<LV * 2, 0, 0>(l0, h0, trV); else frag_tr_issue<LV * 2, 32, 0>(l0, h0, trV);
                bf16x8 a[4];
#pragma unroll
                for (int nt = 0; nt < 4; ++nt) a[nt] = frag_rm(lds, OFF_P, LP, 16 * nt, 32 * ks, lane);
                RET_LWAIT(); SBAR();
                bf16x8 b = RET_PK(l0, h0);
                if (RETD & 8) { const short one = 0x3f80; b = (bf16x8){one, one, one, one, one, one, one, one}; }
#pragma unroll
                for (int nt = 0; nt < 4; ++nt) { bf16x8 aa = a[nt]; if (RETD & 16) { const short one = 0x3f80; aa = (bf16x8){one, one, one, one, one, one, one, one}; } o[nt] = MFMA16(aa, b, o[nt]); }
            }
        }
#pragma unroll
        for (int nt = 0; nt < 4; ++nt)
#pragma unroll
            for (int r = 0; r < 4; ++r) *(LAS unsigned short*)(lds + OFF_OS + ((16 * nt + 4 * g + r) * LV + dvw + i) * 2) = (unsigned short)(pkbf_c(o[nt][r], 0.f) & 0xffffu);
    }
    __syncthreads();
    RET_FLUSH(j0 + dj * (nchunks - 1));
#undef RET_LOAD
#undef RET_FLUSH
}

__device__ __forceinline__ void unit(const Frame& F, const bf16* Q, const bf16* K, const bf16* V, bf16* O, bf16* OB, int t0, int S, int u, const float* lgtab) {
    const int dir = u & 1, slice = (u >> 1) & 3, head = (u >> 3) & 7;
    const float lgf = __hip_atomic_load(lgtab + 2 * head, __ATOMIC_RELAXED, __HIP_MEMORY_SCOPE_AGENT), lgb = __hip_atomic_load(lgtab + 2 * head + 1, __ATOMIC_RELAXED, __HIP_MEMORY_SCOPE_AGENT);
    const bf16* Qg = Q + (size_t)t0 * 2048 + head * 256; const bf16* Kg = K + (size_t)t0 * 2048 + head * 256;
    const size_t voff = (size_t)t0 * 4096 + head * 512 + slice * W;
    if (dir == 0) sweep<true>(F, Qg, Kg, V + voff, O + voff, S / C, lgf, lgb);
    else          sweep<false>(F, Qg, Kg, V + voff, OB + voff, S / C, lgf, lgb);
}

__device__ __forceinline__ void phase(const Frame& F, const bf16* Q, const bf16* K, const bf16* V, bf16* O, bf16* OB, const float* lgtab) {
    int vcu = F.vcu; asm volatile("" : "+s"(vcu));
    if (vcu < 128) {
        unit(F, Q, K, V, O, OB, (vcu >> 6) * 8192, 8192, vcu & 63, lgtab);
    } else {
        for (int k = 0; k < 4; ++k) { const int u = (vcu - 128) * 4 + k; unit(F, Q, K, V, O, OB, TP + (u >> 6) * 2048, 2048, u & 63, lgtab); }
    }
}
}

#ifndef ATT_EARLY
#define ATT_EARLY 0
#endif
#ifndef ATT_VLATE
#define ATT_VLATE 0
#endif
#ifndef ATT_NPARK
#define ATT_NPARK 8
#endif
namespace att {
constexpr int NW = 8, QBLK = 32, KVBLK = 64, LDQ = 3072, LDKV = 4096, LDKR = 64, LDO = 2048;
constexpr int SHM_V = 16384, SHM_K = 24576, OFF_K = 2 * SHM_V, OFF_WS = OFF_K + 2 * SHM_K, NPARK = ATT_NPARK, OFF_QR = OFF_WS + NW * 64 * 4, SHM_ATTN = OFF_QR + NW * NPARK * 1024;
static_assert(SHM_ATTN <= RING_BYTES, "attention LDS");
constexpr float THR2 = 11.0f;
#define AKSWZ(row, colB) ((row) * 384 + ((colB) ^ (((row) & 7) << 4)))
__device__ __forceinline__ int crow(int r, int hi) { return (r & 3) + 8 * (r >> 2) + 4 * hi; }
__device__ __forceinline__ unsigned cvtpk(float lo, float hi) { unsigned r; asm volatile("v_cvt_pk_bf16_f32 %0, %1, %2" : "=v"(r) : "v"(lo), "v"(hi)); return r; }

__device__ __forceinline__ void partialSM(f32x16& p0, f32x16& p1, float& m_reg, float& mn, float& alpha) {
  float pmax = p0[0];
#pragma unroll
  for (int r = 1; r < 16; ++r) pmax = fmaxf(pmax, p0[r]);
#pragma unroll
  for (int r = 0; r < 16; ++r) pmax = fmaxf(pmax, p1[r]);
  { auto rr = __builtin_amdgcn_permlane32_swap(__float_as_uint(pmax), __float_as_uint(pmax), false, false);
    pmax = fmaxf(__uint_as_float(rr[0]), __uint_as_float(rr[1])); }
  if (__builtin_expect(__all(pmax - m_reg <= THR2), 1)) { mn = m_reg; alpha = 1.f; }
  else { mn = fmaxf(m_reg, pmax); alpha = __builtin_amdgcn_exp2f(m_reg - mn); m_reg = mn; }
#pragma unroll
  for (int r = 0; r < 16; ++r) p0[r] = p0[r] - mn;
#pragma unroll
  for (int r = 0; r < 16; ++r) p1[r] = p1[r] - mn;
#pragma unroll
  for (int r = 0; r < 16; ++r) p0[r] = __builtin_amdgcn_exp2f(p0[r]);
}
__device__ __forceinline__ void finishSM(f32x16& p0, f32x16& p1, float alpha, float& l_reg, bf16x8& pa0, bf16x8& pa1, bf16x8& pa2, bf16x8& pa3) {
#pragma unroll
  for (int r = 0; r < 16; ++r) p1[r] = __builtin_amdgcn_exp2f(p1[r]);
  float ps = 0;
#pragma unroll
  for (int r = 0; r < 16; ++r) ps += p0[r];
#pragma unroll
  for (int r = 0; r < 16; ++r) ps += p1[r];
  { auto rr = __builtin_amdgcn_permlane32_swap(__float_as_uint(ps), __float_as_uint(ps), false, false);
    ps = __uint_as_float(rr[0]) + __uint_as_float(rr[1]); }
  l_reg = l_reg * alpha + ps;
#define PK4(P, BASE, OUT) do { unsigned a0 = cvtpk(P[BASE + 0], P[BASE + 1]), a1 = cvtpk(P[BASE + 2], P[BASE + 3]);   \
    unsigned b0 = cvtpk(P[BASE + 4], P[BASE + 5]), b1 = cvtpk(P[BASE + 6], P[BASE + 7]);                              \
    auto r0 = __builtin_amdgcn_permlane32_swap(a0, b0, false, false); auto r1 = __builtin_amdgcn_permlane32_swap(a1, b1, false, false); \
    v4u w = {r0[0], r1[0], r0[1], r1[1]}; OUT = *reinterpret_cast<bf16x8*>(&w); } while (0)
  PK4(p0, 0, pa0); PK4(p0, 8, pa1); PK4(p1, 0, pa2); PK4(p1, 8, pa3);
#undef PK4
}
__device__ __forceinline__ void qkt(f32x16& p0, f32x16& p1, const LAS unsigned char* Ks, const bf16x8* qr, const LAS unsigned char* qrl, int r32, int hi) {
  p0 = f32x16{}; p1 = f32x16{};
#pragma unroll
  for (int d0 = 0; d0 < 12; ++d0) { const int cb = (d0 * 16 + hi * 8) * 2;
    const bf16x8 b0 = *reinterpret_cast<const LAS bf16x8*>(Ks + AKSWZ(r32, cb));
    const bf16x8 b1 = *reinterpret_cast<const LAS bf16x8*>(Ks + AKSWZ(32 + r32, cb));
    const bf16x8 q = d0 < 12 - NPARK ? qr[d0 < 12 - NPARK ? d0 : 0] : *reinterpret_cast<const LAS bf16x8*>(qrl + (d0 - (12 - NPARK)) * 1024);
    p0 = __builtin_amdgcn_mfma_f32_32x32x16_bf16(b0, q, p0, 0, 0, 0);
    p1 = __builtin_amdgcn_mfma_f32_32x32x16_bf16(b1, q, p1, 0, 0, 0); }
}
__device__ __forceinline__ int v_st(int k, int c) { const int kk = (k & ~0xC) | ((k & 4) << 1) | ((k & 8) >> 1); return ((kk >> 3) * 4 + (c >> 5)) * 512 + ((kk & 7) * 32 + (c & 31)) * 2; }
__device__ __forceinline__ int v_rd_base(int lane) { return ((lane & 3) << 3) | (((lane >> 2) & 3) << 6) | (((lane >> 4) & 1) << 5) | (((lane >> 5) & 1) << 8); }
constexpr int v_rd_off(int d0, int ks, int half) { return d0 * 512 + ks * 4096 + half * 2048; }
template <int OFF> __device__ __forceinline__ s16x4 tr_read(int vb) {
  s16x4 r; asm volatile("ds_read_b64_tr_b16 %0, %1 offset:%2" : "=&v"(r) : "v"(vb), "i"(OFF) : "memory"); return r;
}
template <int D0> __device__ __forceinline__ void pv_one(f32x16& od, int vb, bf16x8 pa0, bf16x8 pa1, bf16x8 pa2, bf16x8 pa3) {
  const s16x4 l0 = tr_read<v_rd_off(D0, 0, 0)>(vb), h0 = tr_read<v_rd_off(D0, 0, 1)>(vb), l1 = tr_read<v_rd_off(D0, 1, 0)>(vb), h1 = tr_read<v_rd_off(D0, 1, 1)>(vb);
  const s16x4 l2 = tr_read<v_rd_off(D0, 2, 0)>(vb), h2 = tr_read<v_rd_off(D0, 2, 1)>(vb), l3 = tr_read<v_rd_off(D0, 3, 0)>(vb), h3 = tr_read<v_rd_off(D0, 3, 1)>(vb);
  asm volatile("s_waitcnt lgkmcnt(0)" ::: "memory"); SBAR();
#define APK(L, H) (bf16x8){L[0], L[1], L[2], L[3], H[0], H[1], H[2], H[3]}
  od = __builtin_amdgcn_mfma_f32_32x32x16_bf16(pa0, APK(l0, h0), od, 0, 0, 0);
  od = __builtin_amdgcn_mfma_f32_32x32x16_bf16(pa1, APK(l1, h1), od, 0, 0, 0);
  od = __builtin_amdgcn_mfma_f32_32x32x16_bf16(pa2, APK(l2, h2), od, 0, 0, 0);
  od = __builtin_amdgcn_mfma_f32_32x32x16_bf16(pa3, APK(l3, h3), od, 0, 0, 0);
#undef APK
}
__device__ __forceinline__ void pv_d0(f32x16* o, int vb, bf16x8 pa0, bf16x8 pa1, bf16x8 pa2, bf16x8 pa3) {
  pv_one<0>(o[0], vb, pa0, pa1, pa2, pa3); pv_one<1>(o[1], vb, pa0, pa1, pa2, pa3); pv_one<2>(o[2], vb, pa0, pa1, pa2, pa3); pv_one<3>(o[3], vb, pa0, pa1, pa2, pa3);
}

__device__ __forceinline__ void attn_unit(const bf16* __restrict__ Qb, const bf16* __restrict__ Kn, const bf16* __restrict__ Kr, const bf16* __restrict__ Vh,
                                          bf16* __restrict__ Ob, int seq, LAS unsigned char* lds) {
  int tid_l = threadIdx.x; asm volatile("" : "+v"(tid_l));
  const int tid = tid_l, wid = tid >> 6, lane = tid & 63, r32 = lane & 31, hi = lane >> 5;
  LAS unsigned char* V_lds = lds; LAS unsigned char* K_lds = lds + OFF_K;
  LAS float* ws = (LAS float*)(lds + OFF_WS) + wid * 64; LAS float* li_l = ws; LAS float* al_l = ws + 32;
  float m_reg = -1e30f, l_reg = 0; f32x16 o[4] = {}; bf16x8 qr[12 - NPARK];
  const bf16* Qw = Qb + (size_t)(wid * QBLK + r32) * LDQ + hi * 8;
#pragma unroll
  for (int d0 = 0; d0 < 12 - NPARK; ++d0) qr[d0] = *reinterpret_cast<const bf16x8*>(Qw + d0 * 16);
  LAS unsigned char* qrl = lds + OFF_QR + wid * (NPARK * 1024) + hi * 512 + r32 * 16;
  __syncthreads();
#pragma unroll
  for (int d = 0; d < NPARK; ++d) *reinterpret_cast<LAS bf16x8*>(qrl + d * 1024) = *reinterpret_cast<const bf16x8*>(Qw + (12 - NPARK + d) * 16);
  const int sr = tid >> 4, sc = (tid & 15) * 8, vst0 = v_st(sr, sc), vst1 = v_st(32 + sr, sc);
  const int kr_r = tid >> 3, kr_c = (tid & 7) * 8;
  const int vb0 = (int)(unsigned)(uintptr_t)V_lds + v_rd_base(lane);
  bf16x8 vs0, vs1, ks0, ks1, kq0;
  const unsigned vo0 = (unsigned)(sr * LDKV + sc) * 2u, vo1 = vo0 + 32u * LDKV * 2u, vok = (unsigned)(kr_r * LDKR + kr_c) * 2u;
#define SLOAD_K(k0) do { const GAS unsigned char* kbp = (const GAS unsigned char*)Kn + (size_t)(k0) * (LDKV * 2); \
    const GAS unsigned char* rbp = (const GAS unsigned char*)Kr + (size_t)(k0) * (LDKR * 2); \
    ks0 = *reinterpret_cast<const GAS bf16x8*>(kbp + vo0); ks1 = *reinterpret_cast<const GAS bf16x8*>(kbp + vo1); \
    kq0 = *reinterpret_cast<const GAS bf16x8*>(rbp + vok); } while (0)
#define SLOAD_V(k0) do { const GAS unsigned char* vbp = (const GAS unsigned char*)Vh + (size_t)(k0) * (LDKV * 2); \
    vs0 = *reinterpret_cast<const GAS bf16x8*>(vbp + vo0); vs1 = *reinterpret_cast<const GAS bf16x8*>(vbp + vo1); } while (0)
#define SLOAD(k0) do { SLOAD_K(k0); SLOAD_V(k0); } while (0)
#define SWRITE(b) do { *(LAS bf16x8*)(V_lds + (b) * SHM_V + vst0) = vs0; *(LAS bf16x8*)(V_lds + (b) * SHM_V + vst1) = vs1; const int kc = sc * 2; \
    *(LAS bf16x8*)(K_lds + (b) * SHM_K + AKSWZ(sr, kc)) = ks0; *(LAS bf16x8*)(K_lds + (b) * SHM_K + AKSWZ(32 + sr, kc)) = ks1; \
    *(LAS bf16x8*)(K_lds + (b) * SHM_K + AKSWZ(kr_r, 256 + kr_c * 2)) = kq0; } while (0)
#define SWAIT() asm volatile("s_waitcnt vmcnt(0)" ::: "memory")
#define RESC(a) do { if (__any((a) < 1.f)) { if (hi == 0) al_l[r32] = (a); asm volatile("s_waitcnt lgkmcnt(0)" ::: "memory"); \
    _Pragma("unroll") for (int d = 0; d < 4; ++d) _Pragma("unroll") for (int r = 0; r < 16; ++r) o[d][r] *= al_l[crow(r, hi)]; } } while (0)
  f32x16 pA0, pA1, pB0, pB1; float mnA, mnB, alA, alB; bf16x8 pa0, pa1, pa2, pa3; const int NT = seq / KVBLK;
  SLOAD(0); SWAIT(); SWRITE(0); __syncthreads();
  qkt(pA0, pA1, K_lds, qr, qrl, r32, hi); partialSM(pA0, pA1, m_reg, mnA, alA);
  SLOAD(KVBLK);
  SWAIT(); SWRITE(1); __syncthreads();
  for (int j = 1; j + 1 < NT; j += 2) {
#if ATT_EARLY
    SLOAD((j + 1) * KVBLK);
#endif
    SBAR(); qkt(pB0, pB1, K_lds + SHM_K, qr, qrl, r32, hi);
    finishSM(pA0, pA1, alA, l_reg, pa0, pa1, pa2, pa3); SBAR();
#if ATT_EARLY
    pv_d0(o, vb0, pa0, pa1, pa2, pa3); partialSM(pB0, pB1, m_reg, mnB, alB);
#elif ATT_VLATE
    SLOAD_K((j + 1) * KVBLK); SBAR();
    pv_d0(o, vb0, pa0, pa1, pa2, pa3); SBAR(); SLOAD_V((j + 1) * KVBLK); SBAR(); partialSM(pB0, pB1, m_reg, mnB, alB);
#else
    SLOAD((j + 1) * KVBLK); SBAR();
    pv_d0(o, vb0, pa0, pa1, pa2, pa3); partialSM(pB0, pB1, m_reg, mnB, alB);
#endif
    __syncthreads(); SWAIT(); SWRITE(0);
    RESC(alB); __syncthreads();
#if ATT_EARLY
    SLOAD((j + 2) * KVBLK);
#endif
    SBAR(); qkt(pA0, pA1, K_lds, qr, qrl, r32, hi);
    finishSM(pB0, pB1, alB, l_reg, pa0, pa1, pa2, pa3); SBAR();
#if ATT_EARLY
    pv_d0(o, vb0 + SHM_V, pa0, pa1, pa2, pa3); partialSM(pA0, pA1, m_reg, mnA, alA);
#elif ATT_VLATE
    SLOAD_K((j + 2) * KVBLK); SBAR();
    pv_d0(o, vb0 + SHM_V, pa0, pa1, pa2, pa3); SBAR(); SLOAD_V((j + 2) * KVBLK); SBAR(); partialSM(pA0, pA1, m_reg, mnA, alA);
#else
    SLOAD((j + 2) * KVBLK); SBAR();
    pv_d0(o, vb0 + SHM_V, pa0, pa1, pa2, pa3); partialSM(pA0, pA1, m_reg, mnA, alA);
#endif
    __syncthreads(); SWAIT(); SWRITE(1);
    RESC(alA); __syncthreads();
  }
  SBAR(); qkt(pB0, pB1, K_lds + SHM_K, qr, qrl, r32, hi);
  finishSM(pA0, pA1, alA, l_reg, pa0, pa1, pa2, pa3); SBAR();
  pv_d0(o, vb0, pa0, pa1, pa2, pa3); partialSM(pB0, pB1, m_reg, mnB, alB);
  __syncthreads(); RESC(alB);
  finishSM(pB0, pB1, alB, l_reg, pa0, pa1, pa2, pa3); SBAR();
  pv_d0(o, vb0 + SHM_V, pa0, pa1, pa2, pa3);
  if (hi == 0) li_l[r32] = l_reg; asm volatile("s_waitcnt lgkmcnt(0)" ::: "memory");
  float rli[16];
#pragma unroll
  for (int r = 0; r < 16; ++r) rli[r] = __builtin_amdgcn_rcpf(li_l[crow(r, hi)]);
  __syncthreads();
  LAS unsigned short* stg = (LAS unsigned short*)(lds + wid * 8704);
#pragma unroll
  for (int r = 0; r < 16; ++r) { const int orow = crow(r, hi);
#pragma unroll
    for (int d0 = 0; d0 < 4; ++d0) stg[orow * 136 + d0 * 32 + r32] = (unsigned short)(cvtpk(o[d0][r] * rli[r], 0.f) & 0xffffu); }
  asm volatile("s_waitcnt lgkmcnt(0)" ::: "memory");
  bf16* Ow = Ob + (size_t)(wid * QBLK) * LDO;
#pragma unroll
  for (int i2 = 0; i2 < 8; ++i2) { const int id = i2 * 64 + lane, row = id >> 4, ch = id & 15;
    const v4u w = *(const LAS v4u*)((const LAS unsigned char*)stg + row * 272 + ch * 16);
    *(GAS v4u*)(Ow + (size_t)row * LDO + ch * 8) = w; }
#undef SLOAD
#undef SLOAD_K
#undef SLOAD_V
#undef SWRITE
#undef SWAIT
#undef RESC
}

__device__ __forceinline__ void phase(const Frame& F, const bf16* QA, const bf16* KV, const bf16* KR, bf16* O) {
  LAS unsigned char* lds = F.lds + RING_OFF;
  int vcu = F.vcu; asm volatile("" : "+s"(vcu));
  const int x = vcu >> 5, i = vcu & 31;
  for (int k = 0; k < 8; ++k) {
    int t0, S, head, qb;
    if (k < 4) { const int pair = 4 * x + k; t0 = (pair >> 4) * 8192; head = pair & 15; S = 8192; qb = i; }
    else { const int pair = 16 * x + 4 * (i >> 3) + (k - 4); t0 = TP + (pair >> 4) * 2048; head = pair & 15; S = 2048; qb = i & 7; }
    const bf16* Qb = QA + (size_t)(t0 + qb * 256) * LDQ + head * 192;
    const bf16* Kn = KV + (size_t)t0 * LDKV + head * 256; const bf16* Vh = Kn + 128; const bf16* Kr = KR + (size_t)t0 * LDKR;
    bf16* Ob = O + (size_t)(t0 + qb * 256) * LDO + head * 128;
    attn_unit(Qb, Kn, Kr, Vh, Ob, S, lds);
  }
}
}

#ifndef G_ALIGN
#define G_ALIGN true
#endif
#ifndef G_SP2
#define G_SP2 true
#endif
struct Args { const float* in[20]; float* out; unsigned char* ws; };

__device__ __forceinline__ const float* kin(int i) {
    unsigned long long kp = (unsigned long long)__builtin_amdgcn_kernarg_segment_ptr();
    asm volatile("" : "+s"(kp));
    return ((const float* const __attribute__((address_space(4)))*)kp)[i];
}
#define INP(i) kin(i)
#define WSB ((unsigned char*)kin(21))
#define X ((float*)kin(20))
#define XB ((bf16*)(WSB + WS_XB))
#define cosR ((float*)(WSB + WS_TAB))
#define sinR (cosR + 8192 * 128)
#define cosM (cosR + 2 * 8192 * 128)
#define sinM (cosR + 2 * 8192 * 128 + 8192 * 32)
#define ssq_base ((fx64*)(WSB + WS_CTL + CTL_SSQ))
#define STATS(k) ((fx64*)(WSB + WS_CTL + CTL_STATS) + (size_t)(k) * T * 2)
#define CSB2(k) ((fx64*)(WSB + WS_CTL + CTL_CSB2) + (size_t)(k) * 32768)
#define CSF(k) ((float*)(WSB + WS_CTL + CTL_CSF) + (size_t)(k) * 32768)
#define LGTAB ((float*)(WSB + WS_CTL + CTL_LGTAB))
#define wsW (WSB + WS_W)
#define wsA (WSB + WS_ACT)

__device__ __forceinline__ void convert_layer(const Frame& F, int layer, LAS float* scr, int rot) {
    const int j = layer >> 1; const int lp = layer > 0 ? layer - 1 : 0;
    const float* g2 = layer > 0 ? INP(14) + (size_t)lp * DM : nullptr; const float* b2 = layer > 0 ? INP(15) + (size_t)lp * DM : nullptr; fx64* cs_in = layer > 0 ? CSB2(2 * layer) : nullptr;
    if ((layer & 1) == 0) {
        convert_matrix(F, INP(2) + (size_t)j * 2048 * 12288, 2048, 12288, (bf16*)(wsW + W_RET_IN), 1, 1.0f, g2, b2, cs_in, scr, rot);
        convert_matrix(F, INP(5) + (size_t)j * 4096 * 2048, 4096, 2048, (bf16*)(wsW + W_RET_OUT), 0, 1.0f, nullptr, nullptr, nullptr, scr, rot);
    } else {
        convert_matrix(F, INP(6) + (size_t)j * 2048 * 2112, 2048, 2112, (bf16*)(wsW + W_MLA_IN), 2, 1.0f, g2, b2, cs_in, scr, rot);
        { bf16* wt = (bf16*)(wsW + W_MLA_IN);
          PHASE_TID(tid, lane); (void)tid; const int gt = gw * 64 + lane, NGT = NGW * 64; unsigned zz = 0u; asm volatile("" : "+v"(zz));
          for (int e = gt; e < 192 * 2048 / 8; e += NGT) { const int rr = e / 256, cc = e % 256; const int row = 2048 + (rr < 96 ? 32 + rr : 160 + (rr - 96));
              *(GAS v4u*)(wt + (size_t)row * 2048 + cc * 8) = (v4u){zz, zz, zz, zz}; } }
        convert_matrix(F, INP(9) + (size_t)j * 1536 * 3072, 1536, 3072, (bf16*)(wsW + W_MLA_UQ), 3, 0.07216878364870322f * 1.4426950408889634f, INP(7) + (size_t)j * 1536, nullptr, nullptr, scr, rot);
        convert_matrix(F, INP(10) + (size_t)j * 512 * 4096, 512, 4096, (bf16*)(wsW + W_MLA_UKV), 0, 1.0f, INP(8) + (size_t)j * 512, nullptr, nullptr, scr, rot);
        convert_matrix(F, INP(11) + (size_t)j * 2048 * 2048, 2048, 2048, (bf16*)(wsW + W_MLA_OUT), 0, 1.0f, nullptr, nullptr, nullptr, scr, rot);
    }
    convert_matrix(F, INP(16) + (size_t)layer * 2048 * 11264, 2048, 11264, (bf16*)(wsW + W_UP), 4, 1.0f, INP(12) + (size_t)layer * DM, INP(13) + (size_t)layer * DM, CSB2(2 * layer + 1), scr, rot);
    convert_matrix(F, INP(19) + (size_t)layer * 5632 * 2048, 5632, 2048, (bf16*)((layer & 1) ? WSB + WS_WD2 : wsW + W_DOWN), 0, 1.0f, nullptr, nullptr, nullptr, scr, rot);
}

__global__ void __launch_bounds__(NWAVES * 64, 2) fwd_kernel(Args args) {
    extern __shared__ __attribute__((aligned(16))) unsigned char lds_raw[];
    Frame F;
    F.lds = (LAS unsigned char*)lds_raw;
    F.wave = __builtin_amdgcn_readfirstlane((int)threadIdx.x >> 6);
    F.G = gridDim.x; { const int bx = blockIdx.x; F.vcu = (F.G % 8 == 0) ? (bx % 8) * (F.G / 8) + bx / 8 : bx; }
    F.gw = F.vcu * NWAVES + F.wave; F.NGW = F.G * NWAVES;
    volatile LAS unsigned* MISC = (volatile LAS unsigned*)(F.lds + MISC_OFF);
    for (int u = threadIdx.x; u < (LDS_BYTES - LDSCTL_OFF) / 4; u += NWAVES * 64) ((LAS unsigned*)(F.lds + LDSCTL_OFF))[u] = 0u;
    __syncthreads();
    XcdBarrier bar = xcd_barrier_post((unsigned*)(args.ws + WS_CTL) + CW_BAR, MISC + 8);
    LAS float* scr = (LAS float*)(F.lds + RING_OFF + F.wave * 16384);
    PG8_LAS unsigned char* ring = (PG8_LAS unsigned char*)(F.lds + RING_OFF);

#ifdef PROBE_IDLE
    int barno = 0;
#define GRID_BAR() do { XcdBarrier b2_ = bar; unsigned long long bp_ = (unsigned long long)b2_.bar; unsigned bx_ = b2_.x; asm volatile("" : "+s"(bp_), "+s"(bx_)); b2_.bar = (unsigned*)bp_; b2_.x = bx_; \
    __syncthreads(); const unsigned long long t0_ = wall_clock64(); xcd_barrier(b2_); const unsigned long long t1_ = wall_clock64(); \
    if (threadIdx.x == 0 && ((PROBE_IDLE >> (barno < 1 ? 0 : 1 + (barno - 1) % 7)) & 1)) MISC[20] += (unsigned)(t1_ - t0_); ++barno; } while (0)
#else
#define GRID_BAR() do { XcdBarrier b2_ = bar; unsigned long long bp_ = (unsigned long long)b2_.bar; unsigned bx_ = b2_.x; asm volatile("" : "+s"(bp_), "+s"(bx_)); b2_.bar = (unsigned*)bp_; b2_.x = bx_; xcd_barrier(b2_); } while (0)
#endif

    prologue(F, INP(0), INP(1), X, XB, cosR, sinR, cosM, sinM, INP(3), INP(4), LGTAB);
    convert_layer(F, 0, scr, 0);
    GRID_BAR();

#ifndef DIAG_LAYERS
#define DIAG_LAYERS 4
#endif
    for (int layer = 0; layer < DIAG_LAYERS; ++layer) {
        const int j = layer >> 1; const bool is_ret = (layer & 1) == 0;
        const bf16* Aout; const bf16* Wout; int Kout;
        if (is_ret) {
            bf16* RQ = (bf16*)(wsA + A_RQ); bf16* RK = (bf16*)(wsA + A_RK); bf16* RV = (bf16*)(wsA + A_RV); bf16* RG = (bf16*)(wsA + A_RG); bf16* RO = (bf16*)(wsA + A_RO); bf16* ROB = (bf16*)X;
            if (layer == 0) csb2_finalize(F, CSB2(0), CSF(0), 65536);
            {
                pg8::Gemm g{XB, (const bf16*)(wsW + W_RET_IN), T, 12288, 2048}; pg8::StaticOrder S; S.init(T, 12288, F.G, (int)blockIdx.x);
                pg8::EpiRetIn E{RQ, RK, RV, RG, cosR, sinR, pg8::LnCorr{layer > 0 ? STATS(2 * layer - 1) : nullptr, CSF(2 * layer), CSF(2 * layer) + 16384}};
                pg8::gemm_phase<pg8::EpiRetIn, pg8::StaticOrder, G_ALIGN, G_SP2>(ring, g, S, E);
#ifdef PROBE_DUP_R1
                __syncthreads();
                pg8::gemm_phase<pg8::EpiRetIn, pg8::StaticOrder, G_ALIGN, G_SP2>(ring, g, S, E);
#endif
            }
            GRID_BAR();
            ret::phase(F, RQ, RK, RV, RO, ROB, LGTAB + j * 16);
#ifdef PROBE_DUP_RET
            GRID_BAR();
            ret::phase(F, RQ, RK, RV, RO, ROB, LGTAB + j * 16);
#endif
            GRID_BAR();
            gate_pass(F, RO, ROB, RG, RG);
#ifdef PROBE_DUP_GATE
            GRID_BAR();
            gate_pass(F, RO, ROB, RG, RO);
#endif
            GRID_BAR();
            Aout = RG; Wout = (const bf16*)(wsW + W_RET_OUT); Kout = 4096;
        } else {
            bf16* CQ = (bf16*)(wsA + A_MCQ); bf16* CKV = (bf16*)(wsA + A_MCKV); bf16* KR = (bf16*)(wsA + A_MKR); bf16* QA = (bf16*)(wsA + A_MQA);
            bf16* KV = (bf16*)(wsA + A_MKV); bf16* MO = (bf16*)(wsA + A_MO);
            fx64* ssq_q = ssq_base + (size_t)j * T; fx64* ssq_kv = ssq_base + (size_t)(2 + j) * T;
            {
                pg8::Gemm g{XB, (const bf16*)(wsW + W_MLA_IN), T, 2304, 2048}; pg8::StaticOrder S; S.init(T, 2304, F.G, (int)blockIdx.x);
                pg8::EpiMlaIn E{CQ, CKV, KR, ssq_q, ssq_kv, cosM, sinM, pg8::LnCorr{STATS(2 * layer - 1), CSF(2 * layer), CSF(2 * layer) + 16384}};
                pg8::gemm_phase<pg8::EpiMlaIn, pg8::StaticOrder, G_ALIGN, G_SP2>(ring, g, S, E);
            }
            GRID_BAR();
            {
                pg8::Gemm g{CQ, (const bf16*)(wsW + W_MLA_UQ), T, 3072, 1536}; pg8::StaticOrder S; S.init(T, 3072, F.G, (int)blockIdx.x);
                pg8::EpiMlaUq E{QA, ssq_q, cosM, sinM};
                pg8::gemm_phase<pg8::EpiMlaUq, pg8::StaticOrder, G_ALIGN, G_SP2>(ring, g, S, E);
#ifdef PROBE_DUP_M2
                __syncthreads();
                pg8::gemm_phase<pg8::EpiMlaUq, pg8::StaticOrder, G_ALIGN, G_SP2>(ring, g, S, E);
#endif
            }
            __syncthreads();
            {
                pg8::Gemm g{CKV, (const bf16*)(wsW + W_MLA_UKV), T, 4096, 512}; pg8::StaticOrder S; S.init(T, 4096, F.G, (int)blockIdx.x);
                pg8::EpiMlaUkv E{KV, ssq_kv};
                pg8::gemm_phase<pg8::EpiMlaUkv, pg8::StaticOrder, G_ALIGN, G_SP2>(ring, g, S, E);
#ifdef PROBE_DUP_M2
                __syncthreads();
                pg8::gemm_phase<pg8::EpiMlaUkv, pg8::StaticOrder, G_ALIGN, G_SP2>(ring, g, S, E);
#endif
            }
            GRID_BAR();
            att::phase(F, QA, KV, KR, MO);
#ifdef PROBE_DUP_ATT
            GRID_BAR();
            att::phase(F, QA, KV, KR, MO);
#endif
            GRID_BAR();
            Aout = MO; Wout = (const bf16*)(wsW + W_MLA_OUT); Kout = 2048;
        }
        {
            pg8::Gemm g{Aout, Wout, T, 2048, Kout}; pg8::StaticOrder S; S.init(T, 2048, F.G, (int)blockIdx.x);
            const int lp = layer > 0 ? layer - 1 : 0;
            pg8::EpiResid E{XB, nullptr, STATS(2 * layer), layer > 0 ? STATS(2 * layer - 1) : nullptr, INP(14) + (size_t)lp * DM, INP(15) + (size_t)lp * DM, INP(0), INP(1)};
            pg8::gemm_phase<pg8::EpiResid, pg8::StaticOrder, G_ALIGN, G_SP2>(ring, g, S, E);
        }
        GRID_BAR();
#ifndef DIAG_NO_FFN
        bf16* FU = (bf16*)(wsA + A_FU); bf16* FG = (bf16*)(wsA + A_FG);
        {
            pg8::Gemm g{XB, (const bf16*)(wsW + W_UP), T, 11264, 2048}; pg8::StaticOrder S; S.init(T, 11264, F.G, (int)blockIdx.x);
            pg8::EpiFfnUp E{FU, FG, FG + (size_t)512 * 4 * FFN, INP(17) + (size_t)layer * 3 * FFN, INP(18) + (size_t)layer * FFN, pg8::LnCorr{STATS(2 * layer), CSF(2 * layer + 1), CSF(2 * layer + 1) + 16384}};
            pg8::gemm_phase<pg8::EpiFfnUp, pg8::StaticOrder, G_ALIGN, G_SP2>(ring, g, S, E);
#ifdef PROBE_DUP_F1
            __syncthreads();
            pg8::gemm_phase<pg8::EpiFfnUp, pg8::StaticOrder, G_ALIGN, G_SP2>(ring, g, S, E);
#endif
        }
        GRID_BAR();
        ffn_fixup(F, FU, FG, FG + (size_t)512 * 4 * FFN, INP(17) + (size_t)layer * 3 * FFN, INP(18) + (size_t)layer * FFN);
        if (layer < 3) convert_layer(F, layer + 1, scr, (11 * 1024) & 2047);
        GRID_BAR();
        if (layer < 3) csb2_finalize(F, CSB2(2 * layer + 2), CSF(2 * layer + 2), 65536);
        {
            pg8::Gemm g{FU, (const bf16*)((layer & 1) ? WSB + WS_WD2 : wsW + W_DOWN), T, 2048, FFN}; pg8::StaticOrder S; S.init(T, 2048, F.G, (int)blockIdx.x);
            pg8::EpiResid E{XB, layer == DIAG_LAYERS - 1 ? X : nullptr, STATS(2 * layer + 1), STATS(2 * layer), INP(12) + (size_t)layer * DM, INP(13) + (size_t)layer * DM, nullptr, nullptr};
            pg8::gemm_phase<pg8::EpiResid, pg8::StaticOrder, G_ALIGN, G_SP2>(ring, g, S, E);
        }
        GRID_BAR();
#endif
#ifdef PROBE_EXTRA_BARS
        for (int eb = 0; eb < 10; ++eb) GRID_BAR();
#endif
    }
    ln_pass(F, X, XB, nullptr, INP(14) + (size_t)(DIAG_LAYERS - 1) * DM, INP(15) + (size_t)(DIAG_LAYERS - 1) * DM, true);
    GRID_BAR();
#ifdef PROBE_IDLE
    if (threadIdx.x == 0) atomicAdd((unsigned*)(WSB + WS_CTL) + 8192, (unsigned)MISC[20]);
    { XcdBarrier b2_ = bar; xcd_barrier(b2_); }
    if (blockIdx.x == 0 && threadIdx.x == 0) { const unsigned tot = __hip_atomic_load((unsigned*)(WSB + WS_CTL) + 8192, __ATOMIC_RELAXED, __HIP_MEMORY_SCOPE_AGENT);
        const unsigned long long wait = (unsigned long long)(tot / 256u) * PROBE_IDLE_MULT; const unsigned long long ts = wall_clock64();
        while (wall_clock64() - ts < wait) __builtin_amdgcn_s_sleep(32); }
#endif
    if (xb_ld((unsigned*)(WSB + WS_CTL) + CW_BAR + XB_TMO) != 0u) {
        PHASE_TID(tid, lane); (void)tid; const float qn = __builtin_nanf("");
        for (int m = gw; m < T; m += NGW) { GAS f32x4* o = (GAS f32x4*)(X + (size_t)m * DM) + lane;
#pragma unroll
            for (int j2 = 0; j2 < 8; ++j2) o[64 * j2] = (f32x4){qn, qn, qn, qn}; }
    }
}

extern "C" void kernel_launch(void* const* d_in, const int* in_sizes, int n_in, void* d_out, int out_size, void* d_ws, size_t ws_size, hipStream_t stream) {
    static int grid = 0;
    if (grid == 0) {
        if (n_in != 20 || out_size != T * DM || ws_size < WS_END) { fprintf(stderr, "kernel_launch: unexpected shapes (n_in %d out %d ws %zu, need %zu)\n", n_in, out_size, ws_size, (size_t)WS_END); grid = -1; return; }
        int dev = 0, cus = 0, per_cu = 0;
        if (hipGetDevice(&dev) != hipSuccess || hipDeviceGetAttribute(&cus, hipDeviceAttributeMultiprocessorCount, dev) != hipSuccess) { grid = -1; return; }
        if (hipFuncSetAttribute((const void*)fwd_kernel, hipFuncAttributeMaxDynamicSharedMemorySize, LDS_BYTES) != hipSuccess) { fprintf(stderr, "kernel_launch: hipFuncSetAttribute failed\n"); grid = -1; return; }
        if (hipOccupancyMaxActiveBlocksPerMultiprocessor(&per_cu, (const void*)fwd_kernel, NWAVES * 64, LDS_BYTES) != hipSuccess || per_cu < 1)
            fprintf(stderr, "kernel_launch: occupancy query reports %d workgroups per CU\n", per_cu);
        (void)hipGetLastError();
        if (cus != 256) { fprintf(stderr, "kernel_launch: built for a 256-CU device, found %d\n", cus); grid = -1; return; }
        grid = cus;
    }
    if (grid < 0) return;
    if (hipMemsetAsync((char*)d_ws + WS_CTL, 0, CTL_ZERO_BYTES, stream) != hipSuccess) return;
    Args a{};
    for (int i = 0; i < 20; ++i) a.in[i] = (const float*)d_in[i];
    a.out = (float*)d_out; a.ws = (unsigned char*)d_ws;
    hipLaunchKernelGGL(fwd_kernel, dim3(grid), dim3(NWAVES * 64), LDS_BYTES, stream, a);
    const hipError_t le = hipPeekAtLastError();
    if (le != hipSuccess) fprintf(stderr, "kernel_launch: launch failed: %s\n", hipGetErrorName(le));
}
```

```cpp
#include <hip/hip_runtime.h>
#include <cstdio>
#include <cstdint>

#define GAS __attribute__((address_space(1)))
#define LAS __attribute__((address_space(3)))

namespace pg8 {
#define PG8_LAS __attribute__((address_space(3)))
typedef unsigned short bf16_t;
typedef short bf16x8 __attribute__((ext_vector_type(8)));
typedef float f32x4 __attribute__((ext_vector_type(4)));
typedef unsigned u32x4 __attribute__((ext_vector_type(4)));
typedef _Float16 f16x8 __attribute__((ext_vector_type(8)));
template <bool F16> __device__ __forceinline__ f32x4 mfma16(bf16x8 a, bf16x8 b, f32x4 c) {
    if constexpr (F16) return __builtin_amdgcn_mfma_f32_16x16x32_f16(__builtin_bit_cast(f16x8, a), __builtin_bit_cast(f16x8, b), c, 0, 0, 0);
    else return __builtin_amdgcn_mfma_f32_16x16x32_bf16(a, b, c, 0, 0, 0);
}
constexpr int BM = 256, BK = 64, HALF = 128, HTB = HALF * BK * 2  , STAGE_BYTES = 8 * HTB, NXCD = 8, WGM = 8;
constexpr int PF_OFF = STAGE_BYTES, PF_BYTES = 6144;

__host__ __device__ __forceinline__ int lds_byte(int r, int c) { const int st = (r >> 4) * 2 + (c >> 5), rr = r & 15, cc = c & 31, ob = rr * 64 + cc * 2; return st * 1024 + (ob ^ (((ob >> 9) & 1) << 5)); }
__host__ __device__ __forceinline__ void stage_rc(int b, int& R, int& C) { const int st = b / 1024, sb = b % 1024, swz = sb ^ (((sb >> 9) & 1) << 5); R = (st >> 1) * 16 + swz / 64; C = (st & 1) * 32 + (swz % 64) / 2; }
__host__ __device__ __forceinline__ int perm32(int rho) { const int n = rho >> 4, i = rho & 15; return 8 * (i >> 2) + 4 * n + (i & 3); }

struct Unit { int pm, pn; };
struct Gemm { const bf16_t* A; const bf16_t* Bt; int M, N, K; };

struct StaticOrder {
    int nM, nN, nwg, G, c;
    __host__ __device__ void init(int M, int N, int G_, int c_) { nM = M / BM; nN = N / BM; nwg = nM * nN; G = G_; c = c_; }
    __host__ __device__ bool next(int i, Unit& u) const {
        const long L = (long)i * G + c; if (L >= nwg) return false;
        int wgid = (int)L; { const int q = nwg / NXCD, r = nwg % NXCD, xcd = wgid % NXCD, off = wgid / NXCD; wgid = (xcd < r ? xcd * (q + 1) : r * (q + 1) + (xcd - r) * q) + off; }
        const int nig = WGM * nN, gid = wgid / nig, fm = gid * WGM, gsz = (nM - fm) < WGM ? (nM - fm) : WGM;
        u.pm = fm + ((wgid % nig) % gsz); u.pn = (wgid % nig) / gsz; return true;
    }
    __device__ __forceinline__ void a_ready(const Unit&) const {}
    __device__ __forceinline__ void done(const Unit&) const {}
};
__device__ __forceinline__ unsigned cvt_pk_bf16(float lo, float hi) { unsigned r; asm volatile("v_cvt_pk_bf16_f32 %0, %1, %2" : "=v"(r) : "v"(lo), "v"(hi)); return r; }

template <class Epi, class Sched, bool ALIGN_EPI = false, bool SP2 = false>
__device__ __forceinline__ void gemm_phase(PG8_LAS unsigned char* lds, const Gemm g, const Sched& S, const Epi& E) {
    int tid_l = threadIdx.x; asm volatile("" : "+v"(tid_l));
    const int tid = tid_l, wid = __builtin_amdgcn_readfirstlane(tid >> 6), lane = tid & 63, wr = wid >> 2, wc = wid & 3, fr = lane & 15, fq = lane >> 4;
    const int K = g.K, nt = K / BK;
    unsigned voffA[2], voffB[2];
#pragma unroll
    for (int i = 0; i < 2; ++i) { int R, C; stage_rc(tid * 16 + i * 8192, R, C); const int Rb = Epi::PERM ? ((R & ~31) + perm32(R & 31)) : R;
        const int Ra = Epi::APERM ? ((R & ~63) + 4 * (R & 15) + ((R >> 4) & 3)) : R;
        voffA[i] = (unsigned)(Ra * K + C) * 2u; voffB[i] = (unsigned)(Rb * K + C) * 2u; }
    const size_t kstep = (size_t)(BK * 2);
    const size_t hstep = (size_t)HALF * K * 2;
    const size_t tstep = 2 * hstep;
    const unsigned ldsw = (unsigned)wid * 1024u;
    const int aoff = lds_byte(wr * 64 + fr, fq * 8), boff = lds_byte(wc * 32 + fr, fq * 8);
#define PG8_SA(b, h) (((b) * 2 + (h)) * HTB)
#define PG8_SB(b, h) ((4 + (b) * 2 + (h)) * HTB)
#define PG8_STAGE(bufoff, gbase, voff) do { _Pragma("unroll") for (int _i = 0; _i < 2; ++_i) \
        __builtin_amdgcn_global_load_lds((const unsigned*)((const char*)(gbase) + (voff)[_i]), (PG8_LAS unsigned*)(lds + (bufoff) + ldsw + _i * 8192), 16, 0, 0); } while (0)
#define PG8_LDA(dst, b, h) do { _Pragma("unroll") for (int m = 0; m < 4; ++m) _Pragma("unroll") for (int k = 0; k < 2; ++k) dst[m][k] = *(const PG8_LAS bf16x8*)(lds + PG8_SA(b, h) + aoff + m * 2048 + k * 1024); } while (0)
#define PG8_LDB(dst, b, h) do { _Pragma("unroll") for (int n = 0; n < 2; ++n) _Pragma("unroll") for (int k = 0; k < 2; ++k) dst[n][k] = *(const PG8_LAS bf16x8*)(lds + PG8_SB(b, h) + boff + n * 2048 + k * 1024); } while (0)
#define PG8_MMA(ai, bj, At, Bt) do { __builtin_amdgcn_s_setprio(1); _Pragma("unroll") for (int m = 0; m < 4; ++m) _Pragma("unroll") for (int n = 0; n < 2; ++n) _Pragma("unroll") for (int k = 0; k < 2; ++k) \
        acc[ai][bj][m][n] = mfma16<Epi::F16>(Bt[n][k], At[m][k], acc[ai][bj][m][n]); __builtin_amdgcn_s_setprio(0); } while (0)
#define PG8_WAIT_V(n) asm volatile("s_waitcnt vmcnt(" #n ")" ::: "memory")
#define PG8_WAIT_L(n) asm volatile("s_waitcnt lgkmcnt(" #n ")" ::: "memory")
#define PG8_BAR __builtin_amdgcn_s_barrier()
#define PG8_SCHED __builtin_amdgcn_sched_barrier(0)
    Unit cur, nxt; int ui = 0;
    if (!S.next(0, cur)) return;
    f32x4 acc[2][2][4][2];
#pragma unroll
    for (int a = 0; a < 2; ++a)
#pragma unroll
        for (int b = 0; b < 2; ++b)
#pragma unroll
            for (int m = 0; m < 4; ++m)
#pragma unroll
                for (int n = 0; n < 2; ++n) acc[a][b][m][n] = (f32x4){0.f, 0.f, 0.f, 0.f};
    bf16x8 At[4][2], B0[2][2], B1[2][2];
    const char* cA = (const char*)g.A + (size_t)cur.pm * tstep; const char* cB = (const char*)g.Bt + (size_t)cur.pn * tstep;
    S.a_ready(cur);
    if constexpr (SP2) {
        PG8_STAGE(PG8_SB(0, 0), cB, voffB); PG8_STAGE(PG8_SB(0, 1), cB + hstep, voffB); PG8_STAGE(PG8_SA(0, 0), cA, voffA); PG8_STAGE(PG8_SA(0, 1), cA + hstep, voffA);
        if (wr == 1) PG8_BAR;
        PG8_WAIT_V(2); PG8_BAR;
        PG8_STAGE(PG8_SB(1, 0), cB + kstep, voffB); PG8_STAGE(PG8_SA(1, 0), cA + kstep, voffA); PG8_STAGE(PG8_SB(1, 1), cB + hstep + kstep, voffB);
        PG8_WAIT_V(6); PG8_BAR;
    } else {
        PG8_STAGE(PG8_SB(0, 0), cB, voffB); PG8_STAGE(PG8_SA(0, 0), cA, voffA); PG8_STAGE(PG8_SB(0, 1), cB + hstep, voffB); PG8_STAGE(PG8_SA(0, 1), cA + hstep, voffA);
        if (wr == 1) PG8_BAR;
        PG8_WAIT_V(4); PG8_BAR;
        PG8_STAGE(PG8_SB(1, 0), cB + kstep, voffB); PG8_STAGE(PG8_SA(1, 0), cA + kstep, voffA); PG8_STAGE(PG8_SB(1, 1), cB + hstep + kstep, voffB);
        PG8_WAIT_V(6); PG8_BAR;
    }
    for (;;) {
        const bool has_next = S.next(ui + 1, nxt);
        PG8_LAS unsigned char* const pfa = lds + PF_OFF + (ui & 1) * PF_BYTES;
        if constexpr (Epi::HAS_PRE) E.prefetch(cur, pfa, wid, lane);
        const char* nA = has_next ? (const char*)g.A + (size_t)nxt.pm * tstep : cA; const char* nB = has_next ? (const char*)g.Bt + (size_t)nxt.pn * tstep : cB;
        for (int t = 0; t < nt; t += 2) {
            const bool last = (t == nt - 2);
            const char* a1 = cA + (size_t)(t + 1) * kstep;
            const char* a2 = last ? nA : cA + (size_t)(t + 2) * kstep; const char* b2 = last ? nB : cB + (size_t)(t + 2) * kstep;
            const char* a3 = a2 + kstep; const char* b3 = b2 + kstep;
            if (last && has_next) S.a_ready(nxt);
            if constexpr (SP2) {
            PG8_LDB(B0, 0, 0); PG8_LDB(B1, 0, 1); PG8_SCHED; PG8_LDA(At, 0, 0); PG8_STAGE(PG8_SA(1, 1), a1 + hstep, voffA);
            PG8_WAIT_V(8); PG8_WAIT_L(0); PG8_BAR; PG8_MMA(0, 0, At, B0); PG8_MMA(0, 1, At, B1); PG8_BAR; PG8_SCHED;
            PG8_LDA(At, 0, 1); PG8_STAGE(PG8_SB(0, 0), b2, voffB); PG8_STAGE(PG8_SB(0, 1), b2 + hstep, voffB); PG8_STAGE(PG8_SA(0, 0), a2, voffA);
            PG8_WAIT_V(8); PG8_WAIT_L(0); PG8_BAR; PG8_MMA(1, 0, At, B0); PG8_MMA(1, 1, At, B1); PG8_BAR; PG8_SCHED;
            PG8_LDB(B0, 1, 0); PG8_LDB(B1, 1, 1); PG8_SCHED; PG8_LDA(At, 1, 0); PG8_STAGE(PG8_SA(0, 1), a2 + hstep, voffA);
            PG8_WAIT_V(8); PG8_WAIT_L(0); PG8_BAR; PG8_MMA(0, 0, At, B0); PG8_MMA(0, 1, At, B1); PG8_BAR; PG8_SCHED;
            PG8_LDA(At, 1, 1); PG8_STAGE(PG8_SB(1, 0), b3, voffB); PG8_STAGE(PG8_SB(1, 1), b3 + hstep, voffB); PG8_STAGE(PG8_SA(1, 0), a3, voffA);
            PG8_WAIT_V(8); PG8_WAIT_L(0); PG8_BAR; PG8_MMA(1, 0, At, B0); PG8_MMA(1, 1, At, B1); PG8_BAR; PG8_SCHED;
            } else {
            PG8_LDB(B0, 0, 0); PG8_SCHED; PG8_LDA(At, 0, 0); PG8_STAGE(PG8_SA(1, 1), a1 + hstep, voffA);
            PG8_WAIT_L(8); PG8_BAR; PG8_WAIT_L(0); PG8_MMA(0, 0, At, B0); PG8_BAR; PG8_SCHED;
            PG8_LDB(B1, 0, 1); PG8_STAGE(PG8_SB(0, 0), b2, voffB);
            PG8_BAR; PG8_WAIT_L(0); PG8_MMA(0, 1, At, B1); PG8_BAR;
            PG8_LDA(At, 0, 1); PG8_STAGE(PG8_SA(0, 0), a2, voffA);
            PG8_BAR; PG8_WAIT_L(0); PG8_MMA(1, 0, At, B0); PG8_BAR; PG8_SCHED;
            PG8_STAGE(PG8_SB(0, 1), b2 + hstep, voffB);
            PG8_WAIT_V(6); PG8_BAR; PG8_MMA(1, 1, At, B1); PG8_BAR;
            PG8_LDB(B0, 1, 0); PG8_SCHED; PG8_LDA(At, 1, 0); PG8_STAGE(PG8_SA(0, 1), a2 + hstep, voffA);
            PG8_WAIT_L(8); PG8_BAR; PG8_WAIT_L(0); PG8_MMA(0, 0, At, B0); PG8_BAR; PG8_SCHED;
            PG8_LDB(B1, 1, 1); PG8_STAGE(PG8_SB(1, 0), b3, voffB);
            PG8_BAR; PG8_WAIT_L(0); PG8_MMA(0, 1, At, B1); PG8_BAR;
            PG8_LDA(At, 1, 1); PG8_STAGE(PG8_SA(1, 0), a3, voffA);
            PG8_BAR; PG8_WAIT_L(0); PG8_MMA(1, 0, At, B0); PG8_BAR; PG8_SCHED;
            PG8_STAGE(PG8_SB(1, 1), b3 + hstep, voffB);
            PG8_WAIT_V(6); PG8_BAR; PG8_MMA(1, 1, At, B1); PG8_BAR;
            }
        }
        if constexpr (ALIGN_EPI) { if (wr == 0) PG8_BAR; }
        if constexpr (!Epi::AFTER_DRAIN) { if constexpr (Epi::HAS_PRE) E.pre(acc, cur, wr, wc, fr, fq, pfa); E(acc, cur, wr, wc, fr, fq); S.done(cur); }
        if (!has_next) break;
#pragma unroll
        for (int a = 0; a < 2; ++a)
#pragma unroll
            for (int b = 0; b < 2; ++b)
#pragma unroll
                for (int m = 0; m < 4; ++m)
#pragma unroll
                    for (int n = 0; n < 2; ++n) acc[a][b][m][n] = (f32x4){0.f, 0.f, 0.f, 0.f};
        cur = nxt; cA = nA; cB = nB; ++ui;
        if constexpr (ALIGN_EPI) { if (wr == 1) PG8_BAR; }
    }
    PG8_WAIT_V(0);
    if constexpr (!ALIGN_EPI) { if (wr == 0) PG8_BAR; }
    PG8_BAR;
    if constexpr (Epi::AFTER_DRAIN) { E.fused(acc, cur, wr, wc, fr, fq, lds, wid, lane); S.done(cur); }
#undef PG8_SA
#undef PG8_SB
#undef PG8_STAGE
#undef PG8_LDA
#undef PG8_LDB
#undef PG8_MMA
#undef PG8_WAIT_V
#undef PG8_WAIT_L
#undef PG8_BAR
#undef PG8_SCHED
}
}

constexpr int DM = 2048;
constexpr int T = 32768, TP = 16384;
constexpr int FFN = 5632;
constexpr float ALPHA = 1.6817928305074290f;
typedef unsigned short bf16;
typedef unsigned v4u __attribute__((ext_vector_type(4)));
typedef unsigned v2u __attribute__((ext_vector_type(2)));
typedef float f32x4 __attribute__((ext_vector_type(4)));
typedef float f32x16 __attribute__((ext_vector_type(16)));
typedef short bf16x8 __attribute__((ext_vector_type(8)));
typedef short s16x4 __attribute__((ext_vector_type(4)));

__device__ __forceinline__ int seq_pos(int r) { return r < TP ? (r & 8191) : (r & 2047); }
__device__ __forceinline__ unsigned pkbf(float lo, float hi) { return pg8::cvt_pk_bf16(lo, hi); }
__device__ __forceinline__ v4u pack8(f32x4 a, f32x4 b) { v4u w; w.x = pkbf(a[0], a[1]); w.y = pkbf(a[2], a[3]); w.z = pkbf(b[0], b[1]); w.w = pkbf(b[2], b[3]); return w; }
__device__ __forceinline__ float bf2f(unsigned short b) { return __builtin_bit_cast(float, (unsigned)b << 16); }
__device__ __forceinline__ float bflo(unsigned w) { return __builtin_bit_cast(float, w << 16); }
__device__ __forceinline__ float bfhi(unsigned w) { return __builtin_bit_cast(float, w & 0xffff0000u); }
typedef _Float16 h2_t __attribute__((ext_vector_type(2)));
typedef float f2_t __attribute__((ext_vector_type(2)));
__device__ __forceinline__ unsigned pkh(float a, float b) { const f2_t v = {a, b}; return __builtin_bit_cast(unsigned, __builtin_convertvector(v, h2_t)); }
__device__ __forceinline__ float hlo(unsigned w) { return (float)__builtin_bit_cast(h2_t, w).x; }
__device__ __forceinline__ float hhi(unsigned w) { return (float)__builtin_bit_cast(h2_t, w).y; }
#ifndef SQ_DROP
#define SQ_DROP 2
#endif
__device__ __forceinline__ unsigned SQ(unsigned w) {
    if (SQ_DROP == 0) return w;
    const unsigned half = (1u << (SQ_DROP - 1)) - 1u, lsb = (w >> SQ_DROP) & 0x00010001u, msk = ~(((1u << SQ_DROP) - 1u) * 0x00010001u);
    return (w + half * 0x00010001u + lsb) & msk;
}
typedef long long fx64;
__device__ __forceinline__ void fx_add(fx64* p, float v) { atomicAdd((unsigned long long*)p, (unsigned long long)(long long)(v * 4294967296.0f)); }
__device__ __forceinline__ float fx_val(fx64 x) { return (float)((double)x * (1.0 / 4294967296.0)); }
__device__ __forceinline__ float fx_load(const fx64* p) { return fx_val(__hip_atomic_load(p, __ATOMIC_RELAXED, __HIP_MEMORY_SCOPE_AGENT)); }

namespace pg8 {
struct LnCorr { const fx64* st; const float* cs; const float* b2; };
__device__ __forceinline__ void ln_prefetch(const LnCorr& L, const Unit& u, PG8_LAS unsigned char* pfa, int wid, int lane) {
    if (!L.st) return;
    if (wid < 4) __builtin_amdgcn_global_load_lds((const unsigned*)(L.st + 2 * (u.pm * BM + 64 * wid + lane)), (PG8_LAS unsigned*)(pfa + wid * 1024), 16, 0, 0);
    else if (wid < 6) { const float* v = (wid == 4 ? L.cs : L.b2) + u.pn * BM + 4 * lane; __builtin_amdgcn_global_load_lds((const unsigned*)v, (PG8_LAS unsigned*)(pfa + 4096 + (wid - 4) * 1024), 16, 0, 0); }
}
template <bool PERM, bool APERM = false> __device__ __forceinline__ void ln_correct(const LnCorr& L, f32x4 (&acc)[2][2][4][2], int wr, int wc, int fr, int fq, const PG8_LAS unsigned char* pfa) {
    if (!L.st) return;
    typedef long long ll2 __attribute__((ext_vector_type(2)));
    float rs[2][4], mr[2][4];
#pragma unroll
    for (int ai = 0; ai < 2; ++ai)
#pragma unroll
        for (int m = 0; m < 4; ++m) { const int lr = ai * HALF + wr * 64 + (APERM ? 4 * fr + m : m * 16 + fr);
            const ll2 sv = *(const PG8_LAS ll2*)(pfa + lr * 16);
            const float s1 = fx_val(sv.x), s2 = fx_val(sv.y);
            const float mu = s1 * (1.0f / DM), var = s2 * (1.0f / DM) - mu * mu; const float r_ = __builtin_amdgcn_rsqf(var + 1e-5f); rs[ai][m] = r_; mr[ai][m] = mu * r_; }
#pragma unroll
    for (int bj = 0; bj < 2; ++bj)
#pragma unroll
        for (int n = 0; n < 2; ++n) { const int lc = bj * HALF + wc * 32 + (PERM ? 8 * fq + 4 * n : 16 * n + 4 * fq);
            const f32x4 c4 = *(const PG8_LAS f32x4*)(pfa + 4096 + lc * 4), b4 = *(const PG8_LAS f32x4*)(pfa + 5120 + lc * 4);
#pragma unroll
            for (int ai = 0; ai < 2; ++ai)
#pragma unroll
                for (int m = 0; m < 4; ++m) acc[ai][bj][m][n] = acc[ai][bj][m][n] * rs[ai][m] - c4 * mr[ai][m] + b4; }
}
struct EpiRetIn {
    static constexpr bool PERM = true, AFTER_DRAIN = false, APERM = false, HAS_PRE = true, F16 = true;
    bf16_t *Q, *K, *V, *G; const float *cosT, *sinT; LnCorr lc;
    __device__ __forceinline__ void prefetch(const Unit& u, PG8_LAS unsigned char* pfa, int wid, int lane) const { ln_prefetch(lc, u, pfa, wid, lane); }
    __device__ __forceinline__ void pre(f32x4 (&acc)[2][2][4][2], const Unit& u, int wr, int wc, int fr, int fq, const PG8_LAS unsigned char* pfa) const { ln_correct<true>(lc, acc, wr, wc, fr, fq, pfa); }
    __device__ __forceinline__ void operator()(const f32x4 (&acc)[2][2][4][2], const Unit& u, int wr, int wc, int fr, int fq) const {
        const int row0 = u.pm * BM + wr * 64 + fr, cl = wc * 32 + 8 * fq;
        if (u.pn < 16) {
            bf16_t* base = (u.pn < 8 ? Q : K) + (size_t)(u.pn & 7) * 256 + cl;
#pragma unroll
            for (int ai = 0; ai < 2; ++ai)
#pragma unroll
                for (int m = 0; m < 4; ++m) {
                    const int r = row0 + ai * HALF + m * 16; const int pos = seq_pos(r);
                    const float* cp = cosT + (size_t)pos * 128 + cl; const float* sp = sinT + (size_t)pos * 128 + cl;
                    const f32x4 c0 = *(const f32x4*)cp, c1 = *(const f32x4*)(cp + 4), s0 = *(const f32x4*)sp, s1 = *(const f32x4*)(sp + 4);
                    const f32x4 x1a = acc[ai][0][m][0], x1b = acc[ai][0][m][1], x2a = acc[ai][1][m][0], x2b = acc[ai][1][m][1];
                    const f32x4 y1a = x1a * c0 - x2a * s0, y1b = x1b * c1 - x2b * s1, y2a = x1a * s0 + x2a * c0, y2b = x1b * s1 + x2b * c1;
                    bf16_t* rp = base + (size_t)r * 2048;
                    *(u32x4*)rp = pack8(y1a, y1b); *(u32x4*)(rp + 128) = pack8(y2a, y2b);
                    asm volatile("" ::: "memory"); }
        } else {
            bf16_t* base = (u.pn < 32 ? V + (size_t)(u.pn - 16) * 256 : G + (size_t)(u.pn - 32) * 256) + cl;
#pragma unroll
            for (int ai = 0; ai < 2; ++ai)
#pragma unroll
                for (int m = 0; m < 4; ++m) { bf16_t* rp = base + (size_t)(row0 + ai * HALF + m * 16) * 4096;
#pragma unroll
                    for (int bj = 0; bj < 2; ++bj) *(u32x4*)(rp + bj * HALF) = pack8(acc[ai][bj][m][0], acc[ai][bj][m][1]); }
        }
    }
};
struct EpiResid {
    static constexpr bool PERM = true, AFTER_DRAIN = false, APERM = false, HAS_PRE = true, F16 = false;
    bf16_t* XBs; float* Yf; fx64* st_new; const fx64* st_prev; const float* g; const float* b; const float* xin_p; const float* xin_s;
    __device__ __forceinline__ void prefetch(const Unit& u, PG8_LAS unsigned char* pfa, int wid, int lane) const { ln_prefetch(LnCorr{st_prev, g, b}, u, pfa, wid, lane); }
    __device__ __forceinline__ void operator()(const f32x4 (&acc)[2][2][4][2], const Unit& u, int wr, int wc, int fr, int fq) const {}
    __device__ __forceinline__ void pre(f32x4 (&acc)[2][2][4][2], const Unit& u, int wr, int wc, int fr, int fq, const PG8_LAS unsigned char* pfa) const {
        typedef long long ll2 __attribute__((ext_vector_type(2)));
        const int row0 = u.pm * BM + wr * 64 + fr, lc0 = wc * 32 + 8 * fq, col0 = u.pn * BM + lc0;
#pragma unroll
        for (int ai = 0; ai < 2; ++ai) {
            float mu[4], rs[4], s1[4], s2[4];
#pragma unroll
            for (int m = 0; m < 4; ++m) { s1[m] = 0.f; s2[m] = 0.f; mu[m] = 0.f; rs[m] = 1.f;
                if (st_prev) { const ll2 sv = *(const PG8_LAS ll2*)(pfa + (ai * HALF + wr * 64 + m * 16 + fr) * 16);
                    const float p1 = fx_val(sv.x), p2 = fx_val(sv.y); mu[m] = p1 * (1.0f / DM); const float var = p2 * (1.0f / DM) - mu[m] * mu[m]; rs[m] = __builtin_amdgcn_rsqf(var + 1e-5f); } }
#pragma unroll
            for (int bj = 0; bj < 2; ++bj) {
                f32x4 xv[4][2];
                if (!st_prev) {
#pragma unroll
                    for (int m = 0; m < 4; ++m) { const int r = row0 + ai * HALF + m * 16; const float* srcp = (r < TP ? xin_p + (size_t)r * DM : xin_s + (size_t)(r - TP) * DM) + col0 + bj * HALF;
                        xv[m][0] = *(const f32x4*)srcp; xv[m][1] = *(const f32x4*)(srcp + 4); }
                } else {
                    v4u w[4];
#pragma unroll
                    for (int m = 0; m < 4; ++m) w[m] = *(const v4u*)(XBs + (size_t)(row0 + ai * HALF + m * 16) * DM + col0 + bj * HALF);
                    const f32x4 g0 = *(const PG8_LAS f32x4*)(pfa + 4096 + (bj * HALF + lc0) * 4), g1 = *(const PG8_LAS f32x4*)(pfa + 4096 + (bj * HALF + lc0 + 4) * 4);
                    const f32x4 b0 = *(const PG8_LAS f32x4*)(pfa + 5120 + (bj * HALF + lc0) * 4), b1 = *(const PG8_LAS f32x4*)(pfa + 5120 + (bj * HALF + lc0 + 4) * 4);
#pragma unroll
                    for (int m = 0; m < 4; ++m) {
                        const f32x4 x0 = (f32x4){hlo(w[m].x), hhi(w[m].x), hlo(w[m].y), hhi(w[m].y)}, x1 = (f32x4){hlo(w[m].z), hhi(w[m].z), hlo(w[m].w), hhi(w[m].w)};
                        xv[m][0] = (x0 - mu[m]) * rs[m] * g0 + b0; xv[m][1] = (x1 - mu[m]) * rs[m] * g1 + b1; } }
#pragma unroll
                for (int m = 0; m < 4; ++m) { const int r = row0 + ai * HALF + m * 16;
                    const f32x4 y0 = xv[m][0] * ALPHA + acc[ai][bj][m][0], y1 = xv[m][1] * ALPHA + acc[ai][bj][m][1];
                    if (Yf) { float* yp = Yf + (size_t)r * DM + col0 + bj * HALF; *(f32x4*)yp = y0; *(f32x4*)(yp + 4) = y1; }
                    else { v4u w; w.x = SQ(pkh(y0[0], y0[1])); w.y = SQ(pkh(y0[2], y0[3])); w.z = SQ(pkh(y1[0], y1[1])); w.w = SQ(pkh(y1[2], y1[3]));
                        *(v4u*)(XBs + (size_t)r * DM + col0 + bj * HALF) = w;
                        const float a0 = hlo(w.x), a1 = hhi(w.x), a2 = hlo(w.y), a3 = hhi(w.y), a4 = hlo(w.z), a5 = hhi(w.z), a6 = hlo(w.w), a7 = hhi(w.w);
                        s1[m] += ((a0 + a1) + (a2 + a3)) + ((a4 + a5) + (a6 + a7)); s2[m] += ((a0 * a0 + a1 * a1) + (a2 * a2 + a3 * a3)) + ((a4 * a4 + a5 * a5) + (a6 * a6 + a7 * a7)); } }
                asm volatile("" ::: "memory"); }
            if (!Yf) {
#pragma unroll
                for (int m = 0; m < 4; ++m) { const int r = row0 + ai * HALF + m * 16; float t1 = s1[m], t2 = s2[m];
                    t1 += __shfl_xor(t1, 16); t1 += __shfl_xor(t1, 32); t2 += __shfl_xor(t2, 16); t2 += __shfl_xor(t2, 32);
                    if (fq == 0) { fx_add(st_new + 2 * r, t1); fx_add(st_new + 2 * r + 1, t2); } } }
        }
    }
};
struct EpiSplit {
    static constexpr bool PERM = true, AFTER_DRAIN = false, APERM = false, HAS_PRE = false, F16 = false;
    bf16_t *O0, *O1; int split, ldc;
    __device__ __forceinline__ void operator()(const f32x4 (&acc)[2][2][4][2], const Unit& u, int wr, int wc, int fr, int fq) const {
        const int row0 = u.pm * BM + wr * 64 + fr, cl = wc * 32 + 8 * fq;
        bf16_t* base = (u.pn < split ? O0 + (size_t)u.pn * 256 : O1 + (size_t)(u.pn - split) * 256) + cl;
#pragma unroll
        for (int ai = 0; ai < 2; ++ai)
#pragma unroll
            for (int m = 0; m < 4; ++m) { bf16_t* rp = base + (size_t)(row0 + ai * HALF + m * 16) * ldc;
#pragma unroll
                for (int bj = 0; bj < 2; ++bj) *(u32x4*)(rp + bj * HALF) = pack8(acc[ai][bj][m][0], acc[ai][bj][m][1]); }
    }
};
struct EpiMlaIn {
    static constexpr bool PERM = true, AFTER_DRAIN = false, APERM = false, HAS_PRE = true, F16 = true;
    bf16_t *CQ, *CKV, *KR; fx64 *ssq_q, *ssq_kv; const float *cosM, *sinM; LnCorr lc;
    __device__ __forceinline__ void prefetch(const Unit& u, PG8_LAS unsigned char* pfa, int wid, int lane) const { ln_prefetch(lc, u, pfa, wid, lane); }
    __device__ __forceinline__ void pre(f32x4 (&acc)[2][2][4][2], const Unit& u, int wr, int wc, int fr, int fq, const PG8_LAS unsigned char* pfa) const { ln_correct<true>(lc, acc, wr, wc, fr, fq, pfa); }
    __device__ __forceinline__ void operator()(const f32x4 (&acc)[2][2][4][2], const Unit& u, int wr, int wc, int fr, int fq) const {
        const int row0 = u.pm * BM + wr * 64 + fr, cl = wc * 32 + 8 * fq;
        if (u.pn < 8) {
            const bool isq = u.pn < 6; const int ldc = isq ? 1536 : 512;
            bf16_t* base = (isq ? CQ + (size_t)u.pn * 256 : CKV + (size_t)(u.pn - 6) * 256) + cl; fx64* ssq = isq ? ssq_q : ssq_kv;
#pragma unroll
            for (int ai = 0; ai < 2; ++ai)
#pragma unroll
                for (int m = 0; m < 4; ++m) { const int r = row0 + ai * HALF + m * 16; bf16_t* rp = base + (size_t)r * ldc; float s = 0.f;
#pragma unroll
                    for (int bj = 0; bj < 2; ++bj) { const f32x4 a = acc[ai][bj][m][0], b = acc[ai][bj][m][1];
                        s += (a[0] * a[0] + a[1] * a[1]) + (a[2] * a[2] + a[3] * a[3]) + (b[0] * b[0] + b[1] * b[1]) + (b[2] * b[2] + b[3] * b[3]);
                        *(u32x4*)(rp + bj * HALF) = pack8(a, b); }
                    s += __shfl_xor(s, 16); s += __shfl_xor(s, 32);
                    if (fq == 0) fx_add(ssq + r, s); }
        } else if (wc == 0) {
#pragma unroll
            for (int ai = 0; ai < 2; ++ai)
#pragma unroll
                for (int m = 0; m < 4; ++m) { const int r = row0 + ai * HALF + m * 16; const int pos = seq_pos(r);
                    const float* cp = cosM + (size_t)pos * 32 + 8 * fq; const float* sp = sinM + (size_t)pos * 32 + 8 * fq;
                    const f32x4 c0 = *(const f32x4*)cp, c1 = *(const f32x4*)(cp + 4), s0 = *(const f32x4*)sp, s1 = *(const f32x4*)(sp + 4);
                    const f32x4 x1a = acc[ai][0][m][0], x1b = acc[ai][0][m][1], x2a = acc[ai][1][m][0], x2b = acc[ai][1][m][1];
                    const f32x4 y1a = x1a * c0 - x2a * s0, y1b = x1b * c1 - x2b * s1, y2a = x1a * s0 + x2a * c0, y2b = x1b * s1 + x2b * c1;
                    bf16_t* rp = KR + (size_t)r * 64 + 8 * fq;
                    *(u32x4*)rp = pack8(y1a, y1b); *(u32x4*)(rp + 32) = pack8(y2a, y2b); }
        }
    }
};
__device__ __forceinline__ void ssq_prefetch(const fx64* ssq, const Unit& u, PG8_LAS unsigned char* pfa, int wid, int lane) {
    if (wid < 2) __builtin_amdgcn_global_load_lds((const unsigned*)(ssq + u.pm * BM + 128 * wid + 2 * lane), (PG8_LAS unsigned*)(pfa + wid * 1024), 16, 0, 0);
}
__device__ __forceinline__ void ssq_scale(f32x4 (&acc)[2][2][4][2], float inv_n, int wr, int fr, const PG8_LAS unsigned char* pfa) {
#pragma unroll
    for (int ai = 0; ai < 2; ++ai)
#pragma unroll
        for (int m = 0; m < 4; ++m) { const float rs = __builtin_amdgcn_rsqf(fx_val(*(const PG8_LAS fx64*)(pfa + (ai * HALF + wr * 64 + m * 16 + fr) * 8)) * inv_n + 1e-6f);
#pragma unroll
            for (int bj = 0; bj < 2; ++bj)
#pragma unroll
                for (int n = 0; n < 2; ++n) acc[ai][bj][m][n] = acc[ai][bj][m][n] * rs; }
}
struct EpiMlaUq {
    static constexpr bool PERM = true, AFTER_DRAIN = false, APERM = false, HAS_PRE = true, F16 = false;
    bf16_t* QA; const fx64* ssq_q; const float *cosM, *sinM;
    __device__ __forceinline__ void prefetch(const Unit& u, PG8_LAS unsigned char* pfa, int wid, int lane) const { ssq_prefetch(ssq_q, u, pfa, wid, lane); }
    __device__ __forceinline__ void pre(f32x4 (&acc)[2][2][4][2], const Unit& u, int wr, int wc, int fr, int fq, const PG8_LAS unsigned char* pfa) const { ssq_scale(acc, 1.0f / 1536.0f, wr, fr, pfa); }
    __device__ __forceinline__ void operator()(const f32x4 (&acc)[2][2][4][2], const Unit& u, int wr, int wc, int fr, int fq) const {
        const int row0 = u.pm * BM + wr * 64 + fr;
#pragma unroll
        for (int ai = 0; ai < 2; ++ai)
#pragma unroll
            for (int m = 0; m < 4; ++m) { const int r = row0 + ai * HALF + m * 16;
                bf16_t* rp = QA + (size_t)r * 3072;
                if (u.pn < 8) {
#pragma unroll
                    for (int bj = 0; bj < 2; ++bj) *(u32x4*)(rp + (2 * u.pn + bj) * 192 + wc * 32 + 8 * fq) = pack8(acc[ai][bj][m][0], acc[ai][bj][m][1]);
                } else {
                    const int head = 4 * (u.pn - 8) + wc; const int pos = seq_pos(r);
                    const float* cp = cosM + (size_t)pos * 32 + 8 * fq; const float* sp = sinM + (size_t)pos * 32 + 8 * fq;
                    const f32x4 c0 = *(const f32x4*)cp, c1 = *(const f32x4*)(cp + 4), s0 = *(const f32x4*)sp, s1 = *(const f32x4*)(sp + 4);
                    const f32x4 x1a = acc[ai][0][m][0], x1b = acc[ai][0][m][1], x2a = acc[ai][1][m][0], x2b = acc[ai][1][m][1];
                    const f32x4 y1a = x1a * c0 - x2a * s0, y1b = x1b * c1 - x2b * s1, y2a = x1a * s0 + x2a * c0, y2b = x1b * s1 + x2b * c1;
                    *(u32x4*)(rp + head * 192 + 128 + 8 * fq) = pack8(y1a, y1b); *(u32x4*)(rp + head * 192 + 160 + 8 * fq) = pack8(y2a, y2b);
                }
                asm volatile("" ::: "memory"); }
    }
};
struct EpiMlaUkv {
    static constexpr bool PERM = true, AFTER_DRAIN = false, APERM = false, HAS_PRE = true, F16 = false;
    bf16_t* KV; const fx64* ssq_kv;
    __device__ __forceinline__ void prefetch(const Unit& u, PG8_LAS unsigned char* pfa, int wid, int lane) const { ssq_prefetch(ssq_kv, u, pfa, wid, lane); }
    __device__ __forceinline__ void pre(f32x4 (&acc)[2][2][4][2], const Unit& u, int wr, int wc, int fr, int fq, const PG8_LAS unsigned char* pfa) const { ssq_scale(acc, 1.0f / 512.0f, wr, fr, pfa); }
    __device__ __forceinline__ void operator()(const f32x4 (&acc)[2][2][4][2], const Unit& u, int wr, int wc, int fr, int fq) const {
        const int row0 = u.pm * BM + wr * 64 + fr, cl = wc * 32 + 8 * fq;
#pragma unroll
        for (int ai = 0; ai < 2; ++ai)
#pragma unroll
            for (int m = 0; m < 4; ++m) { const int r = row0 + ai * HALF + m * 16;
                bf16_t* rp = KV + (size_t)r * 4096 + (size_t)u.pn * 256 + cl;
#pragma unroll
                for (int bj = 0; bj < 2; ++bj) *(u32x4*)(rp + bj * HALF) = pack8(acc[ai][bj][m][0], acc[ai][bj][m][1]); }
    }
};
#define DPP_ROR(x, n) __builtin_bit_cast(float, __builtin_amdgcn_update_dpp(0, __builtin_bit_cast(int, (float)(x)), 0x120 + (n), 0xf, 0xf, false))
struct EpiFfnUp {
    static constexpr bool PERM = true, AFTER_DRAIN = false, APERM = true, HAS_PRE = true, F16 = true;
    bf16_t *A, *EG, *EU; const float *cw, *cb; LnCorr lc;
    __device__ __forceinline__ void prefetch(const Unit& u, PG8_LAS unsigned char* pfa, int wid, int lane) const { ln_prefetch(lc, u, pfa, wid, lane); }
    __device__ __forceinline__ void pre(f32x4 (&acc)[2][2][4][2], const Unit& u, int wr, int wc, int fr, int fq, const PG8_LAS unsigned char* pfa) const { ln_correct<true, true>(lc, acc, wr, wc, fr, fq, pfa); }
    __device__ __forceinline__ void operator()(const f32x4 (&acc)[2][2][4][2], const Unit& u, int wr, int wc, int fr, int fq) const {
        const int ch0 = u.pn * 128 + wc * 32 + 8 * fq;
        f32x4 w0[2], w1[2], w2[2], bb[2];
#pragma unroll
        for (int n = 0; n < 2; ++n) { w0[n] = *(const f32x4*)(cw + ch0 + 4 * n); w1[n] = *(const f32x4*)(cw + FFN + ch0 + 4 * n); w2[n] = *(const f32x4*)(cw + 2 * FFN + ch0 + 4 * n); bb[n] = *(const f32x4*)(cb + ch0 + 4 * n); }
#pragma unroll
        for (int ai = 0; ai < 2; ++ai) {
            const int rblk = u.pm * BM + ai * HALF + wr * 64; const int blk = rblk >> 6;
            f32x4 P[2], Nx[2];
#pragma unroll
            for (int n = 0; n < 2; ++n)
#pragma unroll
                for (int e = 0; e < 4; ++e) { P[n][e] = DPP_ROR(acc[ai][1][3][n][e], 1); Nx[n][e] = DPP_ROR(acc[ai][1][0][n][e], 15); }
#pragma unroll
            for (int m = 0; m < 4; ++m) {
                f32x4 av[2];
#pragma unroll
                for (int n = 0; n < 2; ++n) {
                    const f32x4 gp = (m == 0) ? P[n] : acc[ai][1][m > 0 ? m - 1 : 0][n], gn = (m == 3) ? Nx[n] : acc[ai][1][m < 3 ? m + 1 : 3][n], gc = acc[ai][1][m][n];
                    f32x4 t = gp * w0[n] + gc * w1[n] + gn * w2[n] + bb[n];
#pragma unroll
                    for (int e = 0; e < 4; ++e) t[e] = t[e] * __builtin_amdgcn_rcpf(1.0f + __expf(-t[e]));
                    av[n] = t * acc[ai][0][m][n];
                }
                const int r = rblk + 4 * fr + m;
                const bool edge = (m == 0 && fr == 0) || (m == 3 && fr == 15);
                if (!edge) *(u32x4*)(A + (size_t)r * FFN + ch0) = pack8(av[0], av[1]);
                if (m < 2 && fr == 0) { *(u32x4*)(EG + ((size_t)blk * 4 + m) * FFN + ch0) = pack8(acc[ai][1][m][0], acc[ai][1][m][1]);
                    if (m == 0) *(u32x4*)(EU + ((size_t)blk * 2) * FFN + ch0) = pack8(acc[ai][0][0][0], acc[ai][0][0][1]); }
                if (m >= 2 && fr == 15) { *(u32x4*)(EG + ((size_t)blk * 4 + m) * FFN + ch0) = pack8(acc[ai][1][m][0], acc[ai][1][m][1]);
                    if (m == 3) *(u32x4*)(EU + ((size_t)blk * 2 + 1) * FFN + ch0) = pack8(acc[ai][0][3][0], acc[ai][0][3][1]); }
            }
        }
    }
};
}

typedef GAS unsigned gu32;
#define RLX_AGENT __ATOMIC_RELAXED, __HIP_MEMORY_SCOPE_AGENT
#define LDS_WAIT() asm volatile("s_waitcnt lgkmcnt(0)" ::: "memory")
#define VM_WAIT() asm volatile("s_waitcnt vmcnt(0)" ::: "memory")
#define SBAR() __builtin_amdgcn_sched_barrier(0)

#define XB_TMO      128
#define XB_XCNT(j)  (256  + 64 * (j))
#define XB_XSUB(j)  (1280 + 64 * (j))
#define XB_XGEN(j)  (2304 + 64 * (j))
#define XB_TOP      3328
#define XB_TOPGEN   3392
#define XCD_BAR_WORDS 3456
#define XB_SPIN_CAP (1u << 22)

__device__ __forceinline__ unsigned xb_ld(unsigned* p)              { return __hip_atomic_load(p, __ATOMIC_RELAXED, __HIP_MEMORY_SCOPE_AGENT); }
__device__ __forceinline__ unsigned xb_add(unsigned* p, unsigned v) { return __hip_atomic_fetch_add(p, v, __ATOMIC_RELAXED, __HIP_MEMORY_SCOPE_AGENT); }
__device__ __forceinline__ unsigned xb_xcc_id() { return (unsigned)__builtin_amdgcn_s_getreg((3 << 11) | 20) & 0xFu; }
#define XB_SPIN(cond, bar) do { unsigned _sp = 0; while (cond) { __builtin_amdgcn_s_sleep(1); \
    if ((++_sp & 255u) == 0u) { if (xb_ld(&(bar)[XB_TMO])) break; if (_sp > XB_SPIN_CAP) { atomicAdd(&(bar)[XB_TMO], 1u); break; } } } } while (0)

struct XcdBarrier {
    unsigned* bar; unsigned x;
    volatile LAS unsigned* st;
};

__device__ __forceinline__ XcdBarrier xcd_barrier_post(unsigned* bar, volatile LAS unsigned* st) {
    XcdBarrier b; b.bar = bar; b.x = xb_xcc_id(); b.st = st;
    if (threadIdx.x == 0) (void)xb_add(&bar[XB_XCNT(b.x)], 1u);
    return b;
}
__device__ __forceinline__ void xcd_barrier_complete(unsigned* bar, unsigned x, unsigned& nloc, unsigned& nx) {
    const unsigned G = gridDim.x * gridDim.y * gridDim.z;
    unsigned sum, cnt, mine, sp = 0u;
    for (;;) {
        sum = 0u; cnt = 0u; mine = 0u;
#pragma unroll
        for (unsigned j = 0; j < 16; ++j) { const unsigned c = xb_ld(&bar[XB_XCNT(j)]); sum += c; cnt += (c > 0u) ? 1u : 0u; mine = (j == x) ? c : mine; }
        if (sum == G) break;
        __builtin_amdgcn_s_sleep(1);
        if ((++sp & 255u) == 0u) { if (xb_ld(&bar[XB_TMO])) break; if (sp > XB_SPIN_CAP) { atomicAdd(&bar[XB_TMO], 1u); break; } }
    }
    nloc = mine > 0u ? mine : 1u; nx = cnt > 0u ? cnt : 1u;
}

__device__ __forceinline__ void xcd_barrier(const XcdBarrier& b) {
    asm volatile("s_waitcnt vmcnt(0)" ::: "memory");
    __syncthreads();
    if (threadIdx.x == 0) {
        unsigned* bar = b.bar;
        __builtin_amdgcn_s_waitcnt(0);
        unsigned nloc = b.st[0], nx = b.st[1];
        if (nloc == 0u) { xcd_barrier_complete(bar, b.x, nloc, nx); b.st[0] = nloc; b.st[1] = nx; }
        const unsigned old = xb_add(&bar[XB_XSUB(b.x)], 1u);
        const unsigned gen = old / nloc;
        if (old + 1u == (gen + 1u) * nloc) {
            __builtin_amdgcn_fence(__ATOMIC_RELEASE, "agent");
            asm volatile("s_waitcnt vmcnt(0)" ::: "memory");
            const unsigned og = xb_add(&bar[XB_TOP], 1u);
            const unsigned tg = og / nx;
            if (og + 1u == (tg + 1u) * nx) xb_add(&bar[XB_TOPGEN], 1u);
            else XB_SPIN(xb_ld(&bar[XB_TOPGEN]) == tg, bar);
            __builtin_amdgcn_fence(__ATOMIC_ACQUIRE, "agent");
            xb_add(&bar[XB_XGEN(b.x)], 1u);
            asm volatile("s_waitcnt vmcnt(0)" ::: "memory");
        } else {
            XB_SPIN(xb_ld(&bar[XB_XGEN(b.x)]) == gen, bar);
            __builtin_amdgcn_fence(__ATOMIC_ACQUIRE, "agent");
            asm volatile("s_waitcnt vmcnt(0)" ::: "memory");
        }
    }
    __syncthreads();
}


constexpr size_t MiB = 1u << 20;
constexpr size_t WS_CTL = 0, CTL_ZERO_BYTES = 8 * MiB;
constexpr int    CW_BAR = 4096;
constexpr size_t CTL_SSQ = 1 * MiB;
constexpr size_t CTL_LGTAB = 64 * 1024;
constexpr size_t CTL_STATS = 2 * MiB;
constexpr size_t CTL_CSB2 = 6 * MiB;
constexpr size_t CTL_CSF = 8 * MiB;
constexpr size_t WS_TAB = 9 * MiB;
constexpr size_t WS_W = 19 * MiB;
constexpr size_t WS_XB = 149 * MiB;
constexpr size_t WS_WD2 = 277 * MiB;
constexpr size_t WS_ACT = 357 * MiB;
constexpr size_t WS_END = WS_ACT + 1024 * MiB;
constexpr size_t W_RET_OUT = 0, W_UP = 16 * MiB, W_DOWN = 60 * MiB, W_RET_IN = 82 * MiB;
constexpr size_t W_MLA_OUT = 0, W_MLA_IN = 82 * MiB, W_MLA_UQ = 92 * MiB, W_MLA_UKV = 102 * MiB;
constexpr size_t A_RQ = 0, A_RK = 128 * MiB, A_RV = 256 * MiB, A_RG = 512 * MiB, A_RO = 768 * MiB;
constexpr size_t A_FU = 0, A_FG = 352 * MiB;
constexpr size_t A_MCQ = 0, A_MCKV = 96 * MiB, A_MKR = 128 * MiB, A_MQA = 132 * MiB, A_MKV = 324 * MiB, A_MO = 580 * MiB;

constexpr int RING_OFF = 0, RING_BYTES = 159744;
constexpr int LDSCTL_OFF = RING_BYTES, MISC_OFF = LDSCTL_OFF + 320;
constexpr int LDS_BYTES = 163840;
constexpr int NWAVES = 8;


struct Frame {
    LAS unsigned char* lds;
    int wave;
    int vcu, G;
    int gw, NGW;
};

#define PHASE_TID(tid, lane) int tid = threadIdx.x; asm volatile("" : "+v"(tid)); const int lane = tid & 63; int gw_ = F.gw; asm volatile("" : "+s"(gw_)); const int gw = gw_, NGW = 2048; (void)gw; (void)NGW

__device__ __forceinline__ float wave_sum(float v) {
#pragma unroll
    for (int o = 1; o < 64; o <<= 1) v += __shfl_xor(v, o);
    return v;
}

#ifndef WQ_DROP
#define WQ_DROP 1
#endif
__device__ __forceinline__ unsigned WQ(unsigned w) {
    if (WQ_DROP == 0) return w;
    const unsigned half = (1u << (WQ_DROP - 1)) - 1u, lsb = (w >> WQ_DROP) & 0x00010001u, msk = ~(((1u << WQ_DROP) - 1u) * 0x00010001u);
    return (w + half * 0x00010001u + lsb) & msk;
}
__device__ __forceinline__ void tr_item(const float* __restrict__ W, int K, int N, bf16* WT, int k0, int n0, int drow0, float sc, const float* __restrict__ ks, const float* __restrict__ bln, fx64* csp, fx64* b2p, bool f16, LAS float* scr, int lane) {
    const int r = lane >> 3, q = lane & 7;
    f32x4 wv[8];
#pragma unroll
    for (int i = 0; i < 8; ++i) wv[i] = *(const GAS f32x4*)(W + (size_t)(k0 + 8 * i + r) * N + n0 + 4 * q);
    f32x4 pc = {0.f, 0.f, 0.f, 0.f}, pb = {0.f, 0.f, 0.f, 0.f};
#pragma unroll
    for (int i = 0; i < 8; ++i) { const int kk = 8 * i + r; const f32x4 w = wv[i] * sc; f32x4 v = w; if (ks) v = v * ks[k0 + kk];
        LAS float* d = scr + kk * 33 + 4 * q; d[0] = v[0]; d[1] = v[1]; d[2] = v[2]; d[3] = v[3];
        if (csp) { pc += v; pb += w * bln[k0 + kk]; } }
    if (csp) {
#pragma unroll
        for (int e = 0; e < 4; ++e) { float a = pc[e], bb = pb[e];
            a += __shfl_xor(a, 8); a += __shfl_xor(a, 16); a += __shfl_xor(a, 32); bb += __shfl_xor(bb, 8); bb += __shfl_xor(bb, 16); bb += __shfl_xor(bb, 32);
            if (lane < 8) { fx_add(csp + drow0 + 4 * lane + e, a); fx_add(b2p + drow0 + 4 * lane + e, bb); } } }
    LDS_WAIT(); asm volatile("" ::: "memory");
    const int c = lane & 7;
#pragma unroll
    for (int j = 0; j < 4; ++j) { const int n = (lane >> 3) + 8 * j; const LAS float* s = scr + (8 * c) * 33 + n;
        v4u o;
        if (f16) {
            const unsigned w0 = WQ(pkbf(s[0 * 33], s[1 * 33])), w1 = WQ(pkbf(s[2 * 33], s[3 * 33])), w2 = WQ(pkbf(s[4 * 33], s[5 * 33])), w3 = WQ(pkbf(s[6 * 33], s[7 * 33]));
            o.x = pkh(bflo(w0), bfhi(w0)); o.y = pkh(bflo(w1), bfhi(w1)); o.z = pkh(bflo(w2), bfhi(w2)); o.w = pkh(bflo(w3), bfhi(w3)); }
        else { o.x = WQ(pkbf(s[0 * 33], s[1 * 33])); o.y = WQ(pkbf(s[2 * 33], s[3 * 33])); o.z = WQ(pkbf(s[4 * 33], s[5 * 33])); o.w = WQ(pkbf(s[6 * 33], s[7 * 33])); }
        *(GAS v4u*)(WT + (size_t)(drow0 + n) * K + k0 + 8 * c) = o; }
    LDS_WAIT(); asm volatile("" ::: "memory");
}
__device__ __forceinline__ int rowmap_mla_in(int nb) { return nb < 64 ? 32 * nb : (nb == 64 ? 2048 : 2048 + 128); }
__device__ __forceinline__ int rowmap_uq(int nb) { const int head = nb / 6, w = nb % 6; return w < 4 ? head * 128 + 32 * w : 2048 + (head >> 2) * 256 + (w == 5 ? 128 : 0) + (head & 3) * 32; }

__device__ __forceinline__ void convert_matrix(const Frame& F, const float* W, int K, int N, bf16* WT, int mode, float sc, const float* ks, const float* bln, fx64* csb, LAS float* scr, int& rot) {
    PHASE_TID(tid, lane); (void)tid;
    const int nblk = N / 32, nitems = (K / 64) * nblk;
    const bool f16 = (mode == 1 || mode == 2 || mode == 4);
    const int it0 = (gw - rot) & (NGW - 1); rot = (rot + nitems) & (NGW - 1);
    for (int it = it0; it < nitems; it += NGW) {
        const int kb = it / nblk, nb = it % nblk;
        int drow = 32 * nb; float s = sc;
        if (mode == 1) { if (nb >= 64 && nb < 128) s = 0.0625f; }
        else if (mode == 2) drow = rowmap_mla_in(nb);
        else if (mode == 3) drow = rowmap_uq(nb);
        else if (mode == 4) drow = nb < 176 ? (nb >> 2) * 256 + 32 * (nb & 3) : ((nb - 176) >> 2) * 256 + 128 + 32 * ((nb - 176) & 3);
        tr_item(W, K, N, WT, 64 * kb, 32 * nb, drow, s, ks, bln, csb, csb + 16384, f16, scr, lane);
    }
}

__device__ __forceinline__ void csb2_finalize(const Frame& F, const fx64* src, float* dst, int n) {
    PHASE_TID(tid, lane); (void)tid;
    for (int i = gw * 64 + lane; i < n; i += NGW * 64) dst[i] = fx_load(src + i);
}

__device__ __forceinline__ void ln_pass(const Frame& F, float* Y, bf16* XB, float* stats, const float* __restrict__ g, const float* __restrict__ b, bool final) {
    PHASE_TID(tid, lane); (void)tid;
    for (int m = gw; m < T; m += NGW) {
        GAS f32x4* xr = (GAS f32x4*)(Y + (size_t)m * DM) + lane;
        f32x4 v[8]; float s = 0.f;
#pragma unroll
        for (int j = 0; j < 8; ++j) { v[j] = xr[64 * j]; s += (v[j].x + v[j].y) + (v[j].z + v[j].w); }
        const float mean = wave_sum(s) * (1.f / DM); float s2 = 0.f;
#pragma unroll
        for (int j = 0; j < 8; ++j) { v[j] = v[j] - mean; s2 += (v[j].x * v[j].x + v[j].y * v[j].y) + (v[j].z * v[j].z + v[j].w * v[j].w); }
        const float rstd = 1.0f / sqrtf(wave_sum(s2) * (1.f / DM) + 1e-5f);
        GAS v2u* o8 = (GAS v2u*)(XB + (size_t)m * DM) + lane;
        if (!final && lane == 0) { stats[2 * m] = mean; stats[2 * m + 1] = rstd; }
#pragma unroll
        for (int j = 0; j < 8; ++j) { const f32x4 gg = *((const f32x4*)g + 64 * j + lane), bb = *((const f32x4*)b + 64 * j + lane);
            const f32x4 y = v[j] * rstd * gg + bb;
            if (final) xr[64 * j] = y; else { v2u w; w.x = pkbf(y.x, y.y); w.y = pkbf(y.z, y.w); o8[64 * j] = w; } }
    }
}

__device__ __forceinline__ void gate_pass(const Frame& F, const bf16* O, const bf16* OB, bf16* G, bf16* D) {
    PHASE_TID(tid, lane); (void)tid;
    for (int m = gw; m < T; m += NGW) {
        const GAS v4u* orow = (const GAS v4u*)(O + (size_t)m * 4096) + lane; const GAS v4u* brow = (const GAS v4u*)(OB + (size_t)m * 4096) + lane; GAS v4u* grow = (GAS v4u*)(G + (size_t)m * 4096) + lane; GAS v4u* drow = (GAS v4u*)(D + (size_t)m * 4096) + lane;
#pragma unroll
        for (int hp = 0; hp < 8; hp += 4) {
            v4u ov[4], bv[4], gv[4];
#pragma unroll
            for (int h = 0; h < 4; ++h) { ov[h] = orow[64 * (hp + h)]; bv[h] = brow[64 * (hp + h)]; gv[h] = grow[64 * (hp + h)]; }
#pragma unroll
            for (int h = 0; h < 4; ++h) {
                float x[8]; x[0] = bflo(ov[h].x) + bflo(bv[h].x); x[1] = bfhi(ov[h].x) + bfhi(bv[h].x); x[2] = bflo(ov[h].y) + bflo(bv[h].y); x[3] = bfhi(ov[h].y) + bfhi(bv[h].y);
                x[4] = bflo(ov[h].z) + bflo(bv[h].z); x[5] = bfhi(ov[h].z) + bfhi(bv[h].z); x[6] = bflo(ov[h].w) + bflo(bv[h].w); x[7] = bfhi(ov[h].w) + bfhi(bv[h].w);
                float gt[8]; gt[0] = bflo(gv[h].x); gt[1] = bfhi(gv[h].x); gt[2] = bflo(gv[h].y); gt[3] = bfhi(gv[h].y); gt[4] = bflo(gv[h].z); gt[5] = bfhi(gv[h].z); gt[6] = bflo(gv[h].w); gt[7] = bfhi(gv[h].w);
                float s = 0.f;
#pragma unroll
                for (int e = 0; e < 8; ++e) s += x[e];
                const float mean = wave_sum(s) * (1.f / 512.f); float s2 = 0.f;
#pragma unroll
                for (int e = 0; e < 8; ++e) { x[e] -= mean; s2 += x[e] * x[e]; }
                const float rstd = __builtin_amdgcn_rsqf(wave_sum(s2) * (1.f / 512.f) + 1e-6f);
                float y[8];
#pragma unroll
                for (int e = 0; e < 8; ++e) { const float sg = gt[e] * __builtin_amdgcn_rcpf(1.0f + __expf(-gt[e])); y[e] = sg * x[e] * rstd; }
                v4u w; w.x = pkbf(y[0], y[1]); w.y = pkbf(y[2], y[3]); w.z = pkbf(y[4], y[5]); w.w = pkbf(y[6], y[7]);
                drow[64 * (hp + h)] = w;
            }
        }
    }
}

__device__ __forceinline__ void conv_pass(const Frame& F, bf16* U, const bf16* G, const float* __restrict__ cw, const float* __restrict__ cb) {
    PHASE_TID(tid, lane); (void)tid;
    constexpr int NCB = FFN / 512, NTB = T / 32;
    for (int it = gw; it < NCB * NTB; it += NGW) {
        const int cbk = it % NCB, tb = it / NCB; const int c0 = cbk * 512 + lane * 8, t0 = tb * 32;
        float w0[8], w1[8], w2[8], bb[8];
#pragma unroll
        for (int e = 0; e < 8; ++e) { w0[e] = cw[c0 + e]; w1[e] = cw[FFN + c0 + e]; w2[e] = cw[2 * FFN + c0 + e]; bb[e] = cb[c0 + e]; }
        const int p0 = seq_pos(t0), L = t0 < TP ? 8192 : 2048;
        const GAS v4u* gp = (const GAS v4u*)(G + (size_t)t0 * FFN + c0); GAS v4u* up = (GAS v4u*)(U + (size_t)t0 * FFN + c0);
        constexpr int RS = FFN / 8;
        const float fprev = p0 > 0 ? 1.f : 0.f;
        v4u prev = gp[p0 > 0 ? -RS : 0], cur = gp[0];
#pragma unroll 4
        for (int t = 0; t < 32; ++t) {
            const bool has_n = (p0 + t + 1 < L); const float fnext = has_n ? 1.f : 0.f; const float fp = (t == 0) ? fprev : 1.f;
            const v4u nxt = gp[(size_t)(has_n ? t + 1 : t) * RS]; const v4u uu = up[(size_t)t * RS];
            float a[8], c[8], n[8], u8[8], y[8];
            a[0] = bflo(prev.x); a[1] = bfhi(prev.x); a[2] = bflo(prev.y); a[3] = bfhi(prev.y); a[4] = bflo(prev.z); a[5] = bfhi(prev.z); a[6] = bflo(prev.w); a[7] = bfhi(prev.w);
            c[0] = bflo(cur.x); c[1] = bfhi(cur.x); c[2] = bflo(cur.y); c[3] = bfhi(cur.y); c[4] = bflo(cur.z); c[5] = bfhi(cur.z); c[6] = bflo(cur.w); c[7] = bfhi(cur.w);
            n[0] = bflo(nxt.x); n[1] = bfhi(nxt.x); n[2] = bflo(nxt.y); n[3] = bfhi(nxt.y); n[4] = bflo(nxt.z); n[5] = bfhi(nxt.z); n[6] = bflo(nxt.w); n[7] = bfhi(nxt.w);
            u8[0] = bflo(uu.x); u8[1] = bfhi(uu.x); u8[2] = bflo(uu.y); u8[3] = bfhi(uu.y); u8[4] = bflo(uu.z); u8[5] = bfhi(uu.z); u8[6] = bflo(uu.w); u8[7] = bfhi(uu.w);
#pragma unroll
            for (int e = 0; e < 8; ++e) { const float gcv = fp * a[e] * w0[e] + c[e] * w1[e] + fnext * n[e] * w2[e] + bb[e]; y[e] = gcv * __builtin_amdgcn_rcpf(1.0f + __expf(-gcv)) * u8[e]; }
            v4u w; w.x = pkbf(y[0], y[1]); w.y = pkbf(y[2], y[3]); w.z = pkbf(y[4], y[5]); w.w = pkbf(y[6], y[7]);
            up[(size_t)t * RS] = w; prev = cur; cur = nxt;
        }
    }
}


__device__ __forceinline__ void ffn_fixup(const Frame& F, bf16* A, const bf16* EG, const bf16* EU, const float* __restrict__ cw, const float* __restrict__ cb) {
    PHASE_TID(tid, lane); (void)tid;
    constexpr int NCB = FFN / 512, NER = (T / 64) * 2;
    for (int it = gw; it < NCB * NER; it += NGW) {
        const int cbk = it % NCB, er = it / NCB, blk = er >> 1, last = er & 1; const int c0 = cbk * 512 + lane * 8;
        const int r = blk * 64 + (last ? 63 : 0); const int pos = seq_pos(r), L = r < TP ? 8192 : 2048;
        const bool hasp = pos > 0, hasn = pos < L - 1;
        const size_t ip = last ? (size_t)blk * 4 + 2 : (hasp ? (size_t)(blk - 1) * 4 + 3 : (size_t)blk * 4);
        const size_t ic = last ? (size_t)blk * 4 + 3 : (size_t)blk * 4;
        const size_t in = last ? (hasn ? (size_t)(blk + 1) * 4 : (size_t)blk * 4 + 3) : (size_t)blk * 4 + 1;
        const float fp = (last || hasp) ? 1.f : 0.f, fn = (!last || hasn) ? 1.f : 0.f;
        const v4u gp = *(const GAS v4u*)(EG + ip * FFN + c0), gc = *(const GAS v4u*)(EG + ic * FFN + c0), gn = *(const GAS v4u*)(EG + in * FFN + c0);
        const v4u uu = *(const GAS v4u*)(EU + ((size_t)blk * 2 + last) * FFN + c0);
        float a[8], c[8], n[8], u8[8], y[8];
        a[0] = bflo(gp.x); a[1] = bfhi(gp.x); a[2] = bflo(gp.y); a[3] = bfhi(gp.y); a[4] = bflo(gp.z); a[5] = bfhi(gp.z); a[6] = bflo(gp.w); a[7] = bfhi(gp.w);
        c[0] = bflo(gc.x); c[1] = bfhi(gc.x); c[2] = bflo(gc.y); c[3] = bfhi(gc.y); c[4] = bflo(gc.z); c[5] = bfhi(gc.z); c[6] = bflo(gc.w); c[7] = bfhi(gc.w);
        n[0] = bflo(gn.x); n[1] = bfhi(gn.x); n[2] = bflo(gn.y); n[3] = bfhi(gn.y); n[4] = bflo(gn.z); n[5] = bfhi(gn.z); n[6] = bflo(gn.w); n[7] = bfhi(gn.w);
        u8[0] = bflo(uu.x); u8[1] = bfhi(uu.x); u8[2] = bflo(uu.y); u8[3] = bfhi(uu.y); u8[4] = bflo(uu.z); u8[5] = bfhi(uu.z); u8[6] = bflo(uu.w); u8[7] = bfhi(uu.w);
#pragma unroll
        for (int e = 0; e < 8; ++e) { const float gcv = fp * a[e] * cw[c0 + e] + c[e] * cw[FFN + c0 + e] + fn * n[e] * cw[2 * FFN + c0 + e] + cb[c0 + e]; y[e] = gcv * __builtin_amdgcn_rcpf(1.0f + __expf(-gcv)) * u8[e]; }
        v4u w; w.x = pkbf(y[0], y[1]); w.y = pkbf(y[2], y[3]); w.z = pkbf(y[4], y[5]); w.w = pkbf(y[6], y[7]);
        *(GAS v4u*)(A + (size_t)r * FFN + c0) = w;
    }
}

__device__ __forceinline__ float log2_sigmoid(float x) { return (float)(-log1p(exp(-(double)x)) * 1.4426950408889634); }
__device__ __forceinline__ void prologue(const Frame& F, const float* xp, const float* xs, float* X, bf16* XB, float* cosR, float* sinR, float* cosM, float* sinM, const float* dfw, const float* dbw, float* lgtab) {
    PHASE_TID(tid, lane); (void)tid;
    if (gw == 0 && lane < 32) { const int jl = lane >> 4, head = (lane >> 1) & 7; lgtab[lane] = log2_sigmoid((lane & 1) ? dbw[jl * 8 + head] : dfw[jl * 8 + head]); }
    const int gt = gw * 64 + lane, NGT = NGW * 64;
    auto tables = [&]() {
        for (int i = gt; i < 8192 * 128; i += NGT) { const int pos = i >> 7, d = i & 127;
            const float e = (float)d * (2.0f / 256.0f); const float inv = 1.0f / powf(10000.0f, e); const float ang = (float)pos * inv;
            cosR[i] = cosf(ang); sinR[i] = sinf(ang); }
        for (int i = gt; i < 8192 * 32; i += NGT) { const int pos = i >> 5, d = i & 31;
            const float e = (float)d * (2.0f / 64.0f); const float inv = 1.0f / powf(10000.0f, e); const float ang = (float)pos * inv;
            cosM[i] = cosf(ang); sinM[i] = sinf(ang); } };
    auto copy = [&]() {
        for (int m = gw; m < T; m += NGW) {
            const GAS f32x4* src = (const GAS f32x4*)((m < TP ? xp + (size_t)m * DM : xs + (size_t)(m - TP) * DM)) + lane;
            GAS v2u* o8 = (GAS v2u*)(XB + (size_t)m * DM) + lane;
#pragma unroll
            for (int j = 0; j < 8; ++j) { const f32x4 v = src[64 * j]; v2u w; w.x = SQ(pkh(v.x, v.y)); w.y = SQ(pkh(v.z, v.w)); o8[64 * j] = w; }
        } };
    if (F.wave & 1) { copy(); tables(); } else { tables(); copy(); }
}

#ifndef RETD
#define RETD 0
#endif
namespace ret {
constexpr int C = 64, W = 128, LQ = 264, LV = 136, LP = 72;
constexpr int OFF_Q = 0, OFF_K = 33792, OFF_V = 67584, OFF_VZ = 84992, OFF_P = 102400, OFF_OS = 111616, LDS_END = 129024;
static_assert(LDS_END <= RING_BYTES, "retention LDS");
typedef float f4 __attribute__((ext_vector_type(4)));
typedef float f2v __attribute__((ext_vector_type(2)));
typedef __bf16 b2v __attribute__((ext_vector_type(2)));
__device__ __forceinline__ unsigned pkbf_c(float lo, float hi) { const f2v v = {lo, hi}; return __builtin_bit_cast(unsigned, __builtin_convertvector(v, b2v)); }

__device__ __forceinline__ bf16x8 frag_rm(const LAS unsigned char* lds, int off, int ld, int r0, int k0, int lane) {
    return *(const LAS bf16x8*)(lds + off + ((r0 + (lane & 15)) * ld + k0 + 8 * (lane >> 4)) * 2);
}
template <int LDB, int K0, int R0> __device__ __forceinline__ void frag_tr_issue(s16x4& lo, s16x4& hi, unsigned base) {
    asm volatile("ds_read_b64_tr_b16 %0, %1 offset:%2" : "=&v"(lo) : "v"(base), "i"(K0 * LDB + R0 * 2) : "memory");
    asm volatile("ds_read_b64_tr_b16 %0, %1 offset:%2" : "=&v"(hi) : "v"(base), "i"(K0 * LDB + R0 * 2 + 4 * LDB) : "memory");
}
#define RET_PK(L, H) (bf16x8){L[0], L[1], L[2], L[3], H[0], H[1], H[2], H[3]}
#define MFMA16(a, b, c) __builtin_amdgcn_mfma_f32_16x16x32_bf16(a, b, c, 0, 0, 0)
#define RET_LWAIT() asm volatile("s_waitcnt lgkmcnt(0)" ::: "memory")

struct Stg { v4u q[4], k[4], v[2]; };

template <bool FWD>
__device__ __forceinline__ void sweep(const Frame& F, const bf16* Qg, const bf16* Kg, const bf16* Vg, bf16* Og, int nchunks, float lgf, float lgb) {
    LAS unsigned char* lds = F.lds + RING_OFF;
    int tid_l = threadIdx.x; asm volatile("" : "+v"(tid_l));
    const int tid = tid_l, lane = tid & 63, wid = __builtin_amdgcn_readfirstlane(tid >> 6), g = lane >> 4, i = lane & 15;
    const int nb = wid >> 1, cb = wid & 1;
    const int dvw = 16 * wid;
    const float lg = FWD ? lgf : lgb;
    const float gch = __builtin_amdgcn_exp2f(lg * (float)C);
    const int vrow = tid >> 4, vch = tid & 15;
    const float zeta0 = __builtin_amdgcn_exp2f(lg * (FWD ? (float)(C - 1 - vrow) : (float)vrow));
    const float zeta1 = __builtin_amdgcn_exp2f(lg * (FWD ? (float)(C - 1 - 32 - vrow) : (float)(32 + vrow)));
    const unsigned ldsb = (unsigned)(uintptr_t)lds;
    const unsigned trK = ldsb + OFF_K + (unsigned)((8 * g + (i >> 2)) * (LQ * 2) + 8 * (i & 3));
    const unsigned trVZ = ldsb + OFF_VZ + (unsigned)((8 * g + (i >> 2)) * (LV * 2) + (dvw + 4 * (i & 3)) * 2);
    const unsigned trV = ldsb + OFF_V + (unsigned)((8 * g + (i >> 2)) * (LV * 2) + (dvw + 4 * (i & 3)) * 2);
    f4 S[16];
#pragma unroll
    for (int t = 0; t < 16; ++t) S[t] = (f4){0.f, 0.f, 0.f, 0.f};
    Stg st;
    const unsigned voffQ = (unsigned)((tid >> 5) * 4096 + (tid & 31) * 16), voffV = (unsigned)(vrow * 8192 + vch * 16);
#define RET_LOAD(j) do { const GAS unsigned char* qb_ = (const GAS unsigned char*)Qg + (size_t)(j) * (C * 4096); const GAS unsigned char* kb_ = (const GAS unsigned char*)Kg + (size_t)(j) * (C * 4096); \
        const GAS unsigned char* vb_ = (const GAS unsigned char*)Vg + (size_t)(j) * (C * 8192); \
        _Pragma("unroll") for (int a = 0; a < 4; ++a) { st.q[a] = *(const GAS v4u*)(qb_ + a * 65536 + voffQ); st.k[a] = *(const GAS v4u*)(kb_ + a * 65536 + voffQ); } \
        st.v[0] = *(const GAS v4u*)(vb_ + voffV); st.v[1] = *(const GAS v4u*)(vb_ + 262144 + voffV); } while (0)
#define RET_FLUSH(jj) do { GAS unsigned char* ob_ = (GAS unsigned char*)Og + (size_t)(jj) * (C * 8192); \
        _Pragma("unroll") for (int a = 0; a < 2; ++a) { const v4u w = *(const LAS v4u*)(lds + OFF_OS + ((vrow + 32 * a) * LV + vch * 8) * 2); \
        *(GAS v4u*)(ob_ + a * 262144 + voffV) = w; } } while (0)
    const int j0 = FWD ? 0 : nchunks - 1, dj = FWD ? 1 : -1;
    __syncthreads();
    RET_LOAD(j0);
    for (int s = 0; s < nchunks; ++s) {
        const int j = j0 + dj * s;
        const bool do_intra = FWD ? ((j & 1) == 0) : ((j & 1) == 1);
        __syncthreads();
#pragma unroll
        for (int a = 0; a < 4; ++a) { const int id = tid + 512 * a, row = id >> 5, ch = id & 31;
            *(LAS v4u*)(lds + OFF_Q + (row * LQ + ch * 8) * 2) = st.q[a]; *(LAS v4u*)(lds + OFF_K + (row * LQ + ch * 8) * 2) = st.k[a]; }
#pragma unroll
        for (int a = 0; a < 2; ++a) { const float zt = a ? zeta1 : zeta0; const v4u vv = st.v[a]; const int row = 32 * a + vrow;
            if (do_intra) *(LAS v4u*)(lds + OFF_V + (row * LV + vch * 8) * 2) = vv;
            v4u z; z.x = pkbf(bflo(vv.x) * zt, bfhi(vv.x) * zt); z.y = pkbf(bflo(vv.y) * zt, bfhi(vv.y) * zt);
            z.z = pkbf(bflo(vv.z) * zt, bfhi(vv.z) * zt); z.w = pkbf(bflo(vv.w) * zt, bfhi(vv.w) * zt);
            *(LAS v4u*)(lds + OFF_VZ + (row * LV + vch * 8) * 2) = z; }
        if (s > 0) RET_FLUSH(j - dj);
        __syncthreads();
        f4 o[4];
#pragma unroll
        for (int nt = 0; nt < 4; ++nt) o[nt] = (f4){0.f, 0.f, 0.f, 0.f};
#pragma unroll
        for (int s2 = 0; s2 < 8; ++s2) {
            v4u bw; bw.x = pkbf_c(S[2 * s2][0], S[2 * s2][1]); bw.y = pkbf_c(S[2 * s2][2], S[2 * s2][3]); bw.z = pkbf_c(S[2 * s2 + 1][0], S[2 * s2 + 1][1]); bw.w = pkbf_c(S[2 * s2 + 1][2], S[2 * s2 + 1][3]);
            const bf16x8 bfr = __builtin_bit_cast(bf16x8, bw);
#pragma unroll
            for (int nt = 0; nt < 4; ++nt) {
                const LAS unsigned char* qp = lds + OFF_Q + ((16 * nt + i) * LQ + 32 * s2 + 4 * g) * 2;
                const v2u a0 = *(const LAS v2u*)qp, a1 = *(const LAS v2u*)(qp + 32);
                v4u aw; aw.x = a0.x; aw.y = a0.y; aw.z = a1.x; aw.w = a1.y;
                if (!(RETD & 1)) o[nt] = MFMA16(__builtin_bit_cast(bf16x8, aw), bfr, o[nt]);
            }
        }
#pragma unroll
        for (int nt = 0; nt < 4; ++nt)
#pragma unroll
            for (int r = 0; r < 4; ++r) { const int n = 16 * nt + 4 * g + r; o[nt][r] *= __builtin_amdgcn_exp2f(lg * (FWD ? (float)(n + 1) : (float)(C - n))); }
        if (s + 1 < nchunks) RET_LOAD(j + dj);
        if (do_intra && !(RETD & 4)) {
            f4 s0 = {0.f, 0.f, 0.f, 0.f}, s1 = {0.f, 0.f, 0.f, 0.f};
#pragma unroll
            for (int ks = 0; ks < 8; ++ks) {
                const bf16x8 a = frag_rm(lds, OFF_Q, LQ, 16 * nb, 32 * ks, lane);
                const bf16x8 b0 = frag_rm(lds, OFF_K, LQ, 32 * cb, 32 * ks, lane), b1 = frag_rm(lds, OFF_K, LQ, 32 * cb + 16, 32 * ks, lane);
                s0 = MFMA16(a, b0, s0); s1 = MFMA16(a, b1, s1);
            }
#pragma unroll
            for (int r = 0; r < 4; ++r) { const int n = 16 * nb + 4 * g + r;
                const int m0 = 32 * cb + i, m1 = m0 + 16;
                const float d0 = (m0 <= n) ? __builtin_amdgcn_exp2f(lgf * (float)(n - m0)) : __builtin_amdgcn_exp2f(lgb * (float)(m0 - n));
                const float d1 = (m1 <= n) ? __builtin_amdgcn_exp2f(lgf * (float)(n - m1)) : __builtin_amdgcn_exp2f(lgb * (float)(m1 - n));
                const float p0v = (RETD & 32) ? (float)(n + 1) * 0.01f + (float)m0 * 0.001f : s0[r] * d0, p1v = (RETD & 32) ? (float)(n + 1) * 0.01f + (float)m1 * 0.001f : s1[r] * d1;
                *(LAS unsigned short*)(lds + OFF_P + (n * LP + m0) * 2) = (unsigned short)(pkbf(p0v, 0.f) & 0xffffu);
                *(LAS unsigned short*)(lds + OFF_P + (n * LP + m1) * 2) = (unsigned short)(pkbf(p1v, 0.f) & 0xffffu); }
        }
#pragma unroll
        for (int t = 0; t < 16; ++t) S[t] = S[t] * gch;
        {
            s16x4 bl[2], bh[2], al[2][4], ah[2][4];
            RET_LWAIT(); SBAR();
            frag_tr_issue<LV * 2, 0, 0>(bl[0], bh[0], trVZ);
#define RET_ISSUE_K(BUF, Q1) do { constexpr int ks1_ = (Q1) >> 2, t0_ = 4 * ((Q1) & 3); \
                frag_tr_issue<LQ * 2, 32 * ks1_, 16 * (t0_ + 0)>(al[BUF][0], ah[BUF][0], trK); frag_tr_issue<LQ * 2, 32 * ks1_, 16 * (t0_ + 1)>(al[BUF][1], ah[BUF][1], trK); \
                frag_tr_issue<LQ * 2, 32 * ks1_, 16 * (t0_ + 2)>(al[BUF][2], ah[BUF][2], trK); frag_tr_issue<LQ * 2, 32 * ks1_, 16 * (t0_ + 3)>(al[BUF][3], ah[BUF][3], trK); } while (0)
#define RET_GROUP(Q) do { constexpr int cur_ = (Q) & 1, ks_ = (Q) >> 2; \
                RET_LWAIT(); SBAR(); \
                if constexpr ((Q) + 1 == 4) frag_tr_issue<LV * 2, 32, 0>(bl[1], bh[1], trVZ); \
                if constexpr ((Q) < 7) RET_ISSUE_K(cur_ ^ 1, (Q) + 1); \
                { const bf16x8 b_ = RET_PK(bl[ks_], bh[ks_]); \
                  _Pragma("unroll") for (int t = 0; t < 4; ++t) if (!(RETD & 2)) S[4 * ((Q) & 3) + t] = MFMA16(RET_PK(al[cur_][t], ah[cur_][t]), b_, S[4 * ((Q) & 3) + t]); } \
                SBAR(); } while (0)
            RET_ISSUE_K(0, 0);
            RET_GROUP(0); RET_GROUP(1); RET_GROUP(2); RET_GROUP(3); RET_GROUP(4); RET_GROUP(5); RET_GROUP(6); RET_GROUP(7);
#undef RET_GROUP
#undef RET_ISSUE_K
        }
        __syncthreads();
        if (do_intra && !(RETD & 4)) {
#pragma unroll
            for (int ks = 0; ks < 2; ++ks) {
                s16x4 l0, h0;
                RET_LWAIT();
                if (ks == 0) frag_tr_issue<LV * 2, 0, 0>(l0, h0, trV); else frag_tr_issue<LV * 2, 32, 0>(l0, h0, trV);
                bf16x8 a[4];
#pragma unroll
                for (int nt = 0; nt < 4; ++nt) a[nt] = frag_rm(lds, OFF_P, LP, 16 * nt, 32 * ks, lane);
                RET_LWAIT(); SBAR();
                bf16x8 b = RET_PK(l0, h0);
                if (RETD & 8) { const short one = 0x3f80; b = (bf16x8){one, one, one, one, one, one, one, one}; }
#pragma unroll
                for (int nt = 0; nt < 4; ++nt) { bf16x8 aa = a[nt]; if (RETD & 16) { const short one = 0x3f80; aa = (bf16x8){one, one, one, one, one, one, one, one}; } o[nt] = MFMA16(aa, b, o[nt]); }
            }
        }
#pragma unroll
        for (int nt = 0; nt < 4; ++nt)
#pragma unroll
            for (int r = 0; r < 4; ++r) *(LAS unsigned short*)(lds + OFF_OS + ((16 * nt + 4 * g + r) * LV + dvw + i) * 2) = (unsigned short)(pkbf_c(o[nt][r], 0.f) & 0xffffu);
    }
    __syncthreads();
    RET_FLUSH(j0 + dj * (nchunks - 1));
#undef RET_LOAD
#undef RET_FLUSH
}

__device__ __forceinline__ void unit(const Frame& F, const bf16* Q, const bf16* K, const bf16* V, bf16* O, bf16* OB, int t0, int S, int u, const float* lgtab) {
    const int dir = u & 1, slice = (u >> 1) & 3, head = (u >> 3) & 7;
    const float lgf = __hip_atomic_load(lgtab + 2 * head, __ATOMIC_RELAXED, __HIP_MEMORY_SCOPE_AGENT), lgb = __hip_atomic_load(lgtab + 2 * head + 1, __ATOMIC_RELAXED, __HIP_MEMORY_SCOPE_AGENT);
    const bf16* Qg = Q + (size_t)t0 * 2048 + head * 256; const bf16* Kg = K + (size_t)t0 * 2048 + head * 256;
    const size_t voff = (size_t)t0 * 4096 + head * 512 + slice * W;
    if (dir == 0) sweep<true>(F, Qg, Kg, V + voff, O + voff, S / C, lgf, lgb);
    else          sweep<false>(F, Qg, Kg, V + voff, OB + voff, S / C, lgf, lgb);
}

__device__ __forceinline__ void phase(const Frame& F, const bf16* Q, const bf16* K, const bf16* V, bf16* O, bf16* OB, const float* lgtab) {
    int vcu = F.vcu; asm volatile("" : "+s"(vcu));
    if (vcu < 128) {
        unit(F, Q, K, V, O, OB, (vcu >> 6) * 8192, 8192, vcu & 63, lgtab);
    } else {
        for (int k = 0; k < 4; ++k) { const int u = (vcu - 128) * 4 + k; unit(F, Q, K, V, O, OB, TP + (u >> 6) * 2048, 2048, u & 63, lgtab); }
    }
}
}

#ifndef ATT_EARLY
#define ATT_EARLY 0
#endif
#ifndef ATT_VLATE
#define ATT_VLATE 0
#endif
#ifndef ATT_NPARK
#define ATT_NPARK 8
#endif
namespace att {
constexpr int NW = 8, QBLK = 32, KVBLK = 64, LDQ = 3072, LDKV = 4096, LDKR = 64, LDO = 2048;
constexpr int SHM_V = 16384, SHM_K = 24576, OFF_K = 2 * SHM_V, OFF_WS = OFF_K + 2 * SHM_K, NPARK = ATT_NPARK, OFF_QR = OFF_WS + NW * 64 * 4, SHM_ATTN = OFF_QR + NW * NPARK * 1024;
static_assert(SHM_ATTN <= RING_BYTES, "attention LDS");
constexpr float THR2 = 11.0f;
#define AKSWZ(row, colB) ((row) * 384 + ((colB) ^ (((row) & 7) << 4)))
__device__ __forceinline__ int crow(int r, int hi) { return (r & 3) + 8 * (r >> 2) + 4 * hi; }
__device__ __forceinline__ unsigned cvtpk(float lo, float hi) { unsigned r; asm volatile("v_cvt_pk_bf16_f32 %0, %1, %2" : "=v"(r) : "v"(lo), "v"(hi)); return r; }

__device__ __forceinline__ void partialSM(f32x16& p0, f32x16& p1, float& m_reg, float& mn, float& alpha) {
  float pmax = p0[0];
#pragma unroll
  for (int r = 1; r < 16; ++r) pmax = fmaxf(pmax, p0[r]);
#pragma unroll
  for (int r = 0; r < 16; ++r) pmax = fmaxf(pmax, p1[r]);
  { auto rr = __builtin_amdgcn_permlane32_swap(__float_as_uint(pmax), __float_as_uint(pmax), false, false);
    pmax = fmaxf(__uint_as_float(rr[0]), __uint_as_float(rr[1])); }
  if (__builtin_expect(__all(pmax - m_reg <= THR2), 1)) { mn = m_reg; alpha = 1.f; }
  else { mn = fmaxf(m_reg, pmax); alpha = __builtin_amdgcn_exp2f(m_reg - mn); m_reg = mn; }
#pragma unroll
  for (int r = 0; r < 16; ++r) p0[r] = p0[r] - mn;
#pragma unroll
  for (int r = 0; r < 16; ++r) p1[r] = p1[r] - mn;
#pragma unroll
  for (int r = 0; r < 16; ++r) p0[r] = __builtin_amdgcn_exp2f(p0[r]);
}
__device__ __forceinline__ void finishSM(f32x16& p0, f32x16& p1, float alpha, float& l_reg, bf16x8& pa0, bf16x8& pa1, bf16x8& pa2, bf16x8& pa3) {
#pragma unroll
  for (int r = 0; r < 16; ++r) p1[r] = __builtin_amdgcn_exp2f(p1[r]);
  float ps = 0;
#pragma unroll
  for (int r = 0; r < 16; ++r) ps += p0[r];
#pragma unroll
  for (int r = 0; r < 16; ++r) ps += p1[r];
  { auto rr = __builtin_amdgcn_permlane32_swap(__float_as_uint(ps), __float_as_uint(ps), false, false);
    ps = __uint_as_float(rr[0]) + __uint_as_float(rr[1]); }
  l_reg = l_reg * alpha + ps;
#define PK4(P, BASE, OUT) do { unsigned a0 = cvtpk(P[BASE + 0], P[BASE + 1]), a1 = cvtpk(P[BASE + 2], P[BASE + 3]);   \
    unsigned b0 = cvtpk(P[BASE + 4], P[BASE + 5]), b1 = cvtpk(P[BASE + 6], P[BASE + 7]);                              \
    auto r0 = __builtin_amdgcn_permlane32_swap(a0, b0, false, false); auto r1 = __builtin_amdgcn_permlane32_swap(a1, b1, false, false); \
    v4u w = {r0[0], r1[0], r0[1], r1[1]}; OUT = *reinterpret_cast<bf16x8*>(&w); } while (0)
  PK4(p0, 0, pa0); PK4(p0, 8, pa1); PK4(p1, 0, pa2); PK4(p1, 8, pa3);
#undef PK4
}
__device__ __forceinline__ void qkt(f32x16& p0, f32x16& p1, const LAS unsigned char* Ks, const bf16x8* qr, const LAS unsigned char* qrl, int r32, int hi) {
  p0 = f32x16{}; p1 = f32x16{};
#pragma unroll
  for (int d0 = 0; d0 < 12; ++d0) { const int cb = (d0 * 16 + hi * 8) * 2;
    const bf16x8 b0 = *reinterpret_cast<const LAS bf16x8*>(Ks + AKSWZ(r32, cb));
    const bf16x8 b1 = *reinterpret_cast<const LAS bf16x8*>(Ks + AKSWZ(32 + r32, cb));
    const bf16x8 q = d0 < 12 - NPARK ? qr[d0 < 12 - NPARK ? d0 : 0] : *reinterpret_cast<const LAS bf16x8*>(qrl + (d0 - (12 - NPARK)) * 1024);
    p0 = __builtin_amdgcn_mfma_f32_32x32x16_bf16(b0, q, p0, 0, 0, 0);
    p1 = __builtin_amdgcn_mfma_f32_32x32x16_bf16(b1, q, p1, 0, 0, 0); }
}
__device__ __forceinline__ int v_st(int k, int c) { const int kk = (k & ~0xC) | ((k & 4) << 1) | ((k & 8) >> 1); return ((kk >> 3) * 4 + (c >> 5)) * 512 + ((kk & 7) * 32 + (c & 31)) * 2; }
__device__ __forceinline__ int v_rd_base(int lane) { return ((lane & 3) << 3) | (((lane >> 2) & 3) << 6) | (((lane >> 4) & 1) << 5) | (((lane >> 5) & 1) << 8); }
constexpr int v_rd_off(int d0, int ks, int half) { return d0 * 512 + ks * 4096 + half * 2048; }
template <int OFF> __device__ __forceinline__ s16x4 tr_read(int vb) {
  s16x4 r; asm volatile("ds_read_b64_tr_b16 %0, %1 offset:%2" : "=&v"(r) : "v"(vb), "i"(OFF) : "memory"); return r;
}
template <int D0> __device__ __forceinline__ void pv_one(f32x16& od, int vb, bf16x8 pa0, bf16x8 pa1, bf16x8 pa2, bf16x8 pa3) {
  const s16x4 l0 = tr_read<v_rd_off(D0, 0, 0)>(vb), h0 = tr_read<v_rd_off(D0, 0, 1)>(vb), l1 = tr_read<v_rd_off(D0, 1, 0)>(vb), h1 = tr_read<v_rd_off(D0, 1, 1)>(vb);
  const s16x4 l2 = tr_read<v_rd_off(D0, 2, 0)>(vb), h2 = tr_read<v_rd_off(D0, 2, 1)>(vb), l3 = tr_read<v_rd_off(D0, 3, 0)>(vb), h3 = tr_read<v_rd_off(D0, 3, 1)>(vb);
  asm volatile("s_waitcnt lgkmcnt(0)" ::: "memory"); SBAR();
#define APK(L, H) (bf16x8){L[0], L[1], L[2], L[3], H[0], H[1], H[2], H[3]}
  od = __builtin_amdgcn_mfma_f32_32x32x16_bf16(pa0, APK(l0, h0), od, 0, 0, 0);
  od = __builtin_amdgcn_mfma_f32_32x32x16_bf16(pa1, APK(l1, h1), od, 0, 0, 0);
  od = __builtin_amdgcn_mfma_f32_32x32x16_bf16(pa2, APK(l2, h2), od, 0, 0, 0);
  od = __builtin_amdgcn_mfma_f32_32x32x16_bf16(pa3, APK(l3, h3), od, 0, 0, 0);
#undef APK
}
__device__ __forceinline__ void pv_d0(f32x16* o, int vb, bf16x8 pa0, bf16x8 pa1, bf16x8 pa2, bf16x8 pa3) {
  pv_one<0>(o[0], vb, pa0, pa1, pa2, pa3); pv_one<1>(o[1], vb, pa0, pa1, pa2, pa3); pv_one<2>(o[2], vb, pa0, pa1, pa2, pa3); pv_one<3>(o[3], vb, pa0, pa1, pa2, pa3);
}

__device__ __forceinline__ void attn_unit(const bf16* __restrict__ Qb, const bf16* __restrict__ Kn, const bf16* __restrict__ Kr, const bf16* __restrict__ Vh,
                                          bf16* __restrict__ Ob, int seq, LAS unsigned char* lds) {
  int tid_l = threadIdx.x; asm volatile("" : "+v"(tid_l));
  const int tid = tid_l, wid = tid >> 6, lane = tid & 63, r32 = lane & 31, hi = lane >> 5;
  LAS unsigned char* V_lds = lds; LAS unsigned char* K_lds = lds + OFF_K;
  LAS float* ws = (LAS float*)(lds + OFF_WS) + wid * 64; LAS float* li_l = ws; LAS float* al_l = ws + 32;
  float m_reg = -1e30f, l_reg = 0; f32x16 o[4] = {}; bf16x8 qr[12 - NPARK];
  const bf16* Qw = Qb + (size_t)(wid * QBLK + r32) * LDQ + hi * 8;
#pragma unroll
  for (int d0 = 0; d0 < 12 - NPARK; ++d0) qr[d0] = *reinterpret_cast<const bf16x8*>(Qw + d0 * 16);
  LAS unsigned char* qrl = lds + OFF_QR + wid * (NPARK * 1024) + hi * 512 + r32 * 16;
  __syncthreads();
#pragma unroll
  for (int d = 0; d < NPARK; ++d) *reinterpret_cast<LAS bf16x8*>(qrl + d * 1024) = *reinterpret_cast<const bf16x8*>(Qw + (12 - NPARK + d) * 16);
  const int sr = tid >> 4, sc = (tid & 15) * 8, vst0 = v_st(sr, sc), vst1 = v_st(32 + sr, sc);
  const int kr_r = tid >> 3, kr_c = (tid & 7) * 8;
  const int vb0 = (int)(unsigned)(uintptr_t)V_lds + v_rd_base(lane);
  bf16x8 vs0, vs1, ks0, ks1, kq0;
  const unsigned vo0 = (unsigned)(sr * LDKV + sc) * 2u, vo1 = vo0 + 32u * LDKV * 2u, vok = (unsigned)(kr_r * LDKR + kr_c) * 2u;
#define SLOAD_K(k0) do { const GAS unsigned char* kbp = (const GAS unsigned char*)Kn + (size_t)(k0) * (LDKV * 2); \
    const GAS unsigned char* rbp = (const GAS unsigned char*)Kr + (size_t)(k0) * (LDKR * 2); \
    ks0 = *reinterpret_cast<const GAS bf16x8*>(kbp + vo0); ks1 = *reinterpret_cast<const GAS bf16x8*>(kbp + vo1); \
    kq0 = *reinterpret_cast<const GAS bf16x8*>(rbp + vok); } while (0)
#define SLOAD_V(k0) do { const GAS unsigned char* vbp = (const GAS unsigned char*)Vh + (size_t)(k0) * (LDKV * 2); \
    vs0 = *reinterpret_cast<const GAS bf16x8*>(vbp + vo0); vs1 = *reinterpret_cast<const GAS bf16x8*>(vbp + vo1); } while (0)
#define SLOAD(k0) do { SLOAD_K(k0); SLOAD_V(k0); } while (0)
#define SWRITE(b) do { *(LAS bf16x8*)(V_lds + (b) * SHM_V + vst0) = vs0; *(LAS bf16x8*)(V_lds + (b) * SHM_V + vst1) = vs1; const int kc = sc * 2; \
    *(LAS bf16x8*)(K_lds + (b) * SHM_K + AKSWZ(sr, kc)) = ks0; *(LAS bf16x8*)(K_lds + (b) * SHM_K + AKSWZ(32 + sr, kc)) = ks1; \
    *(LAS bf16x8*)(K_lds + (b) * SHM_K + AKSWZ(kr_r, 256 + kr_c * 2)) = kq0; } while (0)
#define SWAIT() asm volatile("s_waitcnt vmcnt(0)" ::: "memory")
#define RESC(a) do { if (__any((a) < 1.f)) { if (hi == 0) al_l[r32] = (a); asm volatile("s_waitcnt lgkmcnt(0)" ::: "memory"); \
    _Pragma("unroll") for (int d = 0; d < 4; ++d) _Pragma("unroll") for (int r = 0; r < 16; ++r) o[d][r] *= al_l[crow(r, hi)]; } } while (0)
  f32x16 pA0, pA1, pB0, pB1; float mnA, mnB, alA, alB; bf16x8 pa0, pa1, pa2, pa3; const int NT = seq / KVBLK;
  SLOAD(0); SWAIT(); SWRITE(0); __syncthreads();
  qkt(pA0, pA1, K_lds, qr, qrl, r32, hi); partialSM(pA0, pA1, m_reg, mnA, alA);
  SLOAD(KVBLK);
  SWAIT(); SWRITE(1); __syncthreads();
  for (int j = 1; j + 1 < NT; j += 2) {
#if ATT_EARLY
    SLOAD((j + 1) * KVBLK);
#endif
    SBAR(); qkt(pB0, pB1, K_lds + SHM_K, qr, qrl, r32, hi);
    finishSM(pA0, pA1, alA, l_reg, pa0, pa1, pa2, pa3); SBAR();
#if ATT_EARLY
    pv_d0(o, vb0, pa0, pa1, pa2, pa3); partialSM(pB0, pB1, m_reg, mnB, alB);
#elif ATT_VLATE
    SLOAD_K((j + 1) * KVBLK); SBAR();
    pv_d0(o, vb0, pa0, pa1, pa2, pa3); SBAR(); SLOAD_V((j + 1) * KVBLK); SBAR(); partialSM(pB0, pB1, m_reg, mnB, alB);
#else
    SLOAD((j + 1) * KVBLK); SBAR();
    pv_d0(o, vb0, pa0, pa1, pa2, pa3); partialSM(pB0, pB1, m_reg, mnB, alB);
#endif
    __syncthreads(); SWAIT(); SWRITE(0);
    RESC(alB); __syncthreads();
#if ATT_EARLY
    SLOAD((j + 2) * KVBLK);
#endif
    SBAR(); qkt(pA0, pA1, K_lds, qr, qrl, r32, hi);
    finishSM(pB0, pB1, alB, l_reg, pa0, pa1, pa2, pa3); SBAR();
#if ATT_EARLY
    pv_d0(o, vb0 + SHM_V, pa0, pa1, pa2, pa3); partialSM(pA0, pA1, m_reg, mnA, alA);
#elif ATT_VLATE
    SLOAD_K((j + 2) * KVBLK); SBAR();
    pv_d0(o, vb0 + SHM_V, pa0, pa1, pa2, pa3); SBAR(); SLOAD_V((j + 2) * KVBLK); SBAR(); partialSM(pA0, pA1, m_reg, mnA, alA);
#else
    SLOAD((j + 2) * KVBLK); SBAR();
    pv_d0(o, vb0 + SHM_V, pa0, pa1, pa2, pa3); partialSM(pA0, pA1, m_reg, mnA, alA);
#endif
    __syncthreads(); SWAIT(); SWRITE(1);
    RESC(alA); __syncthreads();
  }
  SBAR(); qkt(pB0, pB1, K_lds + SHM_K, qr, qrl, r32, hi);
  finishSM(pA0, pA1, alA, l_reg, pa0, pa1, pa2, pa3); SBAR();
  pv_d0(o, vb0, pa0, pa1, pa2, pa3); partialSM(pB0, pB1, m_reg, mnB, alB);
  __syncthreads(); RESC(alB);
  finishSM(pB0, pB1, alB, l_reg, pa0, pa1, pa2, pa3); SBAR();
  pv_d0(o, vb0 + SHM_V, pa0, pa1, pa2, pa3);
  if (hi == 0) li_l[r32] = l_reg; asm volatile("s_waitcnt lgkmcnt(0)" ::: "memory");
  float rli[16];
#pragma unroll
  for (int r = 0; r < 16; ++r) rli[r] = __builtin_amdgcn_rcpf(li_l[crow(r, hi)]);
  __syncthreads();
  LAS unsigned short* stg = (LAS unsigned short*)(lds + wid * 8704);
#pragma unroll
  for (int r = 0; r < 16; ++r) { const int orow = crow(r, hi);
#pragma unroll
    for (int d0 = 0; d0 < 4; ++d0) stg[orow * 136 + d0 * 32 + r32] = (unsigned short)(cvtpk(o[d0][r] * rli[r], 0.f) & 0xffffu); }
  asm volatile("s_waitcnt lgkmcnt(0)" ::: "memory");
  bf16* Ow = Ob + (size_t)(wid * QBLK) * LDO;
#pragma unroll
  for (int i2 = 0; i2 < 8; ++i2) { const int id = i2 * 64 + lane, row = id >> 4, ch = id & 15;
    const v4u w = *(const LAS v4u*)((const LAS unsigned char*)stg + row * 272 + ch * 16);
    *(GAS v4u*)(Ow + (size_t)row * LDO + ch * 8) = w; }
#undef SLOAD
#undef SLOAD_K
#undef SLOAD_V
#undef SWRITE
#undef SWAIT
#undef RESC
}

__device__ __forceinline__ void phase(const Frame& F, const bf16* QA, const bf16* KV, const bf16* KR, bf16* O) {
  LAS unsigned char* lds = F.lds + RING_OFF;
  int vcu = F.vcu; asm volatile("" : "+s"(vcu));
  const int x = vcu >> 5, i = vcu & 31;
  for (int k = 0; k < 8; ++k) {
    int t0, S, head, qb;
    if (k < 4) { const int pair = 4 * x + k; t0 = (pair >> 4) * 8192; head = pair & 15; S = 8192; qb = i; }
    else { const int pair = 16 * x + 4 * (i >> 3) + (k - 4); t0 = TP + (pair >> 4) * 2048; head = pair & 15; S = 2048; qb = i & 7; }
    const bf16* Qb = QA + (size_t)(t0 + qb * 256) * LDQ + head * 192;
    const bf16* Kn = KV + (size_t)t0 * LDKV + head * 256; const bf16* Vh = Kn + 128; const bf16* Kr = KR + (size_t)t0 * LDKR;
    bf16* Ob = O + (size_t)(t0 + qb * 256) * LDO + head * 128;
    attn_unit(Qb, Kn, Kr, Vh, Ob, S, lds);
  }
}
}

#ifndef G_ALIGN
#define G_ALIGN true
#endif
#ifndef G_SP2
#define G_SP2 true
#endif
struct Args { const float* in[20]; float* out; unsigned char* ws; };

__device__ __forceinline__ const float* kin(int i) {
    unsigned long long kp = (unsigned long long)__builtin_amdgcn_kernarg_segment_ptr();
    asm volatile("" : "+s"(kp));
    return ((const float* const __attribute__((address_space(4)))*)kp)[i];
}
#define INP(i) kin(i)
#define WSB ((unsigned char*)kin(21))
#define X ((float*)kin(20))
#define XB ((bf16*)(WSB + WS_XB))
#define cosR ((float*)(WSB + WS_TAB))
#define sinR (cosR + 8192 * 128)
#define cosM (cosR + 2 * 8192 * 128)
#define sinM (cosR + 2 * 8192 * 128 + 8192 * 32)
#define ssq_base ((fx64*)(WSB + WS_CTL + CTL_SSQ))
#define STATS(k) ((fx64*)(WSB + WS_CTL + CTL_STATS) + (size_t)(k) * T * 2)
#define CSB2(k) ((fx64*)(WSB + WS_CTL + CTL_CSB2) + (size_t)(k) * 32768)
#define CSF(k) ((float*)(WSB + WS_CTL + CTL_CSF) + (size_t)(k) * 32768)
#define LGTAB ((float*)(WSB + WS_CTL + CTL_LGTAB))
#define wsW (WSB + WS_W)
#define wsA (WSB + WS_ACT)

__device__ __forceinline__ void convert_layer(const Frame& F, int layer, LAS float* scr, int rot) {
    const int j = layer >> 1; const int lp = layer > 0 ? layer - 1 : 0;
    const float* g2 = layer > 0 ? INP(14) + (size_t)lp * DM : nullptr; const float* b2 = layer > 0 ? INP(15) + (size_t)lp * DM : nullptr; fx64* cs_in = layer > 0 ? CSB2(2 * layer) : nullptr;
    if ((layer & 1) == 0) {
        convert_matrix(F, INP(2) + (size_t)j * 2048 * 12288, 2048, 12288, (bf16*)(wsW + W_RET_IN), 1, 1.0f, g2, b2, cs_in, scr, rot);
        convert_matrix(F, INP(5) + (size_t)j * 4096 * 2048, 4096, 2048, (bf16*)(wsW + W_RET_OUT), 0, 1.0f, nullptr, nullptr, nullptr, scr, rot);
    } else {
        convert_matrix(F, INP(6) + (size_t)j * 2048 * 2112, 2048, 2112, (bf16*)(wsW + W_MLA_IN), 2, 1.0f, g2, b2, cs_in, scr, rot);
        { bf16* wt = (bf16*)(wsW + W_MLA_IN);
          PHASE_TID(tid, lane); (void)tid; const int gt = gw * 64 + lane, NGT = NGW * 64; unsigned zz = 0u; asm volatile("" : "+v"(zz));
          for (int e = gt; e < 192 * 2048 / 8; e += NGT) { const int rr = e / 256, cc = e % 256; const int row = 2048 + (rr < 96 ? 32 + rr : 160 + (rr - 96));
              *(GAS v4u*)(wt + (size_t)row * 2048 + cc * 8) = (v4u){zz, zz, zz, zz}; } }
        convert_matrix(F, INP(9) + (size_t)j * 1536 * 3072, 1536, 3072, (bf16*)(wsW + W_MLA_UQ), 3, 0.07216878364870322f * 1.4426950408889634f, INP(7) + (size_t)j * 1536, nullptr, nullptr, scr, rot);
        convert_matrix(F, INP(10) + (size_t)j * 512 * 4096, 512, 4096, (bf16*)(wsW + W_MLA_UKV), 0, 1.0f, INP(8) + (size_t)j * 512, nullptr, nullptr, scr, rot);
        convert_matrix(F, INP(11) + (size_t)j * 2048 * 2048, 2048, 2048, (bf16*)(wsW + W_MLA_OUT), 0, 1.0f, nullptr, nullptr, nullptr, scr, rot);
    }
    convert_matrix(F, INP(16) + (size_t)layer * 2048 * 11264, 2048, 11264, (bf16*)(wsW + W_UP), 4, 1.0f, INP(12) + (size_t)layer * DM, INP(13) + (size_t)layer * DM, CSB2(2 * layer + 1), scr, rot);
    convert_matrix(F, INP(19) + (size_t)layer * 5632 * 2048, 5632, 2048, (bf16*)((layer & 1) ? WSB + WS_WD2 : wsW + W_DOWN), 0, 1.0f, nullptr, nullptr, nullptr, scr, rot);
}

__global__ void __launch_bounds__(NWAVES * 64, 2) fwd_kernel(Args args) {
    extern __shared__ __attribute__((aligned(16))) unsigned char lds_raw[];
    Frame F;
    F.lds = (LAS unsigned char*)lds_raw;
    F.wave = __builtin_amdgcn_readfirstlane((int)threadIdx.x >> 6);
    F.G = gridDim.x; { const int bx = blockIdx.x; F.vcu = (F.G % 8 == 0) ? (bx % 8) * (F.G / 8) + bx / 8 : bx; }
    F.gw = F.vcu * NWAVES + F.wave; F.NGW = F.G * NWAVES;
    volatile LAS unsigned* MISC = (volatile LAS unsigned*)(F.lds + MISC_OFF);
    for (int u = threadIdx.x; u < (LDS_BYTES - LDSCTL_OFF) / 4; u += NWAVES * 64) ((LAS unsigned*)(F.lds + LDSCTL_OFF))[u] = 0u;
    __syncthreads();
    XcdBarrier bar = xcd_barrier_post((unsigned*)(args.ws + WS_CTL) + CW_BAR, MISC + 8);
    LAS float* scr = (LAS float*)(F.lds + RING_OFF + F.wave * 16384);
    PG8_LAS unsigned char* ring = (PG8_LAS unsigned char*)(F.lds + RING_OFF);

#ifdef PROBE_IDLE
    int barno = 0;
#define GRID_BAR() do { XcdBarrier b2_ = bar; unsigned long long bp_ = (unsigned long long)b2_.bar; unsigned bx_ = b2_.x; asm volatile("" : "+s"(bp_), "+s"(bx_)); b2_.bar = (unsigned*)bp_; b2_.x = bx_; \
    __syncthreads(); const unsigned long long t0_ = wall_clock64(); xcd_barrier(b2_); const unsigned long long t1_ = wall_clock64(); \
    if (threadIdx.x == 0 && ((PROBE_IDLE >> (barno < 1 ? 0 : 1 + (barno - 1) % 7)) & 1)) MISC[20] += (unsigned)(t1_ - t0_); ++barno; } while (0)
#else
#define GRID_BAR() do { XcdBarrier b2_ = bar; unsigned long long bp_ = (unsigned long long)b2_.bar; unsigned bx_ = b2_.x; asm volatile("" : "+s"(bp_), "+s"(bx_)); b2_.bar = (unsigned*)bp_; b2_.x = bx_; xcd_barrier(b2_); } while (0)
#endif

    prologue(F, INP(0), INP(1), X, XB, cosR, sinR, cosM, sinM, INP(3), INP(4), LGTAB);
    convert_layer(F, 0, scr, 0);
    GRID_BAR();

#ifndef DIAG_LAYERS
#define DIAG_LAYERS 4
#endif
    for (int layer = 0; layer < DIAG_LAYERS; ++layer) {
        const int j = layer >> 1; const bool is_ret = (layer & 1) == 0;
        const bf16* Aout; const bf16* Wout; int Kout;
        if (is_ret) {
            bf16* RQ = (bf16*)(wsA + A_RQ); bf16* RK = (bf16*)(wsA + A_RK); bf16* RV = (bf16*)(wsA + A_RV); bf16* RG = (bf16*)(wsA + A_RG); bf16* RO = (bf16*)(wsA + A_RO); bf16* ROB = (bf16*)X;
            if (layer == 0) csb2_finalize(F, CSB2(0), CSF(0), 65536);
            {
                pg8::Gemm g{XB, (const bf16*)(wsW + W_RET_IN), T, 12288, 2048}; pg8::StaticOrder S; S.init(T, 12288, F.G, (int)blockIdx.x);
                pg8::EpiRetIn E{RQ, RK, RV, RG, cosR, sinR, pg8::LnCorr{layer > 0 ? STATS(2 * layer - 1) : nullptr, CSF(2 * layer), CSF(2 * layer) + 16384}};
                pg8::gemm_phase<pg8::EpiRetIn, pg8::StaticOrder, G_ALIGN, G_SP2>(ring, g, S, E);
#ifdef PROBE_DUP_R1
                __syncthreads();
                pg8::gemm_phase<pg8::EpiRetIn, pg8::StaticOrder, G_ALIGN, G_SP2>(ring, g, S, E);
#endif
            }
            GRID_BAR();
            ret::phase(F, RQ, RK, RV, RO, ROB, LGTAB + j * 16);
#ifdef PROBE_DUP_RET
            GRID_BAR();
            ret::phase(F, RQ, RK, RV, RO, ROB, LGTAB + j * 16);
#endif
            GRID_BAR();
            gate_pass(F, RO, ROB, RG, RG);
#ifdef PROBE_DUP_GATE
            GRID_BAR();
            gate_pass(F, RO, ROB, RG, RO);
#endif
            GRID_BAR();
            Aout = RG; Wout = (const bf16*)(wsW + W_RET_OUT); Kout = 4096;
        } else {
            bf16* CQ = (bf16*)(wsA + A_MCQ); bf16* CKV = (bf16*)(wsA + A_MCKV); bf16* KR = (bf16*)(wsA + A_MKR); bf16* QA = (bf16*)(wsA + A_MQA);
            bf16* KV = (bf16*)(wsA + A_MKV); bf16* MO = (bf16*)(wsA + A_MO);
            fx64* ssq_q = ssq_base + (size_t)j * T; fx64* ssq_kv = ssq_base + (size_t)(2 + j) * T;
            {
                pg8::Gemm g{XB, (const bf16*)(wsW + W_MLA_IN), T, 2304, 2048}; pg8::StaticOrder S; S.init(T, 2304, F.G, (int)blockIdx.x);
                pg8::EpiMlaIn E{CQ, CKV, KR, ssq_q, ssq_kv, cosM, sinM, pg8::LnCorr{STATS(2 * layer - 1), CSF(2 * layer), CSF(2 * layer) + 16384}};
                pg8::gemm_phase<pg8::EpiMlaIn, pg8::StaticOrder, G_ALIGN, G_SP2>(ring, g, S, E);
            }
            GRID_BAR();
            {
                pg8::Gemm g{CQ, (const bf16*)(wsW + W_MLA_UQ), T, 3072, 1536}; pg8::StaticOrder S; S.init(T, 3072, F.G, (int)blockIdx.x);
                pg8::EpiMlaUq E{QA, ssq_q, cosM, sinM};
                pg8::gemm_phase<pg8::EpiMlaUq, pg8::StaticOrder, G_ALIGN, G_SP2>(ring, g, S, E);
#ifdef PROBE_DUP_M2
                __syncthreads();
                pg8::gemm_phase<pg8::EpiMlaUq, pg8::StaticOrder, G_ALIGN, G_SP2>(ring, g, S, E);
#endif
            }
            __syncthreads();
            {
                pg8::Gemm g{CKV, (const bf16*)(wsW + W_MLA_UKV), T, 4096, 512}; pg8::StaticOrder S; S.init(T, 4096, F.G, (int)blockIdx.x);
                pg8::EpiMlaUkv E{KV, ssq_kv};
                pg8::gemm_phase<pg8::EpiMlaUkv, pg8::StaticOrder, G_ALIGN, G_SP2>(ring, g, S, E);
#ifdef PROBE_DUP_M2
                __syncthreads();
                pg8::gemm_phase<pg8::EpiMlaUkv, pg8::StaticOrder, G_ALIGN, G_SP2>(ring, g, S, E);
#endif
            }
            GRID_BAR();
            att::phase(F, QA, KV, KR, MO);
#ifdef PROBE_DUP_ATT
            GRID_BAR();
            att::phase(F, QA, KV, KR, MO);
#endif
            GRID_BAR();
            Aout = MO; Wout = (const bf16*)(wsW + W_MLA_OUT); Kout = 2048;
        }
        {
            pg8::Gemm g{Aout, Wout, T, 2048, Kout}; pg8::StaticOrder S; S.init(T, 2048, F.G, (int)blockIdx.x);
            const int lp = layer > 0 ? layer - 1 : 0;
            pg8::EpiResid E{XB, nullptr, STATS(2 * layer), layer > 0 ? STATS(2 * layer - 1) : nullptr, INP(14) + (size_t)lp * DM, INP(15) + (size_t)lp * DM, INP(0), INP(1)};
            pg8::gemm_phase<pg8::EpiResid, pg8::StaticOrder, G_ALIGN, G_SP2>(ring, g, S, E);
        }
        GRID_BAR();
#ifndef DIAG_NO_FFN
        bf16* FU = (bf16*)(wsA + A_FU); bf16* FG = (bf16*)(wsA + A_FG);
        {
            pg8::Gemm g{XB, (const bf16*)(wsW + W_UP), T, 11264, 2048}; pg8::StaticOrder S; S.init(T, 11264, F.G, (int)blockIdx.x);
            pg8::EpiFfnUp E{FU, FG, FG + (size_t)512 * 4 * FFN, INP(17) + (size_t)layer * 3 * FFN, INP(18) + (size_t)layer * FFN, pg8::LnCorr{STATS(2 * layer), CSF(2 * layer + 1), CSF(2 * layer + 1) + 16384}};
            pg8::gemm_phase<pg8::EpiFfnUp, pg8::StaticOrder, G_ALIGN, G_SP2>(ring, g, S, E);
#ifdef PROBE_DUP_F1
            __syncthreads();
            pg8::gemm_phase<pg8::EpiFfnUp, pg8::StaticOrder, G_ALIGN, G_SP2>(ring, g, S, E);
#endif
        }
        GRID_BAR();
        ffn_fixup(F, FU, FG, FG + (size_t)512 * 4 * FFN, INP(17) + (size_t)layer * 3 * FFN, INP(18) + (size_t)layer * FFN);
        if (layer < 3) convert_layer(F, layer + 1, scr, (11 * 1024) & 2047);
        GRID_BAR();
        if (layer < 3) csb2_finalize(F, CSB2(2 * layer + 2), CSF(2 * layer + 2), 65536);
        {
            pg8::Gemm g{FU, (const bf16*)((layer & 1) ? WSB + WS_WD2 : wsW + W_DOWN), T, 2048, FFN}; pg8::StaticOrder S; S.init(T, 2048, F.G, (int)blockIdx.x);
            pg8::EpiResid E{XB, layer == DIAG_LAYERS - 1 ? X : nullptr, STATS(2 * layer + 1), STATS(2 * layer), INP(12) + (size_t)layer * DM, INP(13) + (size_t)layer * DM, nullptr, nullptr};
            pg8::gemm_phase<pg8::EpiResid, pg8::StaticOrder, G_ALIGN, G_SP2>(ring, g, S, E);
        }
        GRID_BAR();
#endif
#ifdef PROBE_EXTRA_BARS
        for (int eb = 0; eb < 10; ++eb) GRID_BAR();
#endif
    }
    ln_pass(F, X, XB, nullptr, INP(14) + (size_t)(DIAG_LAYERS - 1) * DM, INP(15) + (size_t)(DIAG_LAYERS - 1) * DM, true);
    GRID_BAR();
#ifdef PROBE_IDLE
    if (threadIdx.x == 0) atomicAdd((unsigned*)(WSB + WS_CTL) + 8192, (unsigned)MISC[20]);
    { XcdBarrier b2_ = bar; xcd_barrier(b2_); }
    if (blockIdx.x == 0 && threadIdx.x == 0) { const unsigned tot = __hip_atomic_load((unsigned*)(WSB + WS_CTL) + 8192, __ATOMIC_RELAXED, __HIP_MEMORY_SCOPE_AGENT);
        const unsigned long long wait = (unsigned long long)(tot / 256u) * PROBE_IDLE_MULT; const unsigned long long ts = wall_clock64();
        while (wall_clock64() - ts < wait) __builtin_amdgcn_s_sleep(32); }
#endif
    if (xb_ld((unsigned*)(WSB + WS_CTL) + CW_BAR + XB_TMO) != 0u) {
        PHASE_TID(tid, lane); (void)tid; const float qn = __builtin_nanf("");
        for (int m = gw; m < T; m += NGW) { GAS f32x4* o = (GAS f32x4*)(X + (size_t)m * DM) + lane;
#pragma unroll
            for (int j2 = 0; j2 < 8; ++j2) o[64 * j2] = (f32x4){qn, qn, qn, qn}; }
    }
}

extern "C" void kernel_launch(void* const* d_in, const int* in_sizes, int n_in, void* d_out, int out_size, void* d_ws, size_t ws_size, hipStream_t stream) {
    static int grid = 0;
    if (grid == 0) {
        if (n_in != 20 || out_size != T * DM || ws_size < WS_END) { fprintf(stderr, "kernel_launch: unexpected shapes (n_in %d out %d ws %zu, need %zu)\n", n_in, out_size, ws_size, (size_t)WS_END); grid = -1; return; }
        int dev = 0, cus = 0, per_cu = 0;
        if (hipGetDevice(&dev) != hipSuccess || hipDeviceGetAttribute(&cus, hipDeviceAttributeMultiprocessorCount, dev) != hipSuccess) { grid = -1; return; }
        if (hipFuncSetAttribute((const void*)fwd_kernel, hipFuncAttributeMaxDynamicSharedMemorySize, LDS_BYTES) != hipSuccess) { fprintf(stderr, "kernel_launch: hipFuncSetAttribute failed\n"); grid = -1; return; }
        if (hipOccupancyMaxActiveBlocksPerMultiprocessor(&per_cu, (const void*)fwd_kernel, NWAVES * 64, LDS_BYTES) != hipSuccess || per_cu < 1)
            fprintf(stderr, "kernel_launch: occupancy query reports %d workgroups per CU\n", per_cu);
        (void)hipGetLastError();
        if (cus != 256) { fprintf(stderr, "kernel_launch: built for a 256-CU device, found %d\n", cus); grid = -1; return; }
        grid = cus;
    }
    if (grid < 0) return;
    if (hipMemsetAsync((char*)d_ws + WS_CTL, 0, CTL_ZERO_BYTES, stream) != hipSuccess) return;
    Args a{};
    for (int i = 0; i < 20; ++i) a.in[i] = (const float*)d_in[i];
    a.out = (float*)d_out; a.ws = (unsigned char*)d_ws;
    hipLaunchKernelGGL(fwd_kernel, dim3(grid), dim3(NWAVES * 64), LDS_BYTES, stream, a);
    const hipError_t le = hipPeekAtLastError();
    if (le != hipSuccess) fprintf(stderr, "kernel_launch: launch failed: %s\n", hipGetErrorName(le));
}
```
